# Optimizing an MI355X kernel written in HIP

```python
import math
import jax, jax.numpy as jnp
from jax import lax
import numpy as np

D_MODEL = 2048
BATCH = 2
SEQ = 4096
DEPTH = 1

PLE_DIM = 256
N_HEADS = 16
HEAD_DIM = 128
D_ATTN = N_HEADS * HEAD_DIM
D_RNN = ((4 * D_MODEL // 3 + 255) // 256) * 256
N_RNN_BLOCKS = 16
RNN_BLOCK = D_RNN // N_RNN_BLOCKS
CONV_WIDTH = 4
LRU_C = 8.0
D_FF = ((8 * D_MODEL + 3 * 256 - 1) // (3 * 256)) * 256
Q_BLOCK = 128
EPS = 1e-6

IN_WIDTHS = (D_RNN, D_RNN, D_ATTN, D_ATTN, D_ATTN, D_MODEL, D_MODEL)
D_IN = sum(IN_WIDTHS)
IN_SPLIT_POINTS = tuple(int(v) for v in np.cumsum(IN_WIDTHS)[:-1])

kernel_name = "hybrid_rglru_stickbreaking_block"


def rmsnorm(x, g):
    x32 = x.astype(jnp.float32)
    r = x32 * lax.rsqrt(jnp.mean(x32 * x32, axis=-1, keepdims=True) + EPS)
    return (r * g.astype(jnp.float32)).astype(x.dtype)


def causal_depthwise_conv(x, w, b):
    S = x.shape[1]
    xp = jnp.pad(x, ((0, 0), (CONV_WIDTH - 1, 0), (0, 0)))
    y = sum(xp[:, k:k + S, :] * w[k] for k in range(CONV_WIDTH))
    return y + b


def rg_lru(x, w_a, b_a, w_x, b_x, lam):
    B, S, _ = x.shape
    xb = x.reshape(B, S, N_RNN_BLOCKS, RNN_BLOCK)
    r = jax.nn.sigmoid(jnp.einsum('bsnc,ncd->bsnd', xb, w_a).reshape(B, S, D_RNN) + b_a)
    i = jax.nn.sigmoid(jnp.einsum('bsnc,ncd->bsnd', xb, w_x).reshape(B, S, D_RNN) + b_x)
    log_a = (-LRU_C * r.astype(jnp.float32) * jax.nn.softplus(-lam.astype(jnp.float32)))
    a = jnp.exp(log_a)
    u = jnp.sqrt(-jnp.expm1(2.0 * log_a)) * (i * x).astype(jnp.float32)

    def combine(c1, c2):
        a1, b1 = c1
        a2, b2 = c2
        return a1 * a2, a2 * b1 + b2

    _, h = lax.associative_scan(combine, (a, u), axis=1)
    return h.astype(x.dtype)


def head_rmsnorm(x, g):
    x32 = x.astype(jnp.float32)
    r = x32 * lax.rsqrt(jnp.mean(x32 * x32, axis=-1, keepdims=True) + EPS)
    return (r * g.astype(jnp.float32)).astype(x.dtype)


def stick_breaking_attention(q, k, v):
    S = q.shape[2]
    scale = 1.0 / math.sqrt(HEAD_DIM)
    outs = []
    for blk in range(S // Q_BLOCK):
        t0 = blk * Q_BLOCK
        tk = t0 + Q_BLOCK
        qb = q[:, :, t0:tk]
        kb = k[:, :, :tk]
        vb = v[:, :, :tk]
        z = jnp.einsum('bhqd,bhkd->bhqk', qb, kb).astype(jnp.float32) * scale
        q_pos = t0 + jnp.arange(Q_BLOCK)[:, None]
        k_pos = jnp.arange(tk)[None, :]
        causal = k_pos < q_pos
        log_keep = jnp.where(causal, jax.nn.log_sigmoid(-z), 0.0)
        incl = lax.cumsum(log_keep, axis=3, reverse=True)
        excl = jnp.concatenate([incl[..., 1:], jnp.zeros_like(incl[..., :1])], axis=-1)
        w = jnp.where(causal, jnp.exp(jax.nn.log_sigmoid(z) + excl), 0.0)
        outs.append(jnp.einsum('bhqk,bhkd->bhqd', w.astype(vb.dtype), vb))
    return jnp.concatenate(outs, axis=2)


def setup_inputs(seed: int = 0) -> dict:
    key = jax.random.key(seed)
    ks = jax.random.split(key, 24)
    f32 = jnp.float32

    def nrm(k, shape, fan_in):
        return jax.random.normal(k, shape, f32) * (fan_in ** -0.5)

    def gain(k, shape):
        return 1.0 + 0.02 * jax.random.normal(k, shape, f32)

    u = jax.random.uniform(ks[9], (DEPTH, D_RNN), f32, 0.9, 0.999)
    s = u ** (1.0 / LRU_C)
    lru_lambda = jnp.log(s) - jnp.log1p(-s)

    return {
        "x": jax.random.normal(ks[0], (BATCH, SEQ, D_MODEL), f32),
        "p": jax.random.normal(ks[1], (DEPTH, BATCH, SEQ, PLE_DIM), f32),
        "g_mix": gain(ks[2], (DEPTH, D_MODEL)),
        "w_in": nrm(ks[3], (DEPTH, D_MODEL, D_IN), D_MODEL),
        "conv_w": nrm(ks[4], (DEPTH, CONV_WIDTH, D_RNN), CONV_WIDTH),
        "conv_b": 0.02 * jax.random.normal(ks[5], (DEPTH, D_RNN), f32),
        "w_rg_a": nrm(ks[6], (DEPTH, N_RNN_BLOCKS, RNN_BLOCK, RNN_BLOCK), RNN_BLOCK),
        "b_rg_a": 0.02 * jax.random.normal(ks[7], (DEPTH, D_RNN), f32),
        "w_rg_x": nrm(ks[8], (DEPTH, N_RNN_BLOCKS, RNN_BLOCK, RNN_BLOCK), RNN_BLOCK),
        "b_rg_x": 0.02 * jax.random.normal(ks[10], (DEPTH, D_RNN), f32),
        "lru_lambda": lru_lambda,
        "q_gain": gain(ks[11], (DEPTH, HEAD_DIM)),
        "k_gain": gain(ks[12], (DEPTH, HEAD_DIM)),
        "w_rnn_out": nrm(ks[13], (DEPTH, D_RNN, D_MODEL), D_RNN),
        "w_attn_out": nrm(ks[14], (DEPTH, D_ATTN, D_MODEL), D_ATTN),
        "w_o": nrm(ks[15], (DEPTH, D_MODEL, D_MODEL), D_MODEL),
        "g_ffn": gain(ks[16], (DEPTH, D_MODEL)),
        "w_ffn_gu": nrm(ks[17], (DEPTH, D_MODEL, 2 * D_FF), D_MODEL),
        "w_ffn_down": nrm(ks[18], (DEPTH, D_FF, D_MODEL), D_FF),
        "g_ple": gain(ks[19], (DEPTH, D_MODEL)),
        "w_ple_gate": nrm(ks[20], (DEPTH, D_MODEL, D_MODEL), D_MODEL),
        "w_ple_proj": nrm(ks[21], (DEPTH, PLE_DIM, D_MODEL), PLE_DIM),
    }


def reference(x, p, g_mix, w_in, conv_w, conv_b, w_rg_a, b_rg_a, w_rg_x, b_rg_x,
              lru_lambda, q_gain, k_gain, w_rnn_out, w_attn_out, w_o, g_ffn,
              w_ffn_gu, w_ffn_down, g_ple, w_ple_gate, w_ple_proj):
    B, S, _ = x.shape
    for i in range(DEPTH):
        h = rmsnorm(x, g_mix[i])
        proj = h @ w_in[i]
        x_r, g_r, q, k, v, gate_r, gate_a = jnp.split(proj, IN_SPLIT_POINTS, axis=-1)

        xc = causal_depthwise_conv(x_r, conv_w[i], conv_b[i])
        y_r = jax.nn.gelu(g_r) * rg_lru(xc, w_rg_a[i], b_rg_a[i], w_rg_x[i], b_rg_x[i], lru_lambda[i])
        y_r = y_r @ w_rnn_out[i]

        q = head_rmsnorm(q.reshape(B, S, N_HEADS, HEAD_DIM).transpose(0, 2, 1, 3), q_gain[i])
        k = head_rmsnorm(k.reshape(B, S, N_HEADS, HEAD_DIM).transpose(0, 2, 1, 3), k_gain[i])
        v = v.reshape(B, S, N_HEADS, HEAD_DIM).transpose(0, 2, 1, 3)
        o = stick_breaking_attention(q, k, v)
        y_a = o.transpose(0, 2, 1, 3).reshape(B, S, D_ATTN) @ w_attn_out[i]

        mix = jax.nn.sigmoid(gate_r) * y_r + jax.nn.sigmoid(gate_a) * y_a
        x = x + mix @ w_o[i]

        h = rmsnorm(x, g_ffn[i])
        gu = h @ w_ffn_gu[i]
        g, u = jnp.split(gu, 2, axis=-1)
        x = x + (jax.nn.silu(g) * u) @ w_ffn_down[i]

        ple_gate = jax.nn.sigmoid(rmsnorm(x, g_ple[i]) @ w_ple_gate[i])
        x = x + ple_gate * (p[i] @ w_ple_proj[i])
    return x
```

```cpp
#include <hip/hip_runtime.h>
#include <cstdio>
#include <cstdint>

typedef unsigned short bf16_t;
typedef float f32x4 __attribute__((ext_vector_type(4)));
typedef unsigned u32x4 __attribute__((ext_vector_type(4)));
typedef unsigned u32x2 __attribute__((ext_vector_type(2)));

constexpr int SEQ = 4096, NBATCH = 2, M = NBATCH * SEQ, DM = 2048, DR = 2816, DIN = 15872, DFF = 5632, PLE = 256, NH = 16, HD = 128;
constexpr int NRB = 16, RB = 176;
constexpr float EPS = 1e-6f;
constexpr float LOG2E = 1.4426950408889634f, LN2 = 0.6931471805599453f;

constexpr size_t MiB = (size_t)1 << 20;
constexpr size_t WS_WRO = 0, WS_WAO = 11 * MiB, WS_WO = 19 * MiB, WS_WGU = 27 * MiB, WS_WDN = 71 * MiB, WS_WPG = 93 * MiB, WS_WPP = 101 * MiB, WS_WRA = 102 * MiB, WS_WRX = 102 * MiB + 1536 * 1024;
constexpr size_t WS_W1 = 106 * MiB, WS_HB = 168 * MiB, WS_QN = 200 * MiB, WS_KN = 232 * MiB, WS_VV = 264 * MiB, WS_XR = 296 * MiB, WS_GG = 340 * MiB, WS_SGR = 384 * MiB, WS_SGA = 416 * MiB, WS_PB = 448 * MiB, WS_SMALL = 460 * MiB, WS_END = 464 * MiB;
constexpr size_t WS_XC = WS_W1, WS_OB = WS_HB, WS_MIXA = WS_QN, WS_PP = WS_VV, WS_AR = WS_SGA, WS_MIXB = WS_W1, WS_X1B = WS_GG, WS_X2B = WS_GG, WS_ACT = WS_W1;
constexpr size_t SM_SSQ1 = 0, SM_SSQ2 = 32768, SM_SUMM = 65536;

__device__ __forceinline__ float bf2f(bf16_t b) { return __uint_as_float((unsigned)b << 16); }
__device__ __forceinline__ bf16_t f2bf(float f) { unsigned u = __float_as_uint(f); return (bf16_t)((u + 0x7fffu + ((u >> 16) & 1u)) >> 16); }
__device__ __forceinline__ float rbf(float f) { return bf2f(f2bf(f)); }
__device__ __forceinline__ float sigmoidf_(float x) { return __builtin_amdgcn_rcpf(1.0f + __builtin_amdgcn_exp2f(-x * LOG2E)); }
__device__ __forceinline__ float gelu_tanh(float x) { const float y = 0.7978845608028654f * (x + 0.044715f * x * x * x); return x * __builtin_amdgcn_rcpf(1.0f + __builtin_amdgcn_exp2f(-2.0f * LOG2E * y)); }
__device__ __forceinline__ float softplusf_(float z) { return fmaxf(z, 0.f) + LN2 * __builtin_amdgcn_logf(1.0f + __builtin_amdgcn_exp2f(-fabsf(z) * LOG2E)); }
__device__ __forceinline__ float wave_sum(float v) {
#pragma unroll
    for (int o = 1; o < 64; o <<= 1) v += __shfl_xor(v, o);
    return v;
}

__global__ __launch_bounds__(256) void nv_rmsnorm(const float* __restrict__ x, const float* __restrict__ g, bf16_t* __restrict__ out) {
    const int row = blockIdx.x * 4 + (threadIdx.x >> 6), lane = threadIdx.x & 63;
    const float* xr = x + (size_t)row * DM;
    float s = 0.f;
    for (int c = lane; c < DM; c += 64) { const float v = xr[c]; s += v * v; }
    s = wave_sum(s);
    const float rs = 1.0f / sqrtf(s * (1.0f / DM) + EPS);
    for (int c = lane; c < DM; c += 64) out[(size_t)row * DM + c] = f2bf(xr[c] * rs * g[c]);
}
__global__ __launch_bounds__(256) void nv_cvt(const float* __restrict__ in, bf16_t* __restrict__ out, int n) {
    for (int i = blockIdx.x * 256 + threadIdx.x; i < n; i += gridDim.x * 256) out[i] = f2bf(in[i]);
}
__global__ __launch_bounds__(256) void nv_rowssq(const float* __restrict__ x, float* __restrict__ ssq) {
    const int row = blockIdx.x * 4 + (threadIdx.x >> 6), lane = threadIdx.x & 63;
    float s = 0.f;
    for (int c = lane; c < DM; c += 64) { const float v = x[(size_t)row * DM + c]; s += v * v; }
    s = wave_sum(s);
    if (lane == 0) ssq[row] = s;
}

struct NvEpi {
    int mode;
    bf16_t* O; int ldo;
    float* F; int ldf;
    const bf16_t* G; int ldg;
    const float* X;
    const float* P;
    const float* ssq;
    __device__ __forceinline__ void operator()(int m, int n, float a0, float a1) const {
        switch (mode) {
            case 0: O[(size_t)m * ldo + n] = f2bf(a0); break;
            case 1: O[(size_t)m * ldo + n] = f2bf(gelu_tanh(a0)); break;
            case 2: O[(size_t)m * ldo + n] = f2bf(sigmoidf_(a0)); break;
            case 3: F[(size_t)m * ldf + n] = bf2f(G[(size_t)m * ldg + n]) * a0; break;
            case 4: F[(size_t)m * ldf + n] = a0; break;
            case 5: O[(size_t)m * ldo + n] = f2bf(F[(size_t)m * ldf + n] + bf2f(G[(size_t)m * ldg + n]) * a0); break;
            case 6: { const float v = X[(size_t)m * ldf + n] + a0; F[(size_t)m * ldf + n] = v; O[(size_t)m * ldo + n] = f2bf(v); } break;
            case 7: { const float rs = 1.0f / sqrtf(ssq[m] * (1.0f / DM) + EPS); const float g = rs * a0, u = rs * a1; O[(size_t)m * ldo + n] = f2bf(g * sigmoidf_(g) * u); } break;
            case 8: { const float rs = 1.0f / sqrtf(ssq[m] * (1.0f / DM) + EPS); F[(size_t)m * ldf + n] = X[(size_t)m * ldf + n] + sigmoidf_(rs * a0) * P[(size_t)m * ldf + n]; } break;
        }
    }
};
template <int NB>
__global__ __launch_bounds__(256) void nv_gemm(const bf16_t* __restrict__ A, int lda, const float* __restrict__ W0, const float* __restrict__ W1, int ldw, const float* __restrict__ ks, int K, NvEpi epi) {
    __shared__ float As[16][68];
    __shared__ float Bs[NB][16][68];
    const int tid = threadIdx.x, tx = tid & 15, ty = tid >> 4;
    const int m0 = blockIdx.y * 64, n0 = blockIdx.x * 64;
    float acc[NB][4][4];
#pragma unroll
    for (int b = 0; b < NB; ++b)
#pragma unroll
        for (int i = 0; i < 4; ++i)
#pragma unroll
            for (int j = 0; j < 4; ++j) acc[b][i][j] = 0.f;
    for (int k0 = 0; k0 < K; k0 += 16) {
        { const int r = tid >> 2, kk = (tid & 3) * 4; const bf16_t* ap = A + (size_t)(m0 + r) * lda + k0 + kk;
#pragma unroll
          for (int j = 0; j < 4; ++j) As[kk + j][r] = bf2f(ap[j]); }
        { const int kk = tid >> 4, nn = (tid & 15) * 4; const float sc = ks ? ks[k0 + kk] : 1.0f;
          const f32x4 w0 = *(const f32x4*)(W0 + (size_t)(k0 + kk) * ldw + n0 + nn);
#pragma unroll
          for (int j = 0; j < 4; ++j) Bs[0][kk][nn + j] = rbf(w0[j] * sc);
          if (NB == 2) { const f32x4 w1 = *(const f32x4*)(W1 + (size_t)(k0 + kk) * ldw + n0 + nn);
#pragma unroll
              for (int j = 0; j < 4; ++j) Bs[NB - 1][kk][nn + j] = rbf(w1[j] * sc); } }
        __syncthreads();
#pragma unroll
        for (int kk = 0; kk < 16; ++kk) {
            const f32x4 a = *(const f32x4*)&As[kk][ty * 4];
#pragma unroll
            for (int b = 0; b < NB; ++b) { const f32x4 w = *(const f32x4*)&Bs[b][kk][tx * 4];
#pragma unroll
                for (int i = 0; i < 4; ++i)
#pragma unroll
                    for (int j = 0; j < 4; ++j) acc[b][i][j] += a[i] * w[j]; }
        }
        __syncthreads();
    }
#pragma unroll
    for (int i = 0; i < 4; ++i)
#pragma unroll
        for (int j = 0; j < 4; ++j) epi(m0 + ty * 4 + i, n0 + tx * 4 + j, acc[0][i][j], acc[NB - 1][i][j]);
}
__global__ __launch_bounds__(256) void nv_headnorm(bf16_t* __restrict__ q, const float* __restrict__ gain, float extra) {
    const int idx = blockIdx.x * 4 + (threadIdx.x >> 6), lane = threadIdx.x & 63;
    bf16_t* p = q + (size_t)idx * HD;
    const float a = bf2f(p[lane]), b = bf2f(p[lane + 64]);
    const float s = wave_sum(a * a + b * b);
    const float rs = 1.0f / sqrtf(s * (1.0f / HD) + EPS) * extra;
    p[lane] = f2bf(a * rs * gain[lane]); p[lane + 64] = f2bf(b * rs * gain[lane + 64]);
}
__global__ __launch_bounds__(256) void nv_conv(const bf16_t* __restrict__ xr, const float* __restrict__ cw, const float* __restrict__ cb, bf16_t* __restrict__ xc) {
    const size_t total = (size_t)M * DR;
    for (size_t i = (size_t)blockIdx.x * 256 + threadIdx.x; i < total; i += (size_t)gridDim.x * 256) {
        const int m = (int)(i / DR), c = (int)(i % DR), s = m & (SEQ - 1);
        float acc = cb[c];
#pragma unroll
        for (int j = 0; j < 4; ++j) { const int sj = s - 3 + j; if (sj >= 0) acc += cw[j * DR + c] * bf2f(xr[(size_t)(m - 3 + j) * DR + c]); }
        xc[i] = f2bf(acc);
    }
}
__global__ __launch_bounds__(256) void nv_attn(const bf16_t* __restrict__ qn, const bf16_t* __restrict__ kn, const bf16_t* __restrict__ vv, bf16_t* __restrict__ ob) {
    const int gw = blockIdx.x * 4 + (threadIdx.x >> 6), lane = threadIdx.x & 63;
    const int t = gw & (SEQ - 1), h = (gw >> 12) & 15, b = gw >> 16;
    const size_t rowb = (size_t)b * SEQ;
    const bf16_t* qp = qn + (rowb + t) * DM + h * HD;
    const float q0 = bf2f(qp[lane]), q1 = bf2f(qp[lane + 64]);
    float o0 = 0.f, o1 = 0.f, R = 0.f;
    for (int s = t - 1; s >= 0; --s) {
        const bf16_t* kp = kn + (rowb + s) * DM + h * HD;
        const float z = wave_sum(q0 * bf2f(kp[lane]) + q1 * bf2f(kp[lane + 64]));
        const float sp = softplusf_(z);
        const float w = __builtin_amdgcn_exp2f((z - sp + R) * LOG2E);
        const bf16_t* vp = vv + (rowb + s) * DM + h * HD;
        const float wb = rbf(w);
        o0 += wb * bf2f(vp[lane]); o1 += wb * bf2f(vp[lane + 64]);
        R -= sp;
        if (R < -88.0f) break;
    }
    bf16_t* op = ob + (rowb + t) * DM + h * HD;
    op[lane] = f2bf(o0); op[lane + 64] = f2bf(o1);
}
__global__ __launch_bounds__(192) void nv_rnn(const bf16_t* __restrict__ xc, const bf16_t* __restrict__ gg, const float* __restrict__ wa, const float* __restrict__ ba, const float* __restrict__ wx, const float* __restrict__ bx,
                                              const float* __restrict__ lam, bf16_t* __restrict__ ar) {
    __shared__ float xs[RB];
    const int b = blockIdx.x >> 4, n = blockIdx.x & 15, d = threadIdx.x;
    const bool act = d < RB;
    const int ch = n * RB + (act ? d : 0);
    const float* wap = wa + (size_t)n * RB * RB + (act ? d : 0);
    const float* wxp = wx + (size_t)n * RB * RB + (act ? d : 0);
    const float bav = ba[ch], bxv = bx[ch];
    const float l = lam[ch];
    const float cl = 8.0f * (fmaxf(-l, 0.f) + log1pf(expf(-fabsf(l))));
    float h = 0.f;
    for (int s = 0; s < SEQ; ++s) {
        const size_t m = (size_t)b * SEQ + s;
        __syncthreads();
        if (act) xs[d] = bf2f(xc[m * DR + n * RB + d]);
        __syncthreads();
        float sa = 0.f, sx = 0.f;
        for (int c = 0; c < RB; ++c) { const float xv = xs[c]; sa += xv * rbf(wap[(size_t)c * RB]); sx += xv * rbf(wxp[(size_t)c * RB]); }
        const float r = sigmoidf_(sa + bav), ig = sigmoidf_(sx + bxv);
        const float la = -cl * r;
        const float a = expf(la);
        const float u = sqrtf(-expm1f(2.0f * la)) * (ig * xs[act ? d : 0]);
        h = a * h + u;
        if (act) ar[m * DR + ch] = f2bf(bf2f(gg[m * DR + ch]) * h);
    }
}

extern "C" void kernel_launch(void* const* d_in, const int* in_sizes, int n_in, void* d_out, int out_size, void* d_ws, size_t ws_size, hipStream_t stream) {
    if (n_in != 22 || out_size != M * DM || ws_size < WS_END) { fprintf(stderr, "kernel_launch: unexpected sizes n_in %d out %d ws %zu\n", n_in, out_size, ws_size); return; }
    const float* x = (const float*)d_in[0]; const float* p = (const float*)d_in[1]; const float* g_mix = (const float*)d_in[2]; const float* w_in = (const float*)d_in[3];
    const float* conv_w = (const float*)d_in[4]; const float* conv_b = (const float*)d_in[5]; const float* w_rg_a = (const float*)d_in[6]; const float* b_rg_a = (const float*)d_in[7];
    const float* w_rg_x = (const float*)d_in[8]; const float* b_rg_x = (const float*)d_in[9]; const float* lam = (const float*)d_in[10]; const float* q_gain = (const float*)d_in[11];
    const float* k_gain = (const float*)d_in[12]; const float* w_rnn_out = (const float*)d_in[13]; const float* w_attn_out = (const float*)d_in[14]; const float* w_o = (const float*)d_in[15];
    const float* g_ffn = (const float*)d_in[16]; const float* w_gu = (const float*)d_in[17]; const float* w_dn = (const float*)d_in[18]; const float* g_ple = (const float*)d_in[19];
    const float* w_pg = (const float*)d_in[20]; const float* w_pp = (const float*)d_in[21];
    float* out = (float*)d_out; unsigned char* ws = (unsigned char*)d_ws;
    bf16_t* hb = (bf16_t*)(ws + WS_HB); bf16_t* qn = (bf16_t*)(ws + WS_QN); bf16_t* kn = (bf16_t*)(ws + WS_KN); bf16_t* vv = (bf16_t*)(ws + WS_VV); bf16_t* xr = (bf16_t*)(ws + WS_XR);
    bf16_t* gg = (bf16_t*)(ws + WS_GG); bf16_t* sgr = (bf16_t*)(ws + WS_SGR); bf16_t* sga = (bf16_t*)(ws + WS_SGA); bf16_t* pb = (bf16_t*)(ws + WS_PB); bf16_t* xc = (bf16_t*)(ws + WS_XC);
    bf16_t* ob = (bf16_t*)(ws + WS_OB); float* mixa = (float*)(ws + WS_MIXA); float* Pp = (float*)(ws + WS_PP); bf16_t* ar = (bf16_t*)(ws + WS_AR); bf16_t* mixb = (bf16_t*)(ws + WS_MIXB);
    bf16_t* x1b = (bf16_t*)(ws + WS_X1B); bf16_t* x2b = (bf16_t*)(ws + WS_X2B); bf16_t* act = (bf16_t*)(ws + WS_ACT);
    float* ssq1 = (float*)(ws + WS_SMALL + SM_SSQ1); float* ssq2 = (float*)(ws + WS_SMALL + SM_SSQ2);

    nv_rmsnorm<<<M / 4, 256, 0, stream>>>(x, g_mix, hb);
    nv_cvt<<<2048, 256, 0, stream>>>(p, pb, M * PLE);
    auto gemm1 = [&](const bf16_t* A, int lda, const float* W, int ldw, int wcol, const float* ks, int K, int N, NvEpi e) {
        nv_gemm<1><<<dim3(N / 64, M / 64), 256, 0, stream>>>(A, lda, W + wcol, nullptr, ldw, ks, K, e); };
    NvEpi e{};
    e = NvEpi{}; e.mode = 0; e.O = xr; e.ldo = DR; gemm1(hb, DM, w_in, DIN, 0, nullptr, DM, DR, e);
    e = NvEpi{}; e.mode = 1; e.O = gg; e.ldo = DR; gemm1(hb, DM, w_in, DIN, DR, nullptr, DM, DR, e);
    e = NvEpi{}; e.mode = 0; e.O = qn; e.ldo = DM; gemm1(hb, DM, w_in, DIN, 2 * DR, nullptr, DM, DM, e);
    e = NvEpi{}; e.mode = 0; e.O = kn; e.ldo = DM; gemm1(hb, DM, w_in, DIN, 2 * DR + DM, nullptr, DM, DM, e);
    e = NvEpi{}; e.mode = 0; e.O = vv; e.ldo = DM; gemm1(hb, DM, w_in, DIN, 2 * DR + 2 * DM, nullptr, DM, DM, e);
    e = NvEpi{}; e.mode = 2; e.O = sgr; e.ldo = DM; gemm1(hb, DM, w_in, DIN, 2 * DR + 3 * DM, nullptr, DM, DM, e);
    e = NvEpi{}; e.mode = 2; e.O = sga; e.ldo = DM; gemm1(hb, DM, w_in, DIN, 2 * DR + 4 * DM, nullptr, DM, DM, e);
    nv_headnorm<<<M * NH / 4, 256, 0, stream>>>(qn, q_gain, 0.08838834764831845f);
    nv_headnorm<<<M * NH / 4, 256, 0, stream>>>(kn, k_gain, 1.0f);
    nv_conv<<<4096, 256, 0, stream>>>(xr, conv_w, conv_b, xc);
    nv_attn<<<NBATCH * NH * SEQ / 4, 256, 0, stream>>>(qn, kn, vv, ob);
    e = NvEpi{}; e.mode = 3; e.F = mixa; e.ldf = DM; e.G = sga; e.ldg = DM; gemm1(ob, DM, w_attn_out, DM, 0, nullptr, DM, DM, e);
    e = NvEpi{}; e.mode = 4; e.F = Pp; e.ldf = DM; gemm1(pb, PLE, w_pp, DM, 0, nullptr, PLE, DM, e);
    nv_rnn<<<NBATCH * NRB, 192, 0, stream>>>(xc, gg, w_rg_a, b_rg_a, w_rg_x, b_rg_x, lam, ar);
    e = NvEpi{}; e.mode = 5; e.O = mixb; e.ldo = DM; e.F = mixa; e.ldf = DM; e.G = sgr; e.ldg = DM; gemm1(ar, DR, w_rnn_out, DM, 0, nullptr, DR, DM, e);
    e = NvEpi{}; e.mode = 6; e.O = x1b; e.ldo = DM; e.F = out; e.ldf = DM; e.X = x; gemm1(mixb, DM, w_o, DM, 0, nullptr, DM, DM, e);
    nv_rowssq<<<M / 4, 256, 0, stream>>>(out, ssq1);
    e = NvEpi{}; e.mode = 7; e.O = act; e.ldo = DFF; e.ssq = ssq1;
    nv_gemm<2><<<dim3(DFF / 64, M / 64), 256, 0, stream>>>(x1b, DM, w_gu, w_gu + DFF, 2 * DFF, g_ffn, DM, e);
    e = NvEpi{}; e.mode = 6; e.O = x2b; e.ldo = DM; e.F = out; e.ldf = DM; e.X = out; gemm1(act, DFF, w_dn, DM, 0, nullptr, DFF, DM, e);
    nv_rowssq<<<M / 4, 256, 0, stream>>>(out, ssq2);
    e = NvEpi{}; e.mode = 8; e.F = out; e.ldf = DM; e.X = out; e.P = Pp; e.ssq = ssq2; gemm1(x2b, DM, w_pg, DM, 0, g_ple, DM, DM, e);
}
```

```cpp
#include <hip/hip_runtime.h>
#include <hip/hip_cooperative_groups.h>
#include <cstdio>
#include <cstdint>

typedef unsigned short bf16_t;
typedef float f32x4 __attribute__((ext_vector_type(4)));
typedef unsigned u32x4 __attribute__((ext_vector_type(4)));
typedef unsigned u32x2 __attribute__((ext_vector_type(2)));
typedef short bf16x8 __attribute__((ext_vector_type(8)));
typedef short s16x4 __attribute__((ext_vector_type(4)));
typedef float f32x16 __attribute__((ext_vector_type(16)));
#define LAS __attribute__((address_space(3)))

constexpr int SEQ = 4096, NBATCH = 2, M = NBATCH * SEQ, DM = 2048, DR = 2816, DIN = 15872, DFF = 5632, PLE = 256, NH = 16, HD = 128;
constexpr int NRB = 16, RB = 176, RBP = 192, NCHUNK = 32, CHUNK = 128;
constexpr float EPS = 1e-6f;
constexpr float LOG2E = 1.4426950408889634f, LN2 = 0.6931471805599453f;

constexpr size_t MiB = (size_t)1 << 20;
constexpr size_t WS_WRO = 0, WS_WAO = 11 * MiB, WS_WO = 19 * MiB, WS_WGU = 27 * MiB, WS_WDN = 71 * MiB, WS_WPG = 93 * MiB, WS_WPP = 101 * MiB, WS_WRA = 102 * MiB, WS_WRX = 102 * MiB + 1536 * 1024;
constexpr size_t WS_W1 = 106 * MiB, WS_HB = 168 * MiB, WS_QN = 200 * MiB, WS_KN = 232 * MiB, WS_VV = 264 * MiB, WS_XR = 296 * MiB, WS_GG = 340 * MiB, WS_SGR = 384 * MiB, WS_SGA = 416 * MiB, WS_PB = 448 * MiB, WS_SMALL = 460 * MiB, WS_END = 464 * MiB;
constexpr size_t WS_XC = WS_W1, WS_OB = WS_HB, WS_MIXA = WS_QN, WS_PP = WS_VV, WS_AR = WS_SGA, WS_MIXB = WS_W1, WS_X1B = WS_GG, WS_X2B = WS_GG, WS_ACT = WS_W1;
constexpr size_t SM_SSQ1 = 0, SM_SSQ2 = 32768, SM_SUMM = 65536;

__device__ __forceinline__ float bf2f(bf16_t b) { return __uint_as_float((unsigned)b << 16); }
__device__ __forceinline__ bf16_t f2bf(float f) { unsigned u = __float_as_uint(f); return (bf16_t)((u + 0x7fffu + ((u >> 16) & 1u)) >> 16); }
__device__ __forceinline__ float rbf(float f) { return bf2f(f2bf(f)); }
__device__ __forceinline__ float sigmoidf_(float x) { return __builtin_amdgcn_rcpf(1.0f + __builtin_amdgcn_exp2f(-x * LOG2E)); }
__device__ __forceinline__ float gelu_tanh(float x) { const float y = 0.7978845608028654f * (x + 0.044715f * x * x * x); return x * __builtin_amdgcn_rcpf(1.0f + __builtin_amdgcn_exp2f(-2.0f * LOG2E * y)); }
__device__ __forceinline__ float softplusf_(float z) { return fmaxf(z, 0.f) + LN2 * __builtin_amdgcn_logf(1.0f + __builtin_amdgcn_exp2f(-fabsf(z) * LOG2E)); }
__device__ __forceinline__ float wave_sum(float v) {
#pragma unroll
    for (int o = 1; o < 64; o <<= 1) v += __shfl_xor(v, o);
    return v;
}

__global__ __launch_bounds__(256) void nv_rmsnorm(const float* __restrict__ x, const float* __restrict__ g, bf16_t* __restrict__ out) {
    const int row = blockIdx.x * 4 + (threadIdx.x >> 6), lane = threadIdx.x & 63;
    const float* xr = x + (size_t)row * DM;
    float s = 0.f;
    for (int c = lane; c < DM; c += 64) { const float v = xr[c]; s += v * v; }
    s = wave_sum(s);
    const float rs = 1.0f / sqrtf(s * (1.0f / DM) + EPS);
    for (int c = lane; c < DM; c += 64) out[(size_t)row * DM + c] = f2bf(xr[c] * rs * g[c]);
}
__global__ __launch_bounds__(256) void nv_cvt(const float* __restrict__ in, bf16_t* __restrict__ out, int n) {
    for (int i = blockIdx.x * 256 + threadIdx.x; i < n; i += gridDim.x * 256) out[i] = f2bf(in[i]);
}
__global__ __launch_bounds__(256) void nv_rowssq(const float* __restrict__ x, float* __restrict__ ssq) {
    const int row = blockIdx.x * 4 + (threadIdx.x >> 6), lane = threadIdx.x & 63;
    float s = 0.f;
    for (int c = lane; c < DM; c += 64) { const float v = x[(size_t)row * DM + c]; s += v * v; }
    s = wave_sum(s);
    if (lane == 0) ssq[row] = s;
}

struct NvEpi {
    int mode;
    bf16_t* O; int ldo;
    float* F; int ldf;
    const bf16_t* G; int ldg;
    const float* X;
    const float* P;
    const float* ssq;
    __device__ __forceinline__ void operator()(int m, int n, float a0, float a1) const {
        switch (mode) {
            case 0: O[(size_t)m * ldo + n] = f2bf(a0); break;
            case 1: O[(size_t)m * ldo + n] = f2bf(gelu_tanh(a0)); break;
            case 2: O[(size_t)m * ldo + n] = f2bf(sigmoidf_(a0)); break;
            case 3: F[(size_t)m * ldf + n] = bf2f(G[(size_t)m * ldg + n]) * a0; break;
            case 4: F[(size_t)m * ldf + n] = a0; break;
            case 5: O[(size_t)m * ldo + n] = f2bf(F[(size_t)m * ldf + n] + bf2f(G[(size_t)m * ldg + n]) * a0); break;
            case 6: { const float v = X[(size_t)m * ldf + n] + a0; F[(size_t)m * ldf + n] = v; O[(size_t)m * ldo + n] = f2bf(v); } break;
            case 7: { const float rs = 1.0f / sqrtf(ssq[m] * (1.0f / DM) + EPS); const float g = rs * a0, u = rs * a1; O[(size_t)m * ldo + n] = f2bf(g * sigmoidf_(g) * u); } break;
            case 8: { const float rs = 1.0f / sqrtf(ssq[m] * (1.0f / DM) + EPS); F[(size_t)m * ldf + n] = X[(size_t)m * ldf + n] + sigmoidf_(rs * a0) * P[(size_t)m * ldf + n]; } break;
        }
    }
};
template <int NB>
__global__ __launch_bounds__(256) void nv_gemm(const bf16_t* __restrict__ A, int lda, const float* __restrict__ W0, const float* __restrict__ W1, int ldw, const float* __restrict__ ks, int K, NvEpi epi) {
    __shared__ float As[16][68];
    __shared__ float Bs[NB][16][68];
    const int tid = threadIdx.x, tx = tid & 15, ty = tid >> 4;
    const int m0 = blockIdx.y * 64, n0 = blockIdx.x * 64;
    float acc[NB][4][4];
#pragma unroll
    for (int b = 0; b < NB; ++b)
#pragma unroll
        for (int i = 0; i < 4; ++i)
#pragma unroll
            for (int j = 0; j < 4; ++j) acc[b][i][j] = 0.f;
    for (int k0 = 0; k0 < K; k0 += 16) {
        { const int r = tid >> 2, kk = (tid & 3) * 4; const bf16_t* ap = A + (size_t)(m0 + r) * lda + k0 + kk;
#pragma unroll
          for (int j = 0; j < 4; ++j) As[kk + j][r] = bf2f(ap[j]); }
        { const int kk = tid >> 4, nn = (tid & 15) * 4; const float sc = ks ? ks[k0 + kk] : 1.0f;
          const f32x4 w0 = *(const f32x4*)(W0 + (size_t)(k0 + kk) * ldw + n0 + nn);
#pragma unroll
          for (int j = 0; j < 4; ++j) Bs[0][kk][nn + j] = rbf(w0[j] * sc);
          if (NB == 2) { const f32x4 w1 = *(const f32x4*)(W1 + (size_t)(k0 + kk) * ldw + n0 + nn);
#pragma unroll
              for (int j = 0; j < 4; ++j) Bs[NB - 1][kk][nn + j] = rbf(w1[j] * sc); } }
        __syncthreads();
#pragma unroll
        for (int kk = 0; kk < 16; ++kk) {
            const f32x4 a = *(const f32x4*)&As[kk][ty * 4];
#pragma unroll
            for (int b = 0; b < NB; ++b) { const f32x4 w = *(const f32x4*)&Bs[b][kk][tx * 4];
#pragma unroll
                for (int i = 0; i < 4; ++i)
#pragma unroll
                    for (int j = 0; j < 4; ++j) acc[b][i][j] += a[i] * w[j]; }
        }
        __syncthreads();
    }
#pragma unroll
    for (int i = 0; i < 4; ++i)
#pragma unroll
        for (int j = 0; j < 4; ++j) epi(m0 + ty * 4 + i, n0 + tx * 4 + j, acc[0][i][j], acc[NB - 1][i][j]);
}
__global__ __launch_bounds__(256) void nv_headnorm(bf16_t* __restrict__ q, const float* __restrict__ gain, float extra) {
    const int idx = blockIdx.x * 4 + (threadIdx.x >> 6), lane = threadIdx.x & 63;
    bf16_t* p = q + (size_t)idx * HD;
    const float a = bf2f(p[lane]), b = bf2f(p[lane + 64]);
    const float s = wave_sum(a * a + b * b);
    const float rs = 1.0f / sqrtf(s * (1.0f / HD) + EPS) * extra;
    p[lane] = f2bf(a * rs * gain[lane]); p[lane + 64] = f2bf(b * rs * gain[lane + 64]);
}
__global__ __launch_bounds__(256) void nv_conv(const bf16_t* __restrict__ xr, const float* __restrict__ cw, const float* __restrict__ cb, bf16_t* __restrict__ xc) {
    const size_t total = (size_t)M * DR;
    for (size_t i = (size_t)blockIdx.x * 256 + threadIdx.x; i < total; i += (size_t)gridDim.x * 256) {
        const int m = (int)(i / DR), c = (int)(i % DR), s = m & (SEQ - 1);
        float acc = cb[c];
#pragma unroll
        for (int j = 0; j < 4; ++j) { const int sj = s - 3 + j; if (sj >= 0) acc += cw[j * DR + c] * bf2f(xr[(size_t)(m - 3 + j) * DR + c]); }
        xc[i] = f2bf(acc);
    }
}
__global__ __launch_bounds__(256) void nv_attn(const bf16_t* __restrict__ qn, const bf16_t* __restrict__ kn, const bf16_t* __restrict__ vv, bf16_t* __restrict__ ob) {
    const int gw = blockIdx.x * 4 + (threadIdx.x >> 6), lane = threadIdx.x & 63;
    const int t = gw & (SEQ - 1), h = (gw >> 12) & 15, b = gw >> 16;
    const size_t rowb = (size_t)b * SEQ;
    const bf16_t* qp = qn + (rowb + t) * DM + h * HD;
    const float q0 = bf2f(qp[lane]), q1 = bf2f(qp[lane + 64]);
    float o0 = 0.f, o1 = 0.f, R = 0.f;
    for (int s = t - 1; s >= 0; --s) {
        const bf16_t* kp = kn + (rowb + s) * DM + h * HD;
        const float z = wave_sum(q0 * bf2f(kp[lane]) + q1 * bf2f(kp[lane + 64]));
        const float sp = softplusf_(z);
        const float w = __builtin_amdgcn_exp2f((z - sp + R) * LOG2E);
        const bf16_t* vp = vv + (rowb + s) * DM + h * HD;
        const float wb = rbf(w);
        o0 += wb * bf2f(vp[lane]); o1 += wb * bf2f(vp[lane + 64]);
        R -= sp;
        if (R < -88.0f) break;
    }
    bf16_t* op = ob + (rowb + t) * DM + h * HD;
    op[lane] = f2bf(o0); op[lane + 64] = f2bf(o1);
}
__global__ __launch_bounds__(192) void nv_rnn(const bf16_t* __restrict__ xc, const bf16_t* __restrict__ gg, const float* __restrict__ wa, const float* __restrict__ ba, const float* __restrict__ wx, const float* __restrict__ bx,
                                              const float* __restrict__ lam, bf16_t* __restrict__ ar) {
    __shared__ float xs[RB];
    const int b = blockIdx.x >> 4, n = blockIdx.x & 15, d = threadIdx.x;
    const bool act = d < RB;
    const int ch = n * RB + (act ? d : 0);
    const float* wap = wa + (size_t)n * RB * RB + (act ? d : 0);
    const float* wxp = wx + (size_t)n * RB * RB + (act ? d : 0);
    const float bav = ba[ch], bxv = bx[ch];
    const float l = lam[ch];
    const float cl = 8.0f * (fmaxf(-l, 0.f) + log1pf(expf(-fabsf(l))));
    float h = 0.f;
    for (int s = 0; s < SEQ; ++s) {
        const size_t m = (size_t)b * SEQ + s;
        __syncthreads();
        if (act) xs[d] = bf2f(xc[m * DR + n * RB + d]);
        __syncthreads();
        float sa = 0.f, sx = 0.f;
        for (int c = 0; c < RB; ++c) { const float xv = xs[c]; sa += xv * rbf(wap[(size_t)c * RB]); sx += xv * rbf(wxp[(size_t)c * RB]); }
        const float r = sigmoidf_(sa + bav), ig = sigmoidf_(sx + bxv);
        const float la = -cl * r;
        const float a = expf(la);
        const float u = sqrtf(-expm1f(2.0f * la)) * (ig * xs[act ? d : 0]);
        h = a * h + u;
        if (act) ar[m * DR + ch] = f2bf(bf2f(gg[m * DR + ch]) * h);
    }
}

#define ONE_LAUNCH 0
#define FASTMASK 2047
namespace pg8 {
#define PG8_LAS __attribute__((address_space(3)))
typedef unsigned short bf16_t;
typedef short bf16x8 __attribute__((ext_vector_type(8)));
typedef float f32x4 __attribute__((ext_vector_type(4)));
typedef unsigned u32x4 __attribute__((ext_vector_type(4)));
constexpr int BM = 256, BK = 64, HALF = 128, HTB = HALF * BK * 2  , STAGE_BYTES = 8 * HTB, NXCD = 8, WGM = 8;

__host__ __device__ __forceinline__ int lds_byte(int r, int c) { const int st = (r >> 4) * 2 + (c >> 5), rr = r & 15, cc = c & 31, ob = rr * 64 + cc * 2; return st * 1024 + (ob ^ (((ob >> 9) & 1) << 5)); }
__host__ __device__ __forceinline__ void stage_rc(int b, int& R, int& C) { const int st = b / 1024, sb = b % 1024, swz = sb ^ (((sb >> 9) & 1) << 5); R = (st >> 1) * 16 + swz / 64; C = (st & 1) * 32 + (swz % 64) / 2; }
__host__ __device__ __forceinline__ int perm32(int rho) { const int n = rho >> 4, i = rho & 15; return 8 * (i >> 2) + 4 * n + (i & 3); }

struct Unit { int pm, pn; };
struct Gemm { const bf16_t* A; const bf16_t* Bt; int M, N, K; };

struct StaticOrder {
    int nM, nN, nwg, G, c;
    __host__ __device__ void init(int M, int N, int G_, int c_) { nM = M / BM; nN = N / BM; nwg = nM * nN; G = G_; c = c_; }
    __host__ __device__ bool next(int i, Unit& u) const {
        const long L = (long)i * G + c; if (L >= nwg) return false;
        int wgid = (int)L; { const int q = nwg / NXCD, r = nwg % NXCD, xcd = wgid % NXCD, off = wgid / NXCD; wgid = (xcd < r ? xcd * (q + 1) : r * (q + 1) + (xcd - r) * q) + off; }
        const int nig = WGM * nN, gid = wgid / nig, fm = gid * WGM, gsz = (nM - fm) < WGM ? (nM - fm) : WGM;
        u.pm = fm + ((wgid % nig) % gsz); u.pn = (wgid % nig) / gsz; return true;
    }
    __device__ __forceinline__ void a_ready(const Unit&) const {}
    __device__ __forceinline__ void done(const Unit&) const {}
};


__device__ __forceinline__ unsigned cvt_pk_bf16(float lo, float hi) { unsigned r; asm volatile("v_cvt_pk_bf16_f32 %0, %1, %2" : "=v"(r) : "v"(lo), "v"(hi)); return r; }
__device__ __forceinline__ float bflo(unsigned w) { return __uint_as_float(w << 16); }
__device__ __forceinline__ float bfhi(unsigned w) { return __uint_as_float(w & 0xffff0000u); }
__device__ __forceinline__ float sig_(float x) { return __builtin_amdgcn_rcpf(1.0f + __builtin_amdgcn_exp2f(-x * 1.4426950408889634f)); }
__device__ __forceinline__ float gelu_t(float x) { const float y = 0.7978845608028654f * (x + 0.044715f * x * x * x); return x * __builtin_amdgcn_rcpf(1.0f + __builtin_amdgcn_exp2f(-2.0f * 1.4426950408889634f * y)); }
__device__ __forceinline__ u32x4 pack8(const f32x4& v0, const f32x4& v1) { u32x4 w; w.x = cvt_pk_bf16(v0[0], v0[1]); w.y = cvt_pk_bf16(v0[2], v0[3]); w.z = cvt_pk_bf16(v1[0], v1[1]); w.w = cvt_pk_bf16(v1[2], v1[3]); return w; }

struct Epi1 {
    static constexpr bool PERM = true, AFTER_DRAIN = false;
    bf16_t *xr, *gg, *qn, *kn, *vv, *sgr, *sga; const float *qgain, *kgain; PG8_LAS float* xch;
    __device__ __forceinline__ void operator()(const f32x4 (&acc)[2][2][4][2], const Unit& u, int wr, int wc, int fr, int fq) const {
        const int pn = u.pn;
        int kind, ld, colt; bf16_t* base;
        if (pn < 11) { kind = 0; base = xr; ld = 2816; colt = pn * 256; }
        else if (pn < 22) { kind = 1; base = gg; ld = 2816; colt = (pn - 11) * 256; }
        else if (pn < 30) { kind = 2; base = qn; ld = 2048; colt = (pn - 22) * 256; }
        else if (pn < 38) { kind = 3; base = kn; ld = 2048; colt = (pn - 30) * 256; }
        else if (pn < 46) { kind = 0; base = vv; ld = 2048; colt = (pn - 38) * 256; }
        else if (pn < 54) { kind = 4; base = sgr; ld = 2048; colt = (pn - 46) * 256; }
        else { kind = 4; base = sga; ld = 2048; colt = (pn - 54) * 256; }
        float rst[2][4][2]; f32x4 gv[2];
#pragma unroll
        for (int ai = 0; ai < 2; ++ai)
#pragma unroll
            for (int m = 0; m < 4; ++m) { rst[ai][m][0] = 1.f; rst[ai][m][1] = 1.f; }
        gv[0] = (f32x4){1.f, 1.f, 1.f, 1.f}; gv[1] = gv[0];
        if (kind == 2 || kind == 3) {
#pragma unroll
            for (int ai = 0; ai < 2; ++ai)
#pragma unroll
                for (int m = 0; m < 4; ++m)
#pragma unroll
                    for (int bj = 0; bj < 2; ++bj) { const f32x4 a = acc[ai][bj][m][0], b = acc[ai][bj][m][1];
                        float s = (a[0] * a[0] + a[1] * a[1]) + (a[2] * a[2] + a[3] * a[3]) + (b[0] * b[0] + b[1] * b[1]) + (b[2] * b[2] + b[3] * b[3]);
                        s += __shfl_xor(s, 16); s += __shfl_xor(s, 32);
                        if (fq == 0) xch[((ai * HALF + wr * 64 + m * 16 + fr) * 2 + bj) * 4 + wc] = s; }
            asm volatile("s_waitcnt lgkmcnt(0)" ::: "memory"); __builtin_amdgcn_s_barrier(); asm volatile("" ::: "memory");
            const float extra = kind == 2 ? 0.08838834764831845f : 1.0f;
#pragma unroll
            for (int ai = 0; ai < 2; ++ai)
#pragma unroll
                for (int m = 0; m < 4; ++m)
#pragma unroll
                    for (int bj = 0; bj < 2; ++bj) { const f32x4 t = *(const PG8_LAS f32x4*)&xch[((ai * HALF + wr * 64 + m * 16 + fr) * 2 + bj) * 4];
                        rst[ai][m][bj] = extra * __builtin_amdgcn_rsqf(((t[0] + t[1]) + (t[2] + t[3])) * (1.0f / 128.0f) + 1e-6f); }
            const float* gp = (kind == 2 ? qgain : kgain) + wc * 32 + 8 * fq; gv[0] = *(const f32x4*)gp; gv[1] = *(const f32x4*)(gp + 4);
        }
        bf16_t* rowp = base + (size_t)(u.pm * BM + wr * 64 + fr) * ld + colt + wc * 32 + 8 * fq;
        const size_t step16 = (size_t)16 * ld;
#pragma unroll
        for (int ai = 0; ai < 2; ++ai) {
#pragma unroll
            for (int m = 0; m < 4; ++m) {
#pragma unroll
                for (int bj = 0; bj < 2; ++bj) { f32x4 v0 = acc[ai][bj][m][0], v1 = acc[ai][bj][m][1];
                    if (kind == 1) {
#pragma unroll
                        for (int j = 0; j < 4; ++j) { v0[j] = gelu_t(v0[j]); v1[j] = gelu_t(v1[j]); } }
                    else if (kind == 4) {
#pragma unroll
                        for (int j = 0; j < 4; ++j) { v0[j] = sig_(v0[j]); v1[j] = sig_(v1[j]); } }
                    else { v0 = v0 * rst[ai][m][bj] * gv[0]; v1 = v1 * rst[ai][m][bj] * gv[1]; }
                    *(u32x4*)(rowp + bj * HALF) = pack8(v0, v1); }
                rowp += step16;
                __builtin_amdgcn_sched_barrier(0); }
            rowp += step16 * 4; }
    }
};
struct EpiMixA {
    static constexpr bool PERM = false, AFTER_DRAIN = false;
    float* F; const bf16_t* G; int ld;
    __device__ __forceinline__ void operator()(const f32x4 (&acc)[2][2][4][2], const Unit& u, int wr, int wc, int fr, int fq) const {
        const int row0 = u.pm * BM + wr * 64 + fr, col0 = u.pn * BM + wc * 32 + 4 * fq;
#pragma unroll
        for (int ai = 0; ai < 2; ++ai)
#pragma unroll
            for (int m = 0; m < 4; ++m) { const size_t off = (size_t)(row0 + ai * HALF + m * 16) * ld + col0;
#pragma unroll
                for (int bj = 0; bj < 2; ++bj)
#pragma unroll
                    for (int n = 0; n < 2; ++n) { const size_t o = off + bj * HALF + n * 16; f32x4 v = acc[ai][bj][m][n];
                        if (G) { const u32x2 g = *(const u32x2*)(G + o); v = v * (f32x4){bflo(g.x), bfhi(g.x), bflo(g.y), bfhi(g.y)}; }
                        *(f32x4*)(F + o) = v; } }
    }
};
struct EpiMixB {
    static constexpr bool PERM = true, AFTER_DRAIN = false;
    bf16_t* O; const float* F; const bf16_t* G; int ld;
    __device__ __forceinline__ void operator()(const f32x4 (&acc)[2][2][4][2], const Unit& u, int wr, int wc, int fr, int fq) const {
        const int row0 = u.pm * BM + wr * 64 + fr, col0 = u.pn * BM + wc * 32 + 8 * fq;
#pragma unroll
        for (int ai = 0; ai < 2; ++ai)
#pragma unroll
            for (int m = 0; m < 4; ++m) { const size_t off = (size_t)(row0 + ai * HALF + m * 16) * ld + col0;
#pragma unroll
                for (int bj = 0; bj < 2; ++bj) { const size_t o = off + bj * HALF;
                    const f32x4 f0 = *(const f32x4*)(F + o), f1 = *(const f32x4*)(F + o + 4); const u32x4 g = *(const u32x4*)(G + o);
                    const f32x4 v0 = f0 + acc[ai][bj][m][0] * (f32x4){bflo(g.x), bfhi(g.x), bflo(g.y), bfhi(g.y)};
                    const f32x4 v1 = f1 + acc[ai][bj][m][1] * (f32x4){bflo(g.z), bfhi(g.z), bflo(g.w), bfhi(g.w)};
                    *(u32x4*)(O + o) = pack8(v0, v1); } }
    }
};
struct EpiRes {
    static constexpr bool PERM = false, AFTER_DRAIN = false;
    const float* X; float* Fout; bf16_t* O; float* ssq; int ld;
    __device__ __forceinline__ void operator()(const f32x4 (&acc)[2][2][4][2], const Unit& u, int wr, int wc, int fr, int fq) const {
        const int row0 = u.pm * BM + wr * 64 + fr, col0 = u.pn * BM + wc * 32 + 4 * fq;
#pragma unroll
        for (int ai = 0; ai < 2; ++ai)
#pragma unroll
            for (int m = 0; m < 4; ++m) { const int row = row0 + ai * HALF + m * 16; const size_t off = (size_t)row * ld + col0; float s = 0.f;
#pragma unroll
                for (int bj = 0; bj < 2; ++bj)
#pragma unroll
                    for (int n = 0; n < 2; ++n) { const size_t o = off + bj * HALF + n * 16; const f32x4 v = *(const f32x4*)(X + o) + acc[ai][bj][m][n];
                        *(f32x4*)(Fout + o) = v; u32x2 w; w.x = cvt_pk_bf16(v[0], v[1]); w.y = cvt_pk_bf16(v[2], v[3]); *(u32x2*)(O + o) = w;
                        s += (v[0] * v[0] + v[1] * v[1]) + (v[2] * v[2] + v[3] * v[3]); }
                s += __shfl_xor(s, 16); s += __shfl_xor(s, 32);
                if (fq == 0) unsafeAtomicAdd(ssq + row, s); }
    }
};
struct EpiFfn {
    static constexpr bool PERM = true, AFTER_DRAIN = false;
    bf16_t* O; const float* ssq; int ldo;
    __device__ __forceinline__ void operator()(const f32x4 (&acc)[2][2][4][2], const Unit& u, int wr, int wc, int fr, int fq) const {
        const int row0 = u.pm * BM + wr * 64 + fr, col0 = u.pn * HALF + wc * 32 + 8 * fq;
#pragma unroll
        for (int ai = 0; ai < 2; ++ai)
#pragma unroll
            for (int m = 0; m < 4; ++m) { const int row = row0 + ai * HALF + m * 16; const float rs = __builtin_amdgcn_rsqf(ssq[row] * (1.0f / 2048.0f) + 1e-6f);
                f32x4 v[2];
#pragma unroll
                for (int n = 0; n < 2; ++n)
#pragma unroll
                    for (int j = 0; j < 4; ++j) { const float g = rs * acc[ai][0][m][n][j], uu = rs * acc[ai][1][m][n][j]; v[n][j] = g * sig_(g) * uu; }
                *(u32x4*)(O + (size_t)row * ldo + col0) = pack8(v[0], v[1]); }
    }
};
struct EpiPle {
    static constexpr bool PERM = false, AFTER_DRAIN = false;
    const float* X; const float* P; float* out; const float* ssq; int ld;
    __device__ __forceinline__ void operator()(const f32x4 (&acc)[2][2][4][2], const Unit& u, int wr, int wc, int fr, int fq) const {
        const int row0 = u.pm * BM + wr * 64 + fr, col0 = u.pn * BM + wc * 32 + 4 * fq;
#pragma unroll
        for (int ai = 0; ai < 2; ++ai)
#pragma unroll
            for (int m = 0; m < 4; ++m) { const int row = row0 + ai * HALF + m * 16; const size_t off = (size_t)row * ld + col0; const float rs = __builtin_amdgcn_rsqf(ssq[row] * (1.0f / 2048.0f) + 1e-6f);
#pragma unroll
                for (int bj = 0; bj < 2; ++bj)
#pragma unroll
                    for (int n = 0; n < 2; ++n) { const size_t o = off + bj * HALF + n * 16; const f32x4 xv = *(const f32x4*)(X + o), pv = *(const f32x4*)(P + o); f32x4 r;
#pragma unroll
                        for (int j = 0; j < 4; ++j) r[j] = xv[j] + sig_(rs * acc[ai][bj][m][n][j]) * pv[j];
                        *(f32x4*)(out + o) = r; } }
    }
};
template <class Epi, class Sched, bool ALIGN_EPI = false, bool SP2 = false>
__device__ __forceinline__ void gemm_phase(PG8_LAS unsigned char* lds, const Gemm g, const Sched& S, const Epi& E) {
    const int tid = threadIdx.x, wid = __builtin_amdgcn_readfirstlane(tid >> 6), lane = tid & 63, wr = wid >> 2, wc = wid & 3, fr = lane & 15, fq = lane >> 4;
    const int K = g.K, nt = K / BK;
    unsigned voffA[2], voffB[2];
#pragma unroll
    for (int i = 0; i < 2; ++i) { int R, C; stage_rc(tid * 16 + i * 8192, R, C); const int Rb = Epi::PERM ? ((R & ~31) + perm32(R & 31)) : R;
        voffA[i] = (unsigned)(R * K + C) * 2u; voffB[i] = (unsigned)(Rb * K + C) * 2u; }
    const size_t kstep = (size_t)(BK * 2);
    const size_t hstep = (size_t)HALF * K * 2;
    const size_t tstep = 2 * hstep;
    const unsigned ldsw = (unsigned)wid * 1024u;
    const int aoff = lds_byte(wr * 64 + fr, fq * 8), boff = lds_byte(wc * 32 + fr, fq * 8);
#define PG8_SA(b, h) (((b) * 2 + (h)) * HTB)
#define PG8_SB(b, h) ((4 + (b) * 2 + (h)) * HTB)
#define PG8_STAGE(bufoff, gbase, voff) do { _Pragma("unroll") for (int _i = 0; _i < 2; ++_i) \
        __builtin_amdgcn_global_load_lds((const unsigned*)((const char*)(gbase) + (voff)[_i]), (PG8_LAS unsigned*)(lds + (bufoff) + ldsw + _i * 8192), 16, 0, 0); } while (0)
#define PG8_LDA(dst, b, h) do { _Pragma("unroll") for (int m = 0; m < 4; ++m) _Pragma("unroll") for (int k = 0; k < 2; ++k) dst[m][k] = *(const PG8_LAS bf16x8*)(lds + PG8_SA(b, h) + aoff + m * 2048 + k * 1024); } while (0)
#define PG8_LDB(dst, b, h) do { _Pragma("unroll") for (int n = 0; n < 2; ++n) _Pragma("unroll") for (int k = 0; k < 2; ++k) dst[n][k] = *(const PG8_LAS bf16x8*)(lds + PG8_SB(b, h) + boff + n * 2048 + k * 1024); } while (0)
#define PG8_MMA(ai, bj, At, Bt) do { __builtin_amdgcn_s_setprio(1); _Pragma("unroll") for (int m = 0; m < 4; ++m) _Pragma("unroll") for (int n = 0; n < 2; ++n) _Pragma("unroll") for (int k = 0; k < 2; ++k) \
        acc[ai][bj][m][n] = __builtin_amdgcn_mfma_f32_16x16x32_bf16(Bt[n][k], At[m][k], acc[ai][bj][m][n], 0, 0, 0); __builtin_amdgcn_s_setprio(0); } while (0)
#define PG8_WAIT_V(n) asm volatile("s_waitcnt vmcnt(" #n ")" ::: "memory")
#define PG8_WAIT_L(n) asm volatile("s_waitcnt lgkmcnt(" #n ")" ::: "memory")
#define PG8_BAR __builtin_amdgcn_s_barrier()
#define PG8_SCHED __builtin_amdgcn_sched_barrier(0)
    Unit cur, nxt; int ui = 0;
    if (!S.next(0, cur)) return;
    f32x4 acc[2][2][4][2];
#pragma unroll
    for (int a = 0; a < 2; ++a)
#pragma unroll
        for (int b = 0; b < 2; ++b)
#pragma unroll
            for (int m = 0; m < 4; ++m)
#pragma unroll
                for (int n = 0; n < 2; ++n) acc[a][b][m][n] = (f32x4){0.f, 0.f, 0.f, 0.f};
    bf16x8 At[4][2], B0[2][2], B1[2][2];
    const char* cA = (const char*)g.A + (size_t)cur.pm * tstep; const char* cB = (const char*)g.Bt + (size_t)cur.pn * tstep;
    S.a_ready(cur);
    if constexpr (SP2) {
        PG8_STAGE(PG8_SB(0, 0), cB, voffB); PG8_STAGE(PG8_SB(0, 1), cB + hstep, voffB); PG8_STAGE(PG8_SA(0, 0), cA, voffA); PG8_STAGE(PG8_SA(0, 1), cA + hstep, voffA);
        if (wr == 1) PG8_BAR;
        PG8_WAIT_V(2); PG8_BAR;
        PG8_STAGE(PG8_SB(1, 0), cB + kstep, voffB); PG8_STAGE(PG8_SA(1, 0), cA + kstep, voffA); PG8_STAGE(PG8_SB(1, 1), cB + hstep + kstep, voffB);
        PG8_WAIT_V(6); PG8_BAR;
    } else {
        PG8_STAGE(PG8_SB(0, 0), cB, voffB); PG8_STAGE(PG8_SA(0, 0), cA, voffA); PG8_STAGE(PG8_SB(0, 1), cB + hstep, voffB); PG8_STAGE(PG8_SA(0, 1), cA + hstep, voffA);
        if (wr == 1) PG8_BAR;
        PG8_WAIT_V(4); PG8_BAR;
        PG8_STAGE(PG8_SB(1, 0), cB + kstep, voffB); PG8_STAGE(PG8_SA(1, 0), cA + kstep, voffA); PG8_STAGE(PG8_SB(1, 1), cB + hstep + kstep, voffB);
        PG8_WAIT_V(6); PG8_BAR;
    }
    for (;;) {
        const bool has_next = S.next(ui + 1, nxt);
        const char* nA = has_next ? (const char*)g.A + (size_t)nxt.pm * tstep : cA; const char* nB = has_next ? (const char*)g.Bt + (size_t)nxt.pn * tstep : cB;
        for (int t = 0; t < nt; t += 2) {
            const bool last = (t == nt - 2);
            const char* a1 = cA + (size_t)(t + 1) * kstep;
            const char* a2 = last ? nA : cA + (size_t)(t + 2) * kstep; const char* b2 = last ? nB : cB + (size_t)(t + 2) * kstep;
            const char* a3 = a2 + kstep; const char* b3 = b2 + kstep;
            if (last && has_next) S.a_ready(nxt);
            if constexpr (SP2) {
            PG8_LDB(B0, 0, 0); PG8_LDB(B1, 0, 1); PG8_SCHED; PG8_LDA(At, 0, 0); PG8_STAGE(PG8_SA(1, 1), a1 + hstep, voffA);
            PG8_WAIT_V(8); PG8_WAIT_L(0); PG8_BAR; PG8_MMA(0, 0, At, B0); PG8_MMA(0, 1, At, B1); PG8_BAR; PG8_SCHED;
            PG8_LDA(At, 0, 1); PG8_STAGE(PG8_SB(0, 0), b2, voffB); PG8_STAGE(PG8_SB(0, 1), b2 + hstep, voffB); PG8_STAGE(PG8_SA(0, 0), a2, voffA);
            PG8_WAIT_V(8); PG8_WAIT_L(0); PG8_BAR; PG8_MMA(1, 0, At, B0); PG8_MMA(1, 1, At, B1); PG8_BAR; PG8_SCHED;
            PG8_LDB(B0, 1, 0); PG8_LDB(B1, 1, 1); PG8_SCHED; PG8_LDA(At, 1, 0); PG8_STAGE(PG8_SA(0, 1), a2 + hstep, voffA);
            PG8_WAIT_V(8); PG8_WAIT_L(0); PG8_BAR; PG8_MMA(0, 0, At, B0); PG8_MMA(0, 1, At, B1); PG8_BAR; PG8_SCHED;
            PG8_LDA(At, 1, 1); PG8_STAGE(PG8_SB(1, 0), b3, voffB); PG8_STAGE(PG8_SB(1, 1), b3 + hstep, voffB); PG8_STAGE(PG8_SA(1, 0), a3, voffA);
            PG8_WAIT_V(8); PG8_WAIT_L(0); PG8_BAR; PG8_MMA(1, 0, At, B0); PG8_MMA(1, 1, At, B1); PG8_BAR; PG8_SCHED;
            } else {
            PG8_LDB(B0, 0, 0); PG8_SCHED; PG8_LDA(At, 0, 0); PG8_STAGE(PG8_SA(1, 1), a1 + hstep, voffA);
            PG8_WAIT_L(8); PG8_BAR; PG8_WAIT_L(0); PG8_MMA(0, 0, At, B0); PG8_BAR; PG8_SCHED;
            PG8_LDB(B1, 0, 1); PG8_STAGE(PG8_SB(0, 0), b2, voffB);
            PG8_BAR; PG8_WAIT_L(0); PG8_MMA(0, 1, At, B1); PG8_BAR;
            PG8_LDA(At, 0, 1); PG8_STAGE(PG8_SA(0, 0), a2, voffA);
            PG8_BAR; PG8_WAIT_L(0); PG8_MMA(1, 0, At, B0); PG8_BAR; PG8_SCHED;
            PG8_STAGE(PG8_SB(0, 1), b2 + hstep, voffB);
            PG8_WAIT_V(6); PG8_BAR; PG8_MMA(1, 1, At, B1); PG8_BAR;
            PG8_LDB(B0, 1, 0); PG8_SCHED; PG8_LDA(At, 1, 0); PG8_STAGE(PG8_SA(0, 1), a2 + hstep, voffA);
            PG8_WAIT_L(8); PG8_BAR; PG8_WAIT_L(0); PG8_MMA(0, 0, At, B0); PG8_BAR; PG8_SCHED;
            PG8_LDB(B1, 1, 1); PG8_STAGE(PG8_SB(1, 0), b3, voffB);
            PG8_BAR; PG8_WAIT_L(0); PG8_MMA(0, 1, At, B1); PG8_BAR;
            PG8_LDA(At, 1, 1); PG8_STAGE(PG8_SA(1, 0), a3, voffA);
            PG8_BAR; PG8_WAIT_L(0); PG8_MMA(1, 0, At, B0); PG8_BAR; PG8_SCHED;
            PG8_STAGE(PG8_SB(1, 1), b3 + hstep, voffB);
            PG8_WAIT_V(6); PG8_BAR; PG8_MMA(1, 1, At, B1); PG8_BAR;
            }
        }
        if constexpr (ALIGN_EPI) { if (wr == 0) PG8_BAR; }
        if constexpr (!Epi::AFTER_DRAIN) { E(acc, cur, wr, wc, fr, fq); S.done(cur); }
        if (!has_next) break;
#pragma unroll
        for (int a = 0; a < 2; ++a)
#pragma unroll
            for (int b = 0; b < 2; ++b)
#pragma unroll
                for (int m = 0; m < 4; ++m)
#pragma unroll
                    for (int n = 0; n < 2; ++n) acc[a][b][m][n] = (f32x4){0.f, 0.f, 0.f, 0.f};
        cur = nxt; cA = nA; cB = nB; ++ui;
        if constexpr (ALIGN_EPI) { if (wr == 1) PG8_BAR; }
    }
    PG8_WAIT_V(0);
    if constexpr (!ALIGN_EPI) { if (wr == 0) PG8_BAR; }
    PG8_BAR;
    if constexpr (Epi::AFTER_DRAIN) { E.fused(acc, cur, wr, wc, fr, fq, lds, wid, lane); S.done(cur); }
#undef PG8_SA
#undef PG8_SB
#undef PG8_STAGE
#undef PG8_LDA
#undef PG8_LDB
#undef PG8_MMA
#undef PG8_WAIT_V
#undef PG8_WAIT_L
#undef PG8_BAR
#undef PG8_SCHED
}
}

#ifndef ONLYP
#define ONLYP -1
#endif
constexpr int ONLY = ONLYP;
#define PHON(k) (ONLY < 0 || ONLY == (k))
constexpr int NWAVES = 8, NTHREADS = NWAVES * 64;
constexpr int RING_BYTES = 131072, XCH_OFF = RING_BYTES, XCH_BYTES = 8192, LDS_BYTES = 147456;
static_assert(XCH_OFF + XCH_BYTES <= LDS_BYTES, "LDS map");
constexpr int VST_PITCH = 320, VST_BYTES = 32 * VST_PITCH;
static_assert(NWAVES * VST_BYTES <= RING_BYTES, "attention scratch");

enum { F_P0 = 1, F_G1 = 2, F_CONV = 4, F_ATTN = 8, F_RNN = 16, F_YA = 32, F_YR = 64, F_WO = 128, F_FFU = 256, F_FFD = 512, F_PLE = 1024, F_ALL = 2047 };

struct Args {
    const float *x, *p, *g_mix, *w_in, *conv_w, *conv_b, *w_rg_a, *b_rg_a, *w_rg_x, *b_rg_x, *lam, *q_gain, *k_gain, *w_rnn_out, *w_attn_out, *w_o, *g_ffn, *w_gu, *w_dn, *g_ple, *w_pg, *w_pp;
    float* out; unsigned char* ws; int ph_lo, ph_hi, mask, pad;
};

__device__ __forceinline__ int crow(int reg, int h) { return (reg & 3) + 8 * (reg >> 2) + 4 * h; }
#define MFMA32(a, b, c) __builtin_amdgcn_mfma_f32_32x32x16_bf16((a), (b), (c), 0, 0, 0)
__device__ __forceinline__ unsigned pk2(float lo, float hi) { return (unsigned)f2bf(lo) | ((unsigned)f2bf(hi) << 16); }

__device__ __forceinline__ void p0_transpose_item(const float* __restrict__ W, int ldw, int Kdim, bf16_t* __restrict__ WT, int orow0, const float* __restrict__ ks, LAS float* scr, int k0, int n0, int lane) {
#pragma unroll 8
    for (int i = 0; i < 32; ++i) { const int kk = 2 * i + (lane >> 5); float v = W[(size_t)(k0 + kk) * ldw + n0 + (lane & 31)]; if (ks) v *= ks[k0 + kk]; scr[kk * 33 + (lane & 31)] = v; }
    asm volatile("s_waitcnt lgkmcnt(0)" ::: "memory");
    const int c = lane & 7;
#pragma unroll
    for (int j = 0; j < 4; ++j) { const int n = (lane >> 3) + 8 * j; const LAS float* s = scr + (8 * c) * 33 + n;
        u32x4 o; o.x = pk2(s[0 * 33], s[1 * 33]); o.y = pk2(s[2 * 33], s[3 * 33]); o.z = pk2(s[4 * 33], s[5 * 33]); o.w = pk2(s[6 * 33], s[7 * 33]);
        *(u32x4*)(WT + (size_t)(orow0 + n) * Kdim + k0 + 8 * c) = o; }
    asm volatile("s_waitcnt lgkmcnt(0)" ::: "memory");
}
__device__ __forceinline__ void p0_prologue(const Args& a, LAS unsigned char* lds, int gw, int ngw, int lane, int gtid, int ngt) {
    unsigned char* ws = a.ws;
    LAS float* scr = (LAS float*)(lds + (threadIdx.x >> 6) * 16384);
    constexpr int I1 = (DM / 64) * (DIN / 32), I2 = (DR / 64) * (DM / 32), I3 = (DM / 64) * (DM / 32), I5 = (DM / 64) * (2 * DFF / 32), I6 = (DFF / 64) * (DM / 32), I8 = (PLE / 64) * (DM / 32);
    constexpr int NIT = I1 + I2 + I3 + I3 + I5 + I6 + I3 + I8;
    for (int it = gw; it < NIT; it += ngw) {
        int r = it;
        if (r < I1) { const int nb = DIN / 32; p0_transpose_item(a.w_in, DIN, DM, (bf16_t*)(ws + WS_W1), 32 * (r % nb), nullptr, scr, 64 * (r / nb), 32 * (r % nb), lane); continue; } r -= I1;
        if (r < I2) { const int nb = DM / 32; p0_transpose_item(a.w_rnn_out, DM, DR, (bf16_t*)(ws + WS_WRO), 32 * (r % nb), nullptr, scr, 64 * (r / nb), 32 * (r % nb), lane); continue; } r -= I2;
        if (r < I3) { const int nb = DM / 32; p0_transpose_item(a.w_attn_out, DM, DM, (bf16_t*)(ws + WS_WAO), 32 * (r % nb), nullptr, scr, 64 * (r / nb), 32 * (r % nb), lane); continue; } r -= I3;
        if (r < I3) { const int nb = DM / 32; p0_transpose_item(a.w_o, DM, DM, (bf16_t*)(ws + WS_WO), 32 * (r % nb), nullptr, scr, 64 * (r / nb), 32 * (r % nb), lane); continue; } r -= I3;
        if (r < I5) { const int nb = 2 * DFF / 32; const int n0 = 32 * (r % nb); const int isu = n0 >= DFF ? 1 : 0; const int j0 = n0 - isu * DFF; const int orow = (j0 >> 7) * 256 + isu * 128 + (j0 & 127);
                      p0_transpose_item(a.w_gu, 2 * DFF, DM, (bf16_t*)(ws + WS_WGU), orow, a.g_ffn, scr, 64 * (r / nb), n0, lane); continue; } r -= I5;
        if (r < I6) { const int nb = DM / 32; p0_transpose_item(a.w_dn, DM, DFF, (bf16_t*)(ws + WS_WDN), 32 * (r % nb), nullptr, scr, 64 * (r / nb), 32 * (r % nb), lane); continue; } r -= I6;
        if (r < I3) { const int nb = DM / 32; p0_transpose_item(a.w_pg, DM, DM, (bf16_t*)(ws + WS_WPG), 32 * (r % nb), a.g_ple, scr, 64 * (r / nb), 32 * (r % nb), lane); continue; } r -= I3;
        { const int nb = DM / 32; p0_transpose_item(a.w_pp, DM, PLE, (bf16_t*)(ws + WS_WPP), 32 * (r % nb), nullptr, scr, 64 * (r / nb), 32 * (r % nb), lane); }
    }
    bf16_t* hb = (bf16_t*)(ws + WS_HB);
    for (int m = gw; m < M; m += ngw) {
        const f32x4* xr = (const f32x4*)(a.x + (size_t)m * DM) + lane; const f32x4* gr = (const f32x4*)a.g_mix + lane;
        f32x4 v[8]; float s = 0.f;
#pragma unroll
        for (int j = 0; j < 8; ++j) { v[j] = xr[64 * j]; s += (v[j][0] * v[j][0] + v[j][1] * v[j][1]) + (v[j][2] * v[j][2] + v[j][3] * v[j][3]); }
        const float rs = 1.0f / sqrtf(wave_sum(s) * (1.0f / DM) + EPS);
        u32x2* o8 = (u32x2*)(hb + (size_t)m * DM) + lane;
#pragma unroll
        for (int j = 0; j < 8; ++j) { const f32x4 g = gr[64 * j]; u32x2 w; w.x = pk2(v[j][0] * rs * g[0], v[j][1] * rs * g[1]); w.y = pk2(v[j][2] * rs * g[2], v[j][3] * rs * g[3]); o8[64 * j] = w; }
    }
    { const f32x4* pp = (const f32x4*)a.p; u32x2* po = (u32x2*)(ws + WS_PB);
      for (int i = gtid; i < M * PLE / 4; i += ngt) { const f32x4 v = pp[i]; u32x2 w; w.x = pk2(v[0], v[1]); w.y = pk2(v[2], v[3]); po[i] = w; } }
    { bf16_t* wra = (bf16_t*)(ws + WS_WRA); bf16_t* wrx = (bf16_t*)(ws + WS_WRX);
      for (int i = gtid; i < NRB * RB * RBP; i += ngt) { const int c = i % RBP, d = (i / RBP) % RB, n = i / (RBP * RB);
          const size_t src = ((size_t)n * RB + (c < RB ? c : 0)) * RB + d;
          wra[i] = c < RB ? f2bf(a.w_rg_a[src]) : (bf16_t)0; wrx[i] = c < RB ? f2bf(a.w_rg_x[src]) : (bf16_t)0; } }
    { float* z = (float*)(ws + WS_SMALL); for (int i = gtid; i < 2 * M; i += ngt) z[i] = 0.f; }
}

__device__ __forceinline__ void conv_phase(const Args& a, int gtid, int ngt) {
    const bf16_t* xr = (const bf16_t*)(a.ws + WS_XR); bf16_t* xc = (bf16_t*)(a.ws + WS_XC);
    constexpr int NCG = DR / 8;
    for (int it = gtid; it < (M / 8) * NCG; it += ngt) {
        const int cg = it % NCG, rg = it / NCG, c0 = cg * 8, m0 = rg * 8;
        f32x4 w[4][2]; f32x4 bb[2];
#pragma unroll
        for (int j = 0; j < 4; ++j) { w[j][0] = *(const f32x4*)(a.conv_w + (size_t)j * DR + c0); w[j][1] = *(const f32x4*)(a.conv_w + (size_t)j * DR + c0 + 4); }
        bb[0] = *(const f32x4*)(a.conv_b + c0); bb[1] = *(const f32x4*)(a.conv_b + c0 + 4);
        f32x4 win[3][2];
        const bool first = (m0 & (SEQ - 1)) == 0;
#pragma unroll
        for (int j = 0; j < 3; ++j) {
            if (first) { win[j][0] = (f32x4){0.f, 0.f, 0.f, 0.f}; win[j][1] = win[j][0]; }
            else { const u32x4 t = *(const u32x4*)(xr + (size_t)(m0 - 3 + j) * DR + c0); win[j][0] = (f32x4){pg8::bflo(t.x), pg8::bfhi(t.x), pg8::bflo(t.y), pg8::bfhi(t.y)}; win[j][1] = (f32x4){pg8::bflo(t.z), pg8::bfhi(t.z), pg8::bflo(t.w), pg8::bfhi(t.w)}; } }
#pragma unroll
        for (int i = 0; i < 8; ++i) {
            const u32x4 t = *(const u32x4*)(xr + (size_t)(m0 + i) * DR + c0);
            const f32x4 c0v = (f32x4){pg8::bflo(t.x), pg8::bfhi(t.x), pg8::bflo(t.y), pg8::bfhi(t.y)}, c1v = (f32x4){pg8::bflo(t.z), pg8::bfhi(t.z), pg8::bflo(t.w), pg8::bfhi(t.w)};
            const f32x4 y0 = bb[0] + w[0][0] * win[0][0] + w[1][0] * win[1][0] + w[2][0] * win[2][0] + w[3][0] * c0v;
            const f32x4 y1 = bb[1] + w[0][1] * win[0][1] + w[1][1] * win[1][1] + w[2][1] * win[2][1] + w[3][1] * c1v;
            *(u32x4*)(xc + (size_t)(m0 + i) * DR + c0) = pg8::pack8(y0, y1);
            win[0][0] = win[1][0]; win[0][1] = win[1][1]; win[1][0] = win[2][0]; win[1][1] = win[2][1]; win[2][0] = c0v; win[2][1] = c1v;
        }
    }
}

typedef short v4i16_t __attribute__((ext_vector_type(4)));
__device__ __forceinline__ s16x4 vtr(const LAS unsigned char* p) { return __builtin_bit_cast(s16x4, __builtin_amdgcn_ds_read_tr16_b64_v4i16((LAS v4i16_t*)p)); }
__device__ __forceinline__ void attn_unit(int b, int hh, int qb, const bf16_t* __restrict__ qn, const bf16_t* __restrict__ kn, const bf16_t* __restrict__ vv, bf16_t* __restrict__ ob, LAS unsigned char* vst, int lane) {
    const int r = lane & 31, h = lane >> 5;
    const size_t rowb = (size_t)b * SEQ;
    const int q0 = qb * 32;
    bf16x8 qf[8];
    { const bf16_t* qp = qn + (rowb + q0 + r) * DM + hh * HD + 8 * h;
#pragma unroll
      for (int ks = 0; ks < 8; ++ks) qf[ks] = *(const bf16x8*)(qp + 16 * ks); }
    f32x16 o[4];
#pragma unroll
    for (int d = 0; d < 4; ++d)
#pragma unroll
        for (int i = 0; i < 16; ++i) o[d][i] = 0.f;
    float R = 0.f;
    const int vrow = lane >> 4, vch = lane & 15;
    const int i16 = lane & 15, tq = i16 >> 2, tp = i16 & 3, blk = (lane >> 4) & 1;
    const LAS unsigned char* trb = vst + (4 * h + tq) * VST_PITCH + (16 * blk + 4 * tp) * 2;
    for (int kb = qb; kb >= 0; --kb) {
        const int k0 = kb * 32;
        bf16x8 kf[8];
        { const bf16_t* kp = kn + (rowb + k0 + r) * DM + hh * HD + 8 * h;
#pragma unroll
          for (int ks = 0; ks < 8; ++ks) kf[ks] = *(const bf16x8*)(kp + 16 * ks); }
        u32x4 vt[8];
        { const bf16_t* vp = vv + (rowb + k0 + vrow) * DM + hh * HD + 8 * vch;
#pragma unroll
          for (int i = 0; i < 8; ++i) vt[i] = *(const u32x4*)(vp + (size_t)(4 * i) * DM); }
#pragma unroll
        for (int i = 0; i < 8; ++i) *(LAS u32x4*)(vst + (vrow + 4 * i) * VST_PITCH + 16 * vch) = vt[i];
        f32x16 x;
#pragma unroll
        for (int i = 0; i < 16; ++i) x[i] = 0.f;
#pragma unroll
        for (int ks = 0; ks < 8; ++ks) x = MFMA32(kf[ks], qf[ks], x);
        const bool diag = (kb == qb);
        float lk[16], zz[16];
#pragma unroll
        for (int i = 0; i < 16; ++i) { const float z = x[i]; const bool valid = !diag || crow(i, h) < r; lk[i] = valid ? -softplusf_(z) : 0.f; zz[i] = valid ? z : -1e30f; }
        float I[16], T[4], To[4];
#pragma unroll
        for (int g = 0; g < 4; ++g) { I[4 * g + 3] = lk[4 * g + 3]; I[4 * g + 2] = I[4 * g + 3] + lk[4 * g + 2]; I[4 * g + 1] = I[4 * g + 2] + lk[4 * g + 1]; I[4 * g] = I[4 * g + 1] + lk[4 * g]; T[g] = I[4 * g]; }
#pragma unroll
        for (int g = 0; g < 4; ++g) To[g] = __shfl_xor(T[g], 32);
        const float U0 = T[0] + To[0], U1 = T[1] + To[1], U2 = T[2] + To[2], U3 = T[3] + To[3];
        float C[4]; C[3] = 0.f; C[2] = U3; C[1] = U3 + U2; C[0] = C[1] + U1;
        const float tot = C[0] + U0;
        float w[16];
#pragma unroll
        for (int g = 0; g < 4; ++g) { const float off = C[g] + (h == 0 ? To[g] : 0.f) + R;
#pragma unroll
            for (int j = 0; j < 4; ++j) w[4 * g + j] = __builtin_amdgcn_exp2f((zz[4 * g + j] + I[4 * g + j] + off) * LOG2E); }
        R += tot;
        bf16x8 xs[2];
#pragma unroll
        for (int s = 0; s < 2; ++s) { u32x4 pw; pw.x = pk2(w[8 * s], w[8 * s + 1]); pw.y = pk2(w[8 * s + 2], w[8 * s + 3]); pw.z = pk2(w[8 * s + 4], w[8 * s + 5]); pw.w = pk2(w[8 * s + 6], w[8 * s + 7]); xs[s] = __builtin_bit_cast(bf16x8, pw); }
#pragma unroll
        for (int db = 0; db < 4; ++db)
#pragma unroll
            for (int s = 0; s < 2; ++s) {
                const s16x4 lo = vtr(trb + (16 * s) * VST_PITCH + db * 64), hi = vtr(trb + (16 * s + 8) * VST_PITCH + db * 64);
                const bf16x8 vf = __builtin_shufflevector(lo, hi, 0, 1, 2, 3, 4, 5, 6, 7);
                o[db] = MFMA32(vf, xs[s], o[db]);
            }
        if (__all(R < -88.0f)) break;
    }
    bf16_t* op = ob + (rowb + q0 + r) * DM + hh * HD + 4 * h;
#pragma unroll
    for (int db = 0; db < 4; ++db)
#pragma unroll
        for (int g = 0; g < 4; ++g) { u32x2 wv; wv.x = pk2(o[db][4 * g], o[db][4 * g + 1]); wv.y = pk2(o[db][4 * g + 2], o[db][4 * g + 3]); *(u32x2*)(op + 32 * db + 8 * g) = wv; }
}

template <bool PASSB>
__device__ __forceinline__ void rnn_unit(int b, int n, int ct, int c, const Args& a, int lane) {
    const bf16_t* xc = (const bf16_t*)(a.ws + WS_XC); const bf16_t* gg = (const bf16_t*)(a.ws + WS_GG); bf16_t* ar = (bf16_t*)(a.ws + WS_AR);
    const bf16_t* wra = (const bf16_t*)(a.ws + WS_WRA); const bf16_t* wrx = (const bf16_t*)(a.ws + WS_WRX); float* summ = (float*)(a.ws + WS_SMALL + SM_SUMM);
    const int r = lane & 31, h = lane >> 5;
    const int chl = ct * 32 + r; const bool chv = chl < RB; const int chc = chv ? chl : RB - 1; const int ch = n * RB + chc;
    bf16x8 wa[11], wx[11];
    { const bf16_t* pa = wra + (size_t)(n * RB + chc) * RBP + 8 * h; const bf16_t* px = wrx + (size_t)(n * RB + chc) * RBP + 8 * h;
#pragma unroll
      for (int ks = 0; ks < 11; ++ks) { wa[ks] = *(const bf16x8*)(pa + 16 * ks); wx[ks] = *(const bf16x8*)(px + 16 * ks); } }
    const float bav = a.b_rg_a[ch], bxv = a.b_rg_x[ch]; const float l = a.lam[ch];
    const float cl = 8.0f * (fmaxf(-l, 0.f) + log1pf(expf(-fabsf(l))));
    float hc = 0.f, Pc = 1.f;
    if (PASSB) { for (int cp = 0; cp < c; ++cp) { const float* sp = summ + ((size_t)(b * NCHUNK + cp) * DR + ch) * 2; hc = sp[0] * hc + sp[1]; } }
    for (int tt = 0; tt < 4; ++tt) {
        const size_t m0 = (size_t)b * SEQ + c * CHUNK + tt * 32;
        f32x16 aa, ax;
#pragma unroll
        for (int i = 0; i < 16; ++i) { aa[i] = 0.f; ax[i] = 0.f; }
        { const bf16_t* ap = xc + (m0 + r) * DR + n * RB + 8 * h;
#pragma unroll
          for (int ks = 0; ks < 11; ++ks) { const bf16x8 af = *(const bf16x8*)(ap + 16 * ks); aa = MFMA32(af, wa[ks], aa); ax = MFMA32(af, wx[ks], ax); } }
        float av[16], uv[16];
#pragma unroll
        for (int i = 0; i < 16; ++i) { const size_t tok = m0 + crow(i, h); const float xv = bf2f(xc[tok * DR + ch]);
            const float rg = sigmoidf_(aa[i] + bav), ig = sigmoidf_(ax[i] + bxv); const float la = -cl * rg; av[i] = __builtin_amdgcn_exp2f(la * LOG2E);
            const float t2 = 2.0f * la;
            const float om = t2 > -0.3f ? -t2 * (1.0f + t2 * (0.5f + t2 * (0.16666667f + t2 * (0.041666667f + t2 * 0.0083333333f)))) : 1.0f - __builtin_amdgcn_exp2f(t2 * LOG2E);
            uv[i] = sqrtf(om) * (ig * xv); }
        float pc[16], hl[16], Pg[4], Hg[4], Pgo[4], Hgo[4];
#pragma unroll
        for (int g = 0; g < 4; ++g) { float P = 1.f, H = 0.f;
#pragma unroll
            for (int j = 0; j < 4; ++j) { H = av[4 * g + j] * H + uv[4 * g + j]; P = P * av[4 * g + j]; pc[4 * g + j] = P; hl[4 * g + j] = H; }
            Pg[g] = P; Hg[g] = H; }
#pragma unroll
        for (int g = 0; g < 4; ++g) { Pgo[g] = __shfl_xor(Pg[g], 32); Hgo[g] = __shfl_xor(Hg[g], 32); }
        float cur = hc, cin[4];
#pragma unroll
        for (int g = 0; g < 4; ++g) { const float P0 = h == 0 ? Pg[g] : Pgo[g], H0 = h == 0 ? Hg[g] : Hgo[g], P1 = h == 0 ? Pgo[g] : Pg[g], H1 = h == 0 ? Hgo[g] : Hg[g];
            const float c0 = cur; cur = P0 * cur + H0; const float c1 = cur; cur = P1 * cur + H1; cin[g] = h == 0 ? c0 : c1; Pc *= P0 * P1; }
        hc = cur;
        if (PASSB) {
#pragma unroll
            for (int i = 0; i < 16; ++i) { const size_t tok = m0 + crow(i, h); const float hv = hl[i] + pc[i] * cin[i >> 2]; const float y = bf2f(gg[tok * DR + ch]) * hv; if (chv) ar[tok * DR + ch] = f2bf(y); } }
    }
    if (!PASSB && chv && h == 0) { float* sp = summ + ((size_t)(b * NCHUNK + c) * DR + ch) * 2; sp[0] = Pc; sp[1] = hc; }
}

namespace cg = cooperative_groups;
__global__ void __launch_bounds__(NTHREADS, 2) fwd(Args a) {
    extern __shared__ __attribute__((aligned(16))) unsigned char lds_raw[];
    LAS unsigned char* lds = (LAS unsigned char*)lds_raw;
    const int tid = threadIdx.x, lane = tid & 63, wave = __builtin_amdgcn_readfirstlane(tid >> 6);
    const int G = gridDim.x, bx = blockIdx.x;
    const int gw = bx * NWAVES + wave, ngw = G * NWAVES, gtid = bx * NTHREADS + tid, ngt = G * NTHREADS;
    unsigned char* ws = a.ws;
    const int lo = a.ph_lo, hi = a.ph_hi, mask = a.mask;
#define IN(k) (lo <= (k) && (k) < hi)
#define SEAM(k) do { if (IN(k) && IN((k) + 1)) cg::this_grid().sync(); } while (0)
    bf16_t* hb = (bf16_t*)(ws + WS_HB); bf16_t* qn = (bf16_t*)(ws + WS_QN); bf16_t* kn = (bf16_t*)(ws + WS_KN); bf16_t* vv = (bf16_t*)(ws + WS_VV); bf16_t* xr = (bf16_t*)(ws + WS_XR);
    bf16_t* gg = (bf16_t*)(ws + WS_GG); bf16_t* sgr = (bf16_t*)(ws + WS_SGR); bf16_t* sga = (bf16_t*)(ws + WS_SGA); bf16_t* pb = (bf16_t*)(ws + WS_PB);
    bf16_t* ob = (bf16_t*)(ws + WS_OB); float* mixa = (float*)(ws + WS_MIXA); float* Pp = (float*)(ws + WS_PP); bf16_t* ar = (bf16_t*)(ws + WS_AR); bf16_t* mixb = (bf16_t*)(ws + WS_MIXB);
    bf16_t* x1b = (bf16_t*)(ws + WS_X1B); bf16_t* x2b = (bf16_t*)(ws + WS_X2B); bf16_t* act = (bf16_t*)(ws + WS_ACT);
    float* ssq1 = (float*)(ws + WS_SMALL + SM_SSQ1); float* ssq2 = (float*)(ws + WS_SMALL + SM_SSQ2);

#ifndef NO_P0
    if (IN(0)) { if (mask & F_P0) p0_prologue(a, lds, gw, ngw, lane, gtid, ngt); }
#endif
    SEAM(0);
    if (PHON(1) && IN(1) && (mask & F_G1)) {
        pg8::Gemm g{hb, (const bf16_t*)(ws + WS_W1), M, DIN, DM}; pg8::StaticOrder S; S.init(M, DIN, G, bx);
        pg8::Epi1 E{xr, gg, qn, kn, vv, sgr, sga, a.q_gain, a.k_gain, (LAS float*)(lds + XCH_OFF)};
        pg8::gemm_phase<pg8::Epi1, pg8::StaticOrder, true, true>(lds, g, S, E);
    }
    SEAM(1);
    if (IN(2)) {
#ifndef NO_CONV
        if (mask & F_CONV) conv_phase(a, gtid, ngt);
#endif
#ifndef NO_ATTN
        if (mask & F_ATTN) { LAS unsigned char* vst = lds + wave * VST_BYTES;
            for (int u = gw; u < NBATCH * NH * (SEQ / 32); u += ngw) attn_unit(u >> 11, (u >> 7) & 15, u & 127, qn, kn, vv, ob, vst, lane); }
#endif
    }
    SEAM(2);
    if (IN(3)) {
#ifndef NO_RNNA
        if (mask & F_RNN) { for (int u = gw; u < NBATCH * NRB * 6 * NCHUNK; u += ngw) { const int nct = u >> 6; rnn_unit<false>((u >> 5) & 1, nct / 6, nct % 6, u & 31, a, lane); } }
#endif
        if (PHON(3) && (mask & F_YA)) {
            __syncthreads();
            { pg8::Gemm g{ob, (const bf16_t*)(ws + WS_WAO), M, DM, DM}; pg8::StaticOrder S; S.init(M, DM, G, bx); pg8::EpiMixA E{mixa, sga, DM};
              pg8::gemm_phase<pg8::EpiMixA, pg8::StaticOrder, true, true>(lds, g, S, E); }
            { pg8::Gemm g{pb, (const bf16_t*)(ws + WS_WPP), M, DM, PLE}; pg8::StaticOrder S; S.init(M, DM, G, bx); pg8::EpiMixA E{Pp, nullptr, DM};
              pg8::gemm_phase<pg8::EpiMixA, pg8::StaticOrder, true, true>(lds, g, S, E); }
        }
    }
    SEAM(3);
#ifndef NO_RNNB
    if (IN(4) && (mask & F_RNN)) { for (int u = gw; u < NBATCH * NRB * 6 * NCHUNK; u += ngw) { const int nct = u >> 6; rnn_unit<true>((u >> 5) & 1, nct / 6, nct % 6, u & 31, a, lane); } }
#endif
    SEAM(4);
    if (PHON(5) && IN(5) && (mask & F_YR)) { pg8::Gemm g{ar, (const bf16_t*)(ws + WS_WRO), M, DM, DR}; pg8::StaticOrder S; S.init(M, DM, G, bx); pg8::EpiMixB E{mixb, mixa, sgr, DM};
        pg8::gemm_phase<pg8::EpiMixB, pg8::StaticOrder, true, true>(lds, g, S, E); }
    SEAM(5);
    if (PHON(6) && IN(6) && (mask & F_WO)) { pg8::Gemm g{mixb, (const bf16_t*)(ws + WS_WO), M, DM, DM}; pg8::StaticOrder S; S.init(M, DM, G, bx); pg8::EpiRes E{a.x, a.out, x1b, ssq1, DM};
        pg8::gemm_phase<pg8::EpiRes, pg8::StaticOrder, true, true>(lds, g, S, E); }
    SEAM(6);
    if (PHON(7) && IN(7) && (mask & F_FFU)) { pg8::Gemm g{x1b, (const bf16_t*)(ws + WS_WGU), M, 2 * DFF, DM}; pg8::StaticOrder S; S.init(M, 2 * DFF, G, bx); pg8::EpiFfn E{act, ssq1, DFF};
        pg8::gemm_phase<pg8::EpiFfn, pg8::StaticOrder, true, true>(lds, g, S, E); }
    SEAM(7);
    if (PHON(8) && IN(8) && (mask & F_FFD)) { pg8::Gemm g{act, (const bf16_t*)(ws + WS_WDN), M, DM, DFF}; pg8::StaticOrder S; S.init(M, DM, G, bx); pg8::EpiRes E{a.out, a.out, x2b, ssq2, DM};
        pg8::gemm_phase<pg8::EpiRes, pg8::StaticOrder, true, true>(lds, g, S, E); }
    SEAM(8);
    if (PHON(9) && IN(9) && (mask & F_PLE)) { pg8::Gemm g{x2b, (const bf16_t*)(ws + WS_WPG), M, DM, DM}; pg8::StaticOrder S; S.init(M, DM, G, bx); pg8::EpiPle E{a.out, Pp, a.out, ssq2, DM};
        pg8::gemm_phase<pg8::EpiPle, pg8::StaticOrder, true, true>(lds, g, S, E); }
#undef IN
#undef SEAM
}

#ifndef FASTMASK
#define FASTMASK F_ALL
#endif
#ifndef ONE_LAUNCH
#define ONE_LAUNCH 1
#endif
extern "C" void kernel_launch(void* const* d_in, const int* in_sizes, int n_in, void* d_out, int out_size, void* d_ws, size_t ws_size, hipStream_t stream) {
    if (n_in != 22 || out_size != M * DM || ws_size < WS_END) { fprintf(stderr, "kernel_launch: unexpected sizes n_in %d out %d ws %zu\n", n_in, out_size, ws_size); return; }
    const float* x = (const float*)d_in[0]; const float* p = (const float*)d_in[1]; const float* g_mix = (const float*)d_in[2]; const float* w_in = (const float*)d_in[3];
    const float* conv_w = (const float*)d_in[4]; const float* conv_b = (const float*)d_in[5]; const float* w_rg_a = (const float*)d_in[6]; const float* b_rg_a = (const float*)d_in[7];
    const float* w_rg_x = (const float*)d_in[8]; const float* b_rg_x = (const float*)d_in[9]; const float* lam = (const float*)d_in[10]; const float* q_gain = (const float*)d_in[11];
    const float* k_gain = (const float*)d_in[12]; const float* w_rnn_out = (const float*)d_in[13]; const float* w_attn_out = (const float*)d_in[14]; const float* w_o = (const float*)d_in[15];
    const float* g_ffn = (const float*)d_in[16]; const float* w_gu = (const float*)d_in[17]; const float* w_dn = (const float*)d_in[18]; const float* g_ple = (const float*)d_in[19];
    const float* w_pg = (const float*)d_in[20]; const float* w_pp = (const float*)d_in[21];
    float* out = (float*)d_out; unsigned char* ws = (unsigned char*)d_ws;
    bf16_t* hb = (bf16_t*)(ws + WS_HB); bf16_t* qn = (bf16_t*)(ws + WS_QN); bf16_t* kn = (bf16_t*)(ws + WS_KN); bf16_t* vv = (bf16_t*)(ws + WS_VV); bf16_t* xr = (bf16_t*)(ws + WS_XR);
    bf16_t* gg = (bf16_t*)(ws + WS_GG); bf16_t* sgr = (bf16_t*)(ws + WS_SGR); bf16_t* sga = (bf16_t*)(ws + WS_SGA); bf16_t* pb = (bf16_t*)(ws + WS_PB); bf16_t* xc = (bf16_t*)(ws + WS_XC);
    bf16_t* ob = (bf16_t*)(ws + WS_OB); float* mixa = (float*)(ws + WS_MIXA); float* Pp = (float*)(ws + WS_PP); bf16_t* ar = (bf16_t*)(ws + WS_AR); bf16_t* mixb = (bf16_t*)(ws + WS_MIXB);
    bf16_t* x1b = (bf16_t*)(ws + WS_X1B); bf16_t* x2b = (bf16_t*)(ws + WS_X2B); bf16_t* act = (bf16_t*)(ws + WS_ACT);
    float* ssq1 = (float*)(ws + WS_SMALL + SM_SSQ1); float* ssq2 = (float*)(ws + WS_SMALL + SM_SSQ2);

    static int grid = 0;
    if (grid == 0) {
        int dev = 0, cus = 0, per_cu = 0;
        if (hipGetDevice(&dev) != hipSuccess || hipDeviceGetAttribute(&cus, hipDeviceAttributeMultiprocessorCount, dev) != hipSuccess) { fprintf(stderr, "kernel_launch: device query failed\n"); grid = -1; return; }
        if (hipFuncSetAttribute((const void*)fwd, hipFuncAttributeMaxDynamicSharedMemorySize, LDS_BYTES) != hipSuccess) { fprintf(stderr, "kernel_launch: hipFuncSetAttribute failed\n"); grid = -1; return; }
        if (hipOccupancyMaxActiveBlocksPerMultiprocessor(&per_cu, (const void*)fwd, NTHREADS, LDS_BYTES) != hipSuccess || per_cu < 1) { fprintf(stderr, "kernel_launch: occupancy query says %d blocks per CU\n", per_cu); (void)hipGetLastError(); grid = -1; return; }
        grid = cus;
    }
    if (grid < 0) return;
    Args a{};
    a.x = x; a.p = p; a.g_mix = g_mix; a.w_in = w_in; a.conv_w = conv_w; a.conv_b = conv_b; a.w_rg_a = w_rg_a; a.b_rg_a = b_rg_a; a.w_rg_x = w_rg_x; a.b_rg_x = b_rg_x; a.lam = lam;
    a.q_gain = q_gain; a.k_gain = k_gain; a.w_rnn_out = w_rnn_out; a.w_attn_out = w_attn_out; a.w_o = w_o; a.g_ffn = g_ffn; a.w_gu = w_gu; a.w_dn = w_dn; a.g_ple = g_ple; a.w_pg = w_pg; a.w_pp = w_pp;
    a.out = out; a.ws = ws;
#if ONE_LAUNCH
    a.ph_lo = 0; a.ph_hi = 10; a.mask = F_ALL;
    void* kargs[] = {&a};
    hipError_t e = hipLaunchCooperativeKernel((const void*)fwd, dim3(grid), dim3(NTHREADS), kargs, LDS_BYTES, stream);
    if (e != hipSuccess) fprintf(stderr, "kernel_launch: cooperative launch failed: %s (grid %d)\n", hipGetErrorString(e), grid);
#else
    constexpr int FM = FASTMASK;
    auto fast = [&](int ph, int mask) { if (!mask) return; a.ph_lo = ph; a.ph_hi = ph + 1; a.mask = mask; hipLaunchKernelGGL(fwd, dim3(grid), dim3(NTHREADS), LDS_BYTES, stream, a); };
    auto gemm1 = [&](const bf16_t* A, int lda, const float* W, int ldw, int wcol, const float* ks, int K, int N, NvEpi e) {
        nv_gemm<1><<<dim3(N / 64, M / 64), 256, 0, stream>>>(A, lda, W + wcol, nullptr, ldw, ks, K, e); };
    NvEpi e{};
    fast(0, F_P0);
    if (!(FM & F_P0)) { nv_rmsnorm<<<M / 4, 256, 0, stream>>>(x, g_mix, hb); nv_cvt<<<2048, 256, 0, stream>>>(p, pb, M * PLE); }
    if (FM & F_G1) fast(1, F_G1);
    else {
        e = NvEpi{}; e.mode = 0; e.O = xr; e.ldo = DR; gemm1(hb, DM, w_in, DIN, 0, nullptr, DM, DR, e);
        e = NvEpi{}; e.mode = 1; e.O = gg; e.ldo = DR; gemm1(hb, DM, w_in, DIN, DR, nullptr, DM, DR, e);
        e = NvEpi{}; e.mode = 0; e.O = qn; e.ldo = DM; gemm1(hb, DM, w_in, DIN, 2 * DR, nullptr, DM, DM, e);
        e = NvEpi{}; e.mode = 0; e.O = kn; e.ldo = DM; gemm1(hb, DM, w_in, DIN, 2 * DR + DM, nullptr, DM, DM, e);
        e = NvEpi{}; e.mode = 0; e.O = vv; e.ldo = DM; gemm1(hb, DM, w_in, DIN, 2 * DR + 2 * DM, nullptr, DM, DM, e);
        e = NvEpi{}; e.mode = 2; e.O = sgr; e.ldo = DM; gemm1(hb, DM, w_in, DIN, 2 * DR + 3 * DM, nullptr, DM, DM, e);
        e = NvEpi{}; e.mode = 2; e.O = sga; e.ldo = DM; gemm1(hb, DM, w_in, DIN, 2 * DR + 4 * DM, nullptr, DM, DM, e);
        nv_headnorm<<<M * NH / 4, 256, 0, stream>>>(qn, q_gain, 0.08838834764831845f);
        nv_headnorm<<<M * NH / 4, 256, 0, stream>>>(kn, k_gain, 1.0f);
    }
    fast(2, FM & (F_CONV | F_ATTN));
    if (!(FM & F_CONV)) nv_conv<<<4096, 256, 0, stream>>>(xr, conv_w, conv_b, xc);
    if (!(FM & F_ATTN)) nv_attn<<<NBATCH * NH * SEQ / 4, 256, 0, stream>>>(qn, kn, vv, ob);
    fast(3, FM & (F_RNN | F_YA));
    if (!(FM & F_YA)) {
        e = NvEpi{}; e.mode = 3; e.F = mixa; e.ldf = DM; e.G = sga; e.ldg = DM; gemm1(ob, DM, w_attn_out, DM, 0, nullptr, DM, DM, e);
        e = NvEpi{}; e.mode = 4; e.F = Pp; e.ldf = DM; gemm1(pb, PLE, w_pp, DM, 0, nullptr, PLE, DM, e);
    }
    if (FM & F_RNN) fast(4, F_RNN);
    else nv_rnn<<<NBATCH * NRB, 192, 0, stream>>>(xc, gg, w_rg_a, b_rg_a, w_rg_x, b_rg_x, lam, ar);
    if (FM & F_YR) fast(5, F_YR);
    else { e = NvEpi{}; e.mode = 5; e.O = mixb; e.ldo = DM; e.F = mixa; e.ldf = DM; e.G = sgr; e.ldg = DM; gemm1(ar, DR, w_rnn_out, DM, 0, nullptr, DR, DM, e); }
    if (FM & F_WO) fast(6, F_WO);
    else { e = NvEpi{}; e.mode = 6; e.O = x1b; e.ldo = DM; e.F = out; e.ldf = DM; e.X = x; gemm1(mixb, DM, w_o, DM, 0, nullptr, DM, DM, e); nv_rowssq<<<M / 4, 256, 0, stream>>>(out, ssq1); }
    if (FM & F_FFU) fast(7, F_FFU);
    else { e = NvEpi{}; e.mode = 7; e.O = act; e.ldo = DFF; e.ssq = ssq1; nv_gemm<2><<<dim3(DFF / 64, M / 64), 256, 0, stream>>>(x1b, DM, w_gu, w_gu + DFF, 2 * DFF, g_ffn, DM, e); }
    if (FM & F_FFD) fast(8, F_FFD);
    else { e = NvEpi{}; e.mode = 6; e.O = x2b; e.ldo = DM; e.F = out; e.ldf = DM; e.X = out; gemm1(act, DFF, w_dn, DM, 0, nullptr, DFF, DM, e); nv_rowssq<<<M / 4, 256, 0, stream>>>(out, ssq2); }
    if (FM & F_PLE) fast(9, F_PLE);
    else { e = NvEpi{}; e.mode = 8; e.F = out; e.ldf = DM; e.X = out; e.P = Pp; e.ssq = ssq2; gemm1(x2b, DM, w_pg, DM, 0, g_ple, DM, DM, e); }
#endif
}
```

```cpp
#include <hip/hip_runtime.h>
#include <hip/hip_cooperative_groups.h>
#include <cstdio>
#include <cstdint>

typedef unsigned short bf16_t;
typedef float f32x4 __attribute__((ext_vector_type(4)));
typedef unsigned u32x4 __attribute__((ext_vector_type(4)));
typedef unsigned u32x2 __attribute__((ext_vector_type(2)));
typedef short bf16x8 __attribute__((ext_vector_type(8)));
typedef short s16x4 __attribute__((ext_vector_type(4)));
typedef float f32x16 __attribute__((ext_vector_type(16)));
#define LAS __attribute__((address_space(3)))

constexpr int SEQ = 4096, NBATCH = 2, M = NBATCH * SEQ, DM = 2048, DR = 2816, DIN = 15872, DFF = 5632, PLE = 256, NH = 16, HD = 128;
constexpr int NRB = 16, RB = 176, RBP = 192, NCHUNK = 32, CHUNK = 128;
constexpr float EPS = 1e-6f;
constexpr float LOG2E = 1.4426950408889634f, LN2 = 0.6931471805599453f;

constexpr size_t MiB = (size_t)1 << 20;
constexpr size_t WS_WRO = 0, WS_WAO = 11 * MiB, WS_WO = 19 * MiB, WS_WGU = 27 * MiB, WS_WDN = 71 * MiB, WS_WPG = 93 * MiB, WS_WPP = 101 * MiB, WS_WRA = 102 * MiB, WS_WRX = 102 * MiB + 1536 * 1024;
constexpr size_t WS_W1 = 106 * MiB, WS_HB = 168 * MiB, WS_QN = 200 * MiB, WS_KN = 232 * MiB, WS_VV = 264 * MiB, WS_XR = 296 * MiB, WS_GG = 340 * MiB, WS_SGR = 384 * MiB, WS_SGA = 416 * MiB, WS_PB = 448 * MiB, WS_SMALL = 460 * MiB, WS_END = 464 * MiB;
constexpr size_t WS_XC = WS_W1, WS_OB = WS_HB, WS_MIXA = WS_QN, WS_PP = WS_VV, WS_AR = WS_SGA, WS_MIXB = WS_W1, WS_X1B = WS_GG, WS_X2B = WS_GG, WS_ACT = WS_W1;
constexpr size_t SM_SSQ1 = 0, SM_SSQ2 = 32768, SM_SUMM = 65536;

__device__ __forceinline__ float bf2f(bf16_t b) { return __uint_as_float((unsigned)b << 16); }
__device__ __forceinline__ bf16_t f2bf(float f) { unsigned u = __float_as_uint(f); return (bf16_t)((u + 0x7fffu + ((u >> 16) & 1u)) >> 16); }
__device__ __forceinline__ float rbf(float f) { return bf2f(f2bf(f)); }
__device__ __forceinline__ float sigmoidf_(float x) { return __builtin_amdgcn_rcpf(1.0f + __builtin_amdgcn_exp2f(-x * LOG2E)); }
__device__ __forceinline__ float gelu_tanh(float x) { const float y = 0.7978845608028654f * (x + 0.044715f * x * x * x); return x * __builtin_amdgcn_rcpf(1.0f + __builtin_amdgcn_exp2f(-2.0f * LOG2E * y)); }
__device__ __forceinline__ float softplusf_(float z) { return fmaxf(z, 0.f) + LN2 * __builtin_amdgcn_logf(1.0f + __builtin_amdgcn_exp2f(-fabsf(z) * LOG2E)); }
__device__ __forceinline__ float wave_sum(float v) {
#pragma unroll
    for (int o = 1; o < 64; o <<= 1) v += __shfl_xor(v, o);
    return v;
}

__global__ __launch_bounds__(256) void nv_rmsnorm(const float* __restrict__ x, const float* __restrict__ g, bf16_t* __restrict__ out) {
    const int row = blockIdx.x * 4 + (threadIdx.x >> 6), lane = threadIdx.x & 63;
    const float* xr = x + (size_t)row * DM;
    float s = 0.f;
    for (int c = lane; c < DM; c += 64) { const float v = xr[c]; s += v * v; }
    s = wave_sum(s);
    const float rs = 1.0f / sqrtf(s * (1.0f / DM) + EPS);
    for (int c = lane; c < DM; c += 64) out[(size_t)row * DM + c] = f2bf(xr[c] * rs * g[c]);
}
__global__ __launch_bounds__(256) void nv_cvt(const float* __restrict__ in, bf16_t* __restrict__ out, int n) {
    for (int i = blockIdx.x * 256 + threadIdx.x; i < n; i += gridDim.x * 256) out[i] = f2bf(in[i]);
}
__global__ __launch_bounds__(256) void nv_rowssq(const float* __restrict__ x, float* __restrict__ ssq) {
    const int row = blockIdx.x * 4 + (threadIdx.x >> 6), lane = threadIdx.x & 63;
    float s = 0.f;
    for (int c = lane; c < DM; c += 64) { const float v = x[(size_t)row * DM + c]; s += v * v; }
    s = wave_sum(s);
    if (lane == 0) ssq[row] = s;
}

struct NvEpi {
    int mode;
    bf16_t* O; int ldo;
    float* F; int ldf;
    const bf16_t* G; int ldg;
    const float* X;
    const float* P;
    const float* ssq;
    __device__ __forceinline__ void operator()(int m, int n, float a0, float a1) const {
        switch (mode) {
            case 0: O[(size_t)m * ldo + n] = f2bf(a0); break;
            case 1: O[(size_t)m * ldo + n] = f2bf(gelu_tanh(a0)); break;
            case 2: O[(size_t)m * ldo + n] = f2bf(sigmoidf_(a0)); break;
            case 3: F[(size_t)m * ldf + n] = bf2f(G[(size_t)m * ldg + n]) * a0; break;
            case 4: F[(size_t)m * ldf + n] = a0; break;
            case 5: O[(size_t)m * ldo + n] = f2bf(F[(size_t)m * ldf + n] + bf2f(G[(size_t)m * ldg + n]) * a0); break;
            case 6: { const float v = X[(size_t)m * ldf + n] + a0; F[(size_t)m * ldf + n] = v; O[(size_t)m * ldo + n] = f2bf(v); } break;
            case 7: { const float rs = 1.0f / sqrtf(ssq[m] * (1.0f / DM) + EPS); const float g = rs * a0, u = rs * a1; O[(size_t)m * ldo + n] = f2bf(g * sigmoidf_(g) * u); } break;
            case 8: { const float rs = 1.0f / sqrtf(ssq[m] * (1.0f / DM) + EPS); F[(size_t)m * ldf + n] = X[(size_t)m * ldf + n] + sigmoidf_(rs * a0) * P[(size_t)m * ldf + n]; } break;
        }
    }
};
template <int NB>
__global__ __launch_bounds__(256) void nv_gemm(const bf16_t* __restrict__ A, int lda, const float* __restrict__ W0, const float* __restrict__ W1, int ldw, const float* __restrict__ ks, int K, NvEpi epi) {
    __shared__ float As[16][68];
    __shared__ float Bs[NB][16][68];
    const int tid = threadIdx.x, tx = tid & 15, ty = tid >> 4;
    const int m0 = blockIdx.y * 64, n0 = blockIdx.x * 64;
    float acc[NB][4][4];
#pragma unroll
    for (int b = 0; b < NB; ++b)
#pragma unroll
        for (int i = 0; i < 4; ++i)
#pragma unroll
            for (int j = 0; j < 4; ++j) acc[b][i][j] = 0.f;
    for (int k0 = 0; k0 < K; k0 += 16) {
        { const int r = tid >> 2, kk = (tid & 3) * 4; const bf16_t* ap = A + (size_t)(m0 + r) * lda + k0 + kk;
#pragma unroll
          for (int j = 0; j < 4; ++j) As[kk + j][r] = bf2f(ap[j]); }
        { const int kk = tid >> 4, nn = (tid & 15) * 4; const float sc = ks ? ks[k0 + kk] : 1.0f;
          const f32x4 w0 = *(const f32x4*)(W0 + (size_t)(k0 + kk) * ldw + n0 + nn);
#pragma unroll
          for (int j = 0; j < 4; ++j) Bs[0][kk][nn + j] = rbf(w0[j] * sc);
          if (NB == 2) { const f32x4 w1 = *(const f32x4*)(W1 + (size_t)(k0 + kk) * ldw + n0 + nn);
#pragma unroll
              for (int j = 0; j < 4; ++j) Bs[NB - 1][kk][nn + j] = rbf(w1[j] * sc); } }
        __syncthreads();
#pragma unroll
        for (int kk = 0; kk < 16; ++kk) {
            const f32x4 a = *(const f32x4*)&As[kk][ty * 4];
#pragma unroll
            for (int b = 0; b < NB; ++b) { const f32x4 w = *(const f32x4*)&Bs[b][kk][tx * 4];
#pragma unroll
                for (int i = 0; i < 4; ++i)
#pragma unroll
                    for (int j = 0; j < 4; ++j) acc[b][i][j] += a[i] * w[j]; }
        }
        __syncthreads();
    }
#pragma unroll
    for (int i = 0; i < 4; ++i)
#pragma unroll
        for (int j = 0; j < 4; ++j) epi(m0 + ty * 4 + i, n0 + tx * 4 + j, acc[0][i][j], acc[NB - 1][i][j]);
}
__global__ __launch_bounds__(256) void nv_headnorm(bf16_t* __restrict__ q, const float* __restrict__ gain, float extra) {
    const int idx = blockIdx.x * 4 + (threadIdx.x >> 6), lane = threadIdx.x & 63;
    bf16_t* p = q + (size_t)idx * HD;
    const float a = bf2f(p[lane]), b = bf2f(p[lane + 64]);
    const float s = wave_sum(a * a + b * b);
    const float rs = 1.0f / sqrtf(s * (1.0f / HD) + EPS) * extra;
    p[lane] = f2bf(a * rs * gain[lane]); p[lane + 64] = f2bf(b * rs * gain[lane + 64]);
}
__global__ __launch_bounds__(256) void nv_conv(const bf16_t* __restrict__ xr, const float* __restrict__ cw, const float* __restrict__ cb, bf16_t* __restrict__ xc) {
    const size_t total = (size_t)M * DR;
    for (size_t i = (size_t)blockIdx.x * 256 + threadIdx.x; i < total; i += (size_t)gridDim.x * 256) {
        const int m = (int)(i / DR), c = (int)(i % DR), s = m & (SEQ - 1);
        float acc = cb[c];
#pragma unroll
        for (int j = 0; j < 4; ++j) { const int sj = s - 3 + j; if (sj >= 0) acc += cw[j * DR + c] * bf2f(xr[(size_t)(m - 3 + j) * DR + c]); }
        xc[i] = f2bf(acc);
    }
}
__global__ __launch_bounds__(256) void nv_attn(const bf16_t* __restrict__ qn, const bf16_t* __restrict__ kn, const bf16_t* __restrict__ vv, bf16_t* __restrict__ ob) {
    const int gw = blockIdx.x * 4 + (threadIdx.x >> 6), lane = threadIdx.x & 63;
    const int t = gw & (SEQ - 1), h = (gw >> 12) & 15, b = gw >> 16;
    const size_t rowb = (size_t)b * SEQ;
    const bf16_t* qp = qn + (rowb + t) * DM + h * HD;
    const float q0 = bf2f(qp[lane]), q1 = bf2f(qp[lane + 64]);
    float o0 = 0.f, o1 = 0.f, R = 0.f;
    for (int s = t - 1; s >= 0; --s) {
        const bf16_t* kp = kn + (rowb + s) * DM + h * HD;
        const float z = wave_sum(q0 * bf2f(kp[lane]) + q1 * bf2f(kp[lane + 64]));
        const float sp = softplusf_(z);
        const float w = __builtin_amdgcn_exp2f((z - sp + R) * LOG2E);
        const bf16_t* vp = vv + (rowb + s) * DM + h * HD;
        const float wb = rbf(w);
        o0 += wb * bf2f(vp[lane]); o1 += wb * bf2f(vp[lane + 64]);
        R -= sp;
        if (R < -88.0f) break;
    }
    bf16_t* op = ob + (rowb + t) * DM + h * HD;
    op[lane] = f2bf(o0); op[lane + 64] = f2bf(o1);
}
__global__ __launch_bounds__(192) void nv_rnn(const bf16_t* __restrict__ xc, const bf16_t* __restrict__ gg, const float* __restrict__ wa, const float* __restrict__ ba, const float* __restrict__ wx, const float* __restrict__ bx,
                                              const float* __restrict__ lam, bf16_t* __restrict__ ar) {
    __shared__ float xs[RB];
    const int b = blockIdx.x >> 4, n = blockIdx.x & 15, d = threadIdx.x;
    const bool act = d < RB;
    const int ch = n * RB + (act ? d : 0);
    const float* wap = wa + (size_t)n * RB * RB + (act ? d : 0);
    const float* wxp = wx + (size_t)n * RB * RB + (act ? d : 0);
    const float bav = ba[ch], bxv = bx[ch];
    const float l = lam[ch];
    const float cl = 8.0f * (fmaxf(-l, 0.f) + log1pf(expf(-fabsf(l))));
    float h = 0.f;
    for (int s = 0; s < SEQ; ++s) {
        const size_t m = (size_t)b * SEQ + s;
        __syncthreads();
        if (act) xs[d] = bf2f(xc[m * DR + n * RB + d]);
        __syncthreads();
        float sa = 0.f, sx = 0.f;
        for (int c = 0; c < RB; ++c) { const float xv = xs[c]; sa += xv * rbf(wap[(size_t)c * RB]); sx += xv * rbf(wxp[(size_t)c * RB]); }
        const float r = sigmoidf_(sa + bav), ig = sigmoidf_(sx + bxv);
        const float la = -cl * r;
        const float a = expf(la);
        const float u = sqrtf(-expm1f(2.0f * la)) * (ig * xs[act ? d : 0]);
        h = a * h + u;
        if (act) ar[m * DR + ch] = f2bf(bf2f(gg[m * DR + ch]) * h);
    }
}

#define ONE_LAUNCH 1
#define FASTMASK 2047
namespace pg8 {
#define PG8_LAS __attribute__((address_space(3)))
typedef unsigned short bf16_t;
typedef short bf16x8 __attribute__((ext_vector_type(8)));
typedef float f32x4 __attribute__((ext_vector_type(4)));
typedef unsigned u32x4 __attribute__((ext_vector_type(4)));
constexpr int BM = 256, BK = 64, HALF = 128, HTB = HALF * BK * 2  , STAGE_BYTES = 8 * HTB, NXCD = 8, WGM = 8;

__host__ __device__ __forceinline__ int lds_byte(int r, int c) { const int st = (r >> 4) * 2 + (c >> 5), rr = r & 15, cc = c & 31, ob = rr * 64 + cc * 2; return st * 1024 + (ob ^ (((ob >> 9) & 1) << 5)); }
__host__ __device__ __forceinline__ void stage_rc(int b, int& R, int& C) { const int st = b / 1024, sb = b % 1024, swz = sb ^ (((sb >> 9) & 1) << 5); R = (st >> 1) * 16 + swz / 64; C = (st & 1) * 32 + (swz % 64) / 2; }
__host__ __device__ __forceinline__ int perm32(int rho) { const int n = rho >> 4, i = rho & 15; return 8 * (i >> 2) + 4 * n + (i & 3); }

struct Unit { int pm, pn; };
struct Gemm { const bf16_t* A; const bf16_t* Bt; int M, N, K; };

struct StaticOrder {
    int nM, nN, nwg, G, c;
    __host__ __device__ void init(int M, int N, int G_, int c_) { nM = M / BM; nN = N / BM; nwg = nM * nN; G = G_; c = c_; }
    __host__ __device__ bool next(int i, Unit& u) const {
        const long L = (long)i * G + c; if (L >= nwg) return false;
        int wgid = (int)L; { const int q = nwg / NXCD, r = nwg % NXCD, xcd = wgid % NXCD, off = wgid / NXCD; wgid = (xcd < r ? xcd * (q + 1) : r * (q + 1) + (xcd - r) * q) + off; }
        const int nig = WGM * nN, gid = wgid / nig, fm = gid * WGM, gsz = (nM - fm) < WGM ? (nM - fm) : WGM;
        u.pm = fm + ((wgid % nig) % gsz); u.pn = (wgid % nig) / gsz; return true;
    }
    __device__ __forceinline__ void a_ready(const Unit&) const {}
    __device__ __forceinline__ void done(const Unit&) const {}
};


__device__ __forceinline__ unsigned cvt_pk_bf16(float lo, float hi) { unsigned r; asm volatile("v_cvt_pk_bf16_f32 %0, %1, %2" : "=v"(r) : "v"(lo), "v"(hi)); return r; }
__device__ __forceinline__ float bflo(unsigned w) { return __uint_as_float(w << 16); }
__device__ __forceinline__ float bfhi(unsigned w) { return __uint_as_float(w & 0xffff0000u); }
__device__ __forceinline__ float sig_(float x) { return __builtin_amdgcn_rcpf(1.0f + __builtin_amdgcn_exp2f(-x * 1.4426950408889634f)); }
__device__ __forceinline__ float gelu_t(float x) { const float y = 0.7978845608028654f * (x + 0.044715f * x * x * x); return x * __builtin_amdgcn_rcpf(1.0f + __builtin_amdgcn_exp2f(-2.0f * 1.4426950408889634f * y)); }
__device__ __forceinline__ u32x4 pack8(const f32x4& v0, const f32x4& v1) { u32x4 w; w.x = cvt_pk_bf16(v0[0], v0[1]); w.y = cvt_pk_bf16(v0[2], v0[3]); w.z = cvt_pk_bf16(v1[0], v1[1]); w.w = cvt_pk_bf16(v1[2], v1[3]); return w; }

struct Epi1 {
    static constexpr bool PERM = true, AFTER_DRAIN = false;
    bf16_t *xr, *gg, *qn, *kn, *vv, *sgr, *sga; const float *qgain, *kgain; PG8_LAS float* xch;
    __device__ __forceinline__ void operator()(const f32x4 (&acc)[2][2][4][2], const Unit& u, int wr, int wc, int fr, int fq) const {
        const int pn = u.pn;
        int kind, ld, colt; bf16_t* base;
        if (pn < 11) { kind = 0; base = xr; ld = 2816; colt = pn * 256; }
        else if (pn < 22) { kind = 1; base = gg; ld = 2816; colt = (pn - 11) * 256; }
        else if (pn < 30) { kind = 2; base = qn; ld = 2048; colt = (pn - 22) * 256; }
        else if (pn < 38) { kind = 3; base = kn; ld = 2048; colt = (pn - 30) * 256; }
        else if (pn < 46) { kind = 0; base = vv; ld = 2048; colt = (pn - 38) * 256; }
        else if (pn < 54) { kind = 4; base = sgr; ld = 2048; colt = (pn - 46) * 256; }
        else { kind = 4; base = sga; ld = 2048; colt = (pn - 54) * 256; }
        float rst[2][4][2]; f32x4 gv[2];
#pragma unroll
        for (int ai = 0; ai < 2; ++ai)
#pragma unroll
            for (int m = 0; m < 4; ++m) { rst[ai][m][0] = 1.f; rst[ai][m][1] = 1.f; }
        gv[0] = (f32x4){1.f, 1.f, 1.f, 1.f}; gv[1] = gv[0];
        if (kind == 2 || kind == 3) {
#pragma unroll
            for (int ai = 0; ai < 2; ++ai)
#pragma unroll
                for (int m = 0; m < 4; ++m)
#pragma unroll
                    for (int bj = 0; bj < 2; ++bj) { const f32x4 a = acc[ai][bj][m][0], b = acc[ai][bj][m][1];
                        float s = (a[0] * a[0] + a[1] * a[1]) + (a[2] * a[2] + a[3] * a[3]) + (b[0] * b[0] + b[1] * b[1]) + (b[2] * b[2] + b[3] * b[3]);
                        s += __shfl_xor(s, 16); s += __shfl_xor(s, 32);
                        if (fq == 0) xch[((ai * HALF + wr * 64 + m * 16 + fr) * 2 + bj) * 4 + wc] = s; }
            asm volatile("s_waitcnt lgkmcnt(0)" ::: "memory"); __builtin_amdgcn_s_barrier(); asm volatile("" ::: "memory");
            const float extra = kind == 2 ? 0.08838834764831845f : 1.0f;
#pragma unroll
            for (int ai = 0; ai < 2; ++ai)
#pragma unroll
                for (int m = 0; m < 4; ++m)
#pragma unroll
                    for (int bj = 0; bj < 2; ++bj) { const f32x4 t = *(const PG8_LAS f32x4*)&xch[((ai * HALF + wr * 64 + m * 16 + fr) * 2 + bj) * 4];
                        rst[ai][m][bj] = extra * __builtin_amdgcn_rsqf(((t[0] + t[1]) + (t[2] + t[3])) * (1.0f / 128.0f) + 1e-6f); }
            const float* gp = (kind == 2 ? qgain : kgain) + wc * 32 + 8 * fq; gv[0] = *(const f32x4*)gp; gv[1] = *(const f32x4*)(gp + 4);
        }
        bf16_t* rowp = base + (size_t)(u.pm * BM + wr * 64 + fr) * ld + colt + wc * 32 + 8 * fq;
        const size_t step16 = (size_t)16 * ld;
#pragma unroll
        for (int ai = 0; ai < 2; ++ai) {
#pragma unroll
            for (int m = 0; m < 4; ++m) {
#pragma unroll
                for (int bj = 0; bj < 2; ++bj) { f32x4 v0 = acc[ai][bj][m][0], v1 = acc[ai][bj][m][1];
                    if (kind == 1) {
#pragma unroll
                        for (int j = 0; j < 4; ++j) { v0[j] = gelu_t(v0[j]); v1[j] = gelu_t(v1[j]); } }
                    else if (kind == 4) {
#pragma unroll
                        for (int j = 0; j < 4; ++j) { v0[j] = sig_(v0[j]); v1[j] = sig_(v1[j]); } }
                    else { v0 = v0 * rst[ai][m][bj] * gv[0]; v1 = v1 * rst[ai][m][bj] * gv[1]; }
                    *(u32x4*)(rowp + bj * HALF) = pack8(v0, v1); }
                rowp += step16;
                __builtin_amdgcn_sched_barrier(0); }
            rowp += step16 * 4; }
    }
};
struct EpiMixA {
    static constexpr bool PERM = false, AFTER_DRAIN = false;
    float* F; const bf16_t* G; int ld;
    __device__ __forceinline__ void operator()(const f32x4 (&acc)[2][2][4][2], const Unit& u, int wr, int wc, int fr, int fq) const {
        const int row0 = u.pm * BM + wr * 64 + fr, col0 = u.pn * BM + wc * 32 + 4 * fq;
#pragma unroll
        for (int ai = 0; ai < 2; ++ai)
#pragma unroll
            for (int m = 0; m < 4; ++m) { const size_t off = (size_t)(row0 + ai * HALF + m * 16) * ld + col0;
#pragma unroll
                for (int bj = 0; bj < 2; ++bj)
#pragma unroll
                    for (int n = 0; n < 2; ++n) { const size_t o = off + bj * HALF + n * 16; f32x4 v = acc[ai][bj][m][n];
                        if (G) { const u32x2 g = *(const u32x2*)(G + o); v = v * (f32x4){bflo(g.x), bfhi(g.x), bflo(g.y), bfhi(g.y)}; }
                        *(f32x4*)(F + o) = v; } }
    }
};
struct EpiMixB {
    static constexpr bool PERM = true, AFTER_DRAIN = false;
    bf16_t* O; const float* F; const bf16_t* G; int ld;
    __device__ __forceinline__ void operator()(const f32x4 (&acc)[2][2][4][2], const Unit& u, int wr, int wc, int fr, int fq) const {
        const int row0 = u.pm * BM + wr * 64 + fr, col0 = u.pn * BM + wc * 32 + 8 * fq;
#pragma unroll
        for (int ai = 0; ai < 2; ++ai)
#pragma unroll
            for (int m = 0; m < 4; ++m) { const size_t off = (size_t)(row0 + ai * HALF + m * 16) * ld + col0;
#pragma unroll
                for (int bj = 0; bj < 2; ++bj) { const size_t o = off + bj * HALF;
                    const f32x4 f0 = *(const f32x4*)(F + o), f1 = *(const f32x4*)(F + o + 4); const u32x4 g = *(const u32x4*)(G + o);
                    const f32x4 v0 = f0 + acc[ai][bj][m][0] * (f32x4){bflo(g.x), bfhi(g.x), bflo(g.y), bfhi(g.y)};
                    const f32x4 v1 = f1 + acc[ai][bj][m][1] * (f32x4){bflo(g.z), bfhi(g.z), bflo(g.w), bfhi(g.w)};
                    *(u32x4*)(O + o) = pack8(v0, v1); } }
    }
};
struct EpiRes {
    static constexpr bool PERM = false, AFTER_DRAIN = false;
    const float* X; float* Fout; bf16_t* O; float* ssq; int ld;
    __device__ __forceinline__ void operator()(const f32x4 (&acc)[2][2][4][2], const Unit& u, int wr, int wc, int fr, int fq) const {
        const int row0 = u.pm * BM + wr * 64 + fr, col0 = u.pn * BM + wc * 32 + 4 * fq;
#pragma unroll
        for (int ai = 0; ai < 2; ++ai)
#pragma unroll
            for (int m = 0; m < 4; ++m) { const int row = row0 + ai * HALF + m * 16; const size_t off = (size_t)row * ld + col0; float s = 0.f;
#pragma unroll
                for (int bj = 0; bj < 2; ++bj)
#pragma unroll
                    for (int n = 0; n < 2; ++n) { const size_t o = off + bj * HALF + n * 16; const f32x4 v = *(const f32x4*)(X + o) + acc[ai][bj][m][n];
                        *(f32x4*)(Fout + o) = v; u32x2 w; w.x = cvt_pk_bf16(v[0], v[1]); w.y = cvt_pk_bf16(v[2], v[3]); *(u32x2*)(O + o) = w;
                        s += (v[0] * v[0] + v[1] * v[1]) + (v[2] * v[2] + v[3] * v[3]); }
                s += __shfl_xor(s, 16); s += __shfl_xor(s, 32);
                if (fq == 0) unsafeAtomicAdd(ssq + row, s); }
    }
};
struct EpiFfn {
    static constexpr bool PERM = true, AFTER_DRAIN = false;
    bf16_t* O; const float* ssq; int ldo;
    __device__ __forceinline__ void operator()(const f32x4 (&acc)[2][2][4][2], const Unit& u, int wr, int wc, int fr, int fq) const {
        const int row0 = u.pm * BM + wr * 64 + fr, col0 = u.pn * HALF + wc * 32 + 8 * fq;
#pragma unroll
        for (int ai = 0; ai < 2; ++ai)
#pragma unroll
            for (int m = 0; m < 4; ++m) { const int row = row0 + ai * HALF + m * 16; const float rs = __builtin_amdgcn_rsqf(ssq[row] * (1.0f / 2048.0f) + 1e-6f);
                f32x4 v[2];
#pragma unroll
                for (int n = 0; n < 2; ++n)
#pragma unroll
                    for (int j = 0; j < 4; ++j) { const float g = rs * acc[ai][0][m][n][j], uu = rs * acc[ai][1][m][n][j]; v[n][j] = g * sig_(g) * uu; }
                *(u32x4*)(O + (size_t)row * ldo + col0) = pack8(v[0], v[1]); }
    }
};
struct EpiPle {
    static constexpr bool PERM = false, AFTER_DRAIN = false;
    const float* X; const float* P; float* out; const float* ssq; int ld;
    __device__ __forceinline__ void operator()(const f32x4 (&acc)[2][2][4][2], const Unit& u, int wr, int wc, int fr, int fq) const {
        const int row0 = u.pm * BM + wr * 64 + fr, col0 = u.pn * BM + wc * 32 + 4 * fq;
#pragma unroll
        for (int ai = 0; ai < 2; ++ai)
#pragma unroll
            for (int m = 0; m < 4; ++m) { const int row = row0 + ai * HALF + m * 16; const size_t off = (size_t)row * ld + col0; const float rs = __builtin_amdgcn_rsqf(ssq[row] * (1.0f / 2048.0f) + 1e-6f);
#pragma unroll
                for (int bj = 0; bj < 2; ++bj)
#pragma unroll
                    for (int n = 0; n < 2; ++n) { const size_t o = off + bj * HALF + n * 16; const f32x4 xv = *(const f32x4*)(X + o), pv = *(const f32x4*)(P + o); f32x4 r;
#pragma unroll
                        for (int j = 0; j < 4; ++j) r[j] = xv[j] + sig_(rs * acc[ai][bj][m][n][j]) * pv[j];
                        *(f32x4*)(out + o) = r; } }
    }
};
template <class Epi, class Sched, bool ALIGN_EPI = false, bool SP2 = false>
__device__ __forceinline__ void gemm_phase(PG8_LAS unsigned char* lds, const Gemm g, const Sched& S, const Epi& E) {
    const int tid = threadIdx.x, wid = __builtin_amdgcn_readfirstlane(tid >> 6), lane = tid & 63, wr = wid >> 2, wc = wid & 3, fr = lane & 15, fq = lane >> 4;
    const int K = g.K, nt = K / BK;
    unsigned voffA[2], voffB[2];
#pragma unroll
    for (int i = 0; i < 2; ++i) { int R, C; stage_rc(tid * 16 + i * 8192, R, C); const int Rb = Epi::PERM ? ((R & ~31) + perm32(R & 31)) : R;
        voffA[i] = (unsigned)(R * K + C) * 2u; voffB[i] = (unsigned)(Rb * K + C) * 2u; }
    const size_t kstep = (size_t)(BK * 2);
    const size_t hstep = (size_t)HALF * K * 2;
    const size_t tstep = 2 * hstep;
    const unsigned ldsw = (unsigned)wid * 1024u;
    const int aoff = lds_byte(wr * 64 + fr, fq * 8), boff = lds_byte(wc * 32 + fr, fq * 8);
#define PG8_SA(b, h) (((b) * 2 + (h)) * HTB)
#define PG8_SB(b, h) ((4 + (b) * 2 + (h)) * HTB)
#define PG8_STAGE(bufoff, gbase, voff) do { _Pragma("unroll") for (int _i = 0; _i < 2; ++_i) \
        __builtin_amdgcn_global_load_lds((const unsigned*)((const char*)(gbase) + (voff)[_i]), (PG8_LAS unsigned*)(lds + (bufoff) + ldsw + _i * 8192), 16, 0, 0); } while (0)
#define PG8_LDA(dst, b, h) do { _Pragma("unroll") for (int m = 0; m < 4; ++m) _Pragma("unroll") for (int k = 0; k < 2; ++k) dst[m][k] = *(const PG8_LAS bf16x8*)(lds + PG8_SA(b, h) + aoff + m * 2048 + k * 1024); } while (0)
#define PG8_LDB(dst, b, h) do { _Pragma("unroll") for (int n = 0; n < 2; ++n) _Pragma("unroll") for (int k = 0; k < 2; ++k) dst[n][k] = *(const PG8_LAS bf16x8*)(lds + PG8_SB(b, h) + boff + n * 2048 + k * 1024); } while (0)
#define PG8_MMA(ai, bj, At, Bt) do { __builtin_amdgcn_s_setprio(1); _Pragma("unroll") for (int m = 0; m < 4; ++m) _Pragma("unroll") for (int n = 0; n < 2; ++n) _Pragma("unroll") for (int k = 0; k < 2; ++k) \
        acc[ai][bj][m][n] = __builtin_amdgcn_mfma_f32_16x16x32_bf16(Bt[n][k], At[m][k], acc[ai][bj][m][n], 0, 0, 0); __builtin_amdgcn_s_setprio(0); } while (0)
#define PG8_WAIT_V(n) asm volatile("s_waitcnt vmcnt(" #n ")" ::: "memory")
#define PG8_WAIT_L(n) asm volatile("s_waitcnt lgkmcnt(" #n ")" ::: "memory")
#define PG8_BAR __builtin_amdgcn_s_barrier()
#define PG8_SCHED __builtin_amdgcn_sched_barrier(0)
    Unit cur, nxt; int ui = 0;
    if (!S.next(0, cur)) return;
    f32x4 acc[2][2][4][2];
#pragma unroll
    for (int a = 0; a < 2; ++a)
#pragma unroll
        for (int b = 0; b < 2; ++b)
#pragma unroll
            for (int m = 0; m < 4; ++m)
#pragma unroll
                for (int n = 0; n < 2; ++n) acc[a][b][m][n] = (f32x4){0.f, 0.f, 0.f, 0.f};
    bf16x8 At[4][2], B0[2][2], B1[2][2];
    const char* cA = (const char*)g.A + (size_t)cur.pm * tstep; const char* cB = (const char*)g.Bt + (size_t)cur.pn * tstep;
    S.a_ready(cur);
    if constexpr (SP2) {
        PG8_STAGE(PG8_SB(0, 0), cB, voffB); PG8_STAGE(PG8_SB(0, 1), cB + hstep, voffB); PG8_STAGE(PG8_SA(0, 0), cA, voffA); PG8_STAGE(PG8_SA(0, 1), cA + hstep, voffA);
        if (wr == 1) PG8_BAR;
        PG8_WAIT_V(2); PG8_BAR;
        PG8_STAGE(PG8_SB(1, 0), cB + kstep, voffB); PG8_STAGE(PG8_SA(1, 0), cA + kstep, voffA); PG8_STAGE(PG8_SB(1, 1), cB + hstep + kstep, voffB);
        PG8_WAIT_V(6); PG8_BAR;
    } else {
        PG8_STAGE(PG8_SB(0, 0), cB, voffB); PG8_STAGE(PG8_SA(0, 0), cA, voffA); PG8_STAGE(PG8_SB(0, 1), cB + hstep, voffB); PG8_STAGE(PG8_SA(0, 1), cA + hstep, voffA);
        if (wr == 1) PG8_BAR;
        PG8_WAIT_V(4); PG8_BAR;
        PG8_STAGE(PG8_SB(1, 0), cB + kstep, voffB); PG8_STAGE(PG8_SA(1, 0), cA + kstep, voffA); PG8_STAGE(PG8_SB(1, 1), cB + hstep + kstep, voffB);
        PG8_WAIT_V(6); PG8_BAR;
    }
    for (;;) {
        const bool has_next = S.next(ui + 1, nxt);
        const char* nA = has_next ? (const char*)g.A + (size_t)nxt.pm * tstep : cA; const char* nB = has_next ? (const char*)g.Bt + (size_t)nxt.pn * tstep : cB;
        for (int t = 0; t < nt; t += 2) {
            const bool last = (t == nt - 2);
            const char* a1 = cA + (size_t)(t + 1) * kstep;
            const char* a2 = last ? nA : cA + (size_t)(t + 2) * kstep; const char* b2 = last ? nB : cB + (size_t)(t + 2) * kstep;
            const char* a3 = a2 + kstep; const char* b3 = b2 + kstep;
            if (last && has_next) S.a_ready(nxt);
            if constexpr (SP2) {
            PG8_LDB(B0, 0, 0); PG8_LDB(B1, 0, 1); PG8_SCHED; PG8_LDA(At, 0, 0); PG8_STAGE(PG8_SA(1, 1), a1 + hstep, voffA);
            PG8_WAIT_V(8); PG8_WAIT_L(0); PG8_BAR; PG8_MMA(0, 0, At, B0); PG8_MMA(0, 1, At, B1); PG8_BAR; PG8_SCHED;
            PG8_LDA(At, 0, 1); PG8_STAGE(PG8_SB(0, 0), b2, voffB); PG8_STAGE(PG8_SB(0, 1), b2 + hstep, voffB); PG8_STAGE(PG8_SA(0, 0), a2, voffA);
            PG8_WAIT_V(8); PG8_WAIT_L(0); PG8_BAR; PG8_MMA(1, 0, At, B0); PG8_MMA(1, 1, At, B1); PG8_BAR; PG8_SCHED;
            PG8_LDB(B0, 1, 0); PG8_LDB(B1, 1, 1); PG8_SCHED; PG8_LDA(At, 1, 0); PG8_STAGE(PG8_SA(0, 1), a2 + hstep, voffA);
            PG8_WAIT_V(8); PG8_WAIT_L(0); PG8_BAR; PG8_MMA(0, 0, At, B0); PG8_MMA(0, 1, At, B1); PG8_BAR; PG8_SCHED;
            PG8_LDA(At, 1, 1); PG8_STAGE(PG8_SB(1, 0), b3, voffB); PG8_STAGE(PG8_SB(1, 1), b3 + hstep, voffB); PG8_STAGE(PG8_SA(1, 0), a3, voffA);
            PG8_WAIT_V(8); PG8_WAIT_L(0); PG8_BAR; PG8_MMA(1, 0, At, B0); PG8_MMA(1, 1, At, B1); PG8_BAR; PG8_SCHED;
            } else {
            PG8_LDB(B0, 0, 0); PG8_SCHED; PG8_LDA(At, 0, 0); PG8_STAGE(PG8_SA(1, 1), a1 + hstep, voffA);
            PG8_WAIT_L(8); PG8_BAR; PG8_WAIT_L(0); PG8_MMA(0, 0, At, B0); PG8_BAR; PG8_SCHED;
            PG8_LDB(B1, 0, 1); PG8_STAGE(PG8_SB(0, 0), b2, voffB);
            PG8_BAR; PG8_WAIT_L(0); PG8_MMA(0, 1, At, B1); PG8_BAR;
            PG8_LDA(At, 0, 1); PG8_STAGE(PG8_SA(0, 0), a2, voffA);
            PG8_BAR; PG8_WAIT_L(0); PG8_MMA(1, 0, At, B0); PG8_BAR; PG8_SCHED;
            PG8_STAGE(PG8_SB(0, 1), b2 + hstep, voffB);
            PG8_WAIT_V(6); PG8_BAR; PG8_MMA(1, 1, At, B1); PG8_BAR;
            PG8_LDB(B0, 1, 0); PG8_SCHED; PG8_LDA(At, 1, 0); PG8_STAGE(PG8_SA(0, 1), a2 + hstep, voffA);
            PG8_WAIT_L(8); PG8_BAR; PG8_WAIT_L(0); PG8_MMA(0, 0, At, B0); PG8_BAR; PG8_SCHED;
            PG8_LDB(B1, 1, 1); PG8_STAGE(PG8_SB(1, 0), b3, voffB);
            PG8_BAR; PG8_WAIT_L(0); PG8_MMA(0, 1, At, B1); PG8_BAR;
            PG8_LDA(At, 1, 1); PG8_STAGE(PG8_SA(1, 0), a3, voffA);
            PG8_BAR; PG8_WAIT_L(0); PG8_MMA(1, 0, At, B0); PG8_BAR; PG8_SCHED;
            PG8_STAGE(PG8_SB(1, 1), b3 + hstep, voffB);
            PG8_WAIT_V(6); PG8_BAR; PG8_MMA(1, 1, At, B1); PG8_BAR;
            }
        }
        if constexpr (ALIGN_EPI) { if (wr == 0) PG8_BAR; }
        if constexpr (!Epi::AFTER_DRAIN) { E(acc, cur, wr, wc, fr, fq); S.done(cur); }
        if (!has_next) break;
#pragma unroll
        for (int a = 0; a < 2; ++a)
#pragma unroll
            for (int b = 0; b < 2; ++b)
#pragma unroll
                for (int m = 0; m < 4; ++m)
#pragma unroll
                    for (int n = 0; n < 2; ++n) acc[a][b][m][n] = (f32x4){0.f, 0.f, 0.f, 0.f};
        cur = nxt; cA = nA; cB = nB; ++ui;
        if constexpr (ALIGN_EPI) { if (wr == 1) PG8_BAR; }
    }
    PG8_WAIT_V(0);
    if constexpr (!ALIGN_EPI) { if (wr == 0) PG8_BAR; }
    PG8_BAR;
    if constexpr (Epi::AFTER_DRAIN) { E.fused(acc, cur, wr, wc, fr, fq, lds, wid, lane); S.done(cur); }
#undef PG8_SA
#undef PG8_SB
#undef PG8_STAGE
#undef PG8_LDA
#undef PG8_LDB
#undef PG8_MMA
#undef PG8_WAIT_V
#undef PG8_WAIT_L
#undef PG8_BAR
#undef PG8_SCHED
}
}

#ifndef ONLYP
#define ONLYP -1
#endif
constexpr int ONLY = ONLYP;
#define PHON(k) (ONLY < 0 || ONLY == (k))
constexpr int NWAVES = 8, NTHREADS = NWAVES * 64;
constexpr int RING_BYTES = 131072, XCH_OFF = RING_BYTES, XCH_BYTES = 8192, LDS_BYTES = 147456;
static_assert(XCH_OFF + XCH_BYTES <= LDS_BYTES, "LDS map");
constexpr int VST_PITCH = 320, VST_BYTES = 32 * VST_PITCH;
static_assert(NWAVES * VST_BYTES <= RING_BYTES, "attention scratch");

enum { F_P0 = 1, F_G1 = 2, F_CONV = 4, F_ATTN = 8, F_RNN = 16, F_YA = 32, F_YR = 64, F_WO = 128, F_FFU = 256, F_FFD = 512, F_PLE = 1024, F_ALL = 2047 };

struct Args {
    const float *x, *p, *g_mix, *w_in, *conv_w, *conv_b, *w_rg_a, *b_rg_a, *w_rg_x, *b_rg_x, *lam, *q_gain, *k_gain, *w_rnn_out, *w_attn_out, *w_o, *g_ffn, *w_gu, *w_dn, *g_ple, *w_pg, *w_pp;
    float* out; unsigned char* ws; int ph_lo, ph_hi, mask, pad;
};

__device__ __forceinline__ int crow(int reg, int h) { return (reg & 3) + 8 * (reg >> 2) + 4 * h; }
#define MFMA32(a, b, c) __builtin_amdgcn_mfma_f32_32x32x16_bf16((a), (b), (c), 0, 0, 0)
__device__ __forceinline__ unsigned pk2(float lo, float hi) { return (unsigned)f2bf(lo) | ((unsigned)f2bf(hi) << 16); }

__device__ __forceinline__ void p0_transpose_item(const float* __restrict__ W, int ldw, int Kdim, bf16_t* __restrict__ WT, int orow0, const float* __restrict__ ks, LAS float* scr, int k0, int n0, int lane) {
#pragma unroll 8
    for (int i = 0; i < 32; ++i) { const int kk = 2 * i + (lane >> 5); float v = W[(size_t)(k0 + kk) * ldw + n0 + (lane & 31)]; if (ks) v *= ks[k0 + kk]; scr[kk * 33 + (lane & 31)] = v; }
    asm volatile("s_waitcnt lgkmcnt(0)" ::: "memory");
    const int c = lane & 7;
#pragma unroll
    for (int j = 0; j < 4; ++j) { const int n = (lane >> 3) + 8 * j; const LAS float* s = scr + (8 * c) * 33 + n;
        u32x4 o; o.x = pk2(s[0 * 33], s[1 * 33]); o.y = pk2(s[2 * 33], s[3 * 33]); o.z = pk2(s[4 * 33], s[5 * 33]); o.w = pk2(s[6 * 33], s[7 * 33]);
        *(u32x4*)(WT + (size_t)(orow0 + n) * Kdim + k0 + 8 * c) = o; }
    asm volatile("s_waitcnt lgkmcnt(0)" ::: "memory");
}
__device__ __forceinline__ void p0_prologue(const Args& a, LAS unsigned char* lds, int gw, int ngw, int lane, int gtid, int ngt) {
    unsigned char* ws = a.ws;
    LAS float* scr = (LAS float*)(lds + (threadIdx.x >> 6) * 16384);
    constexpr int I1 = (DM / 64) * (DIN / 32), I2 = (DR / 64) * (DM / 32), I3 = (DM / 64) * (DM / 32), I5 = (DM / 64) * (2 * DFF / 32), I6 = (DFF / 64) * (DM / 32), I8 = (PLE / 64) * (DM / 32);
    constexpr int NIT = I1 + I2 + I3 + I3 + I5 + I6 + I3 + I8;
    for (int it = gw; it < NIT; it += ngw) {
        int r = it;
        if (r < I1) { const int nb = DIN / 32; p0_transpose_item(a.w_in, DIN, DM, (bf16_t*)(ws + WS_W1), 32 * (r % nb), nullptr, scr, 64 * (r / nb), 32 * (r % nb), lane); continue; } r -= I1;
        if (r < I2) { const int nb = DM / 32; p0_transpose_item(a.w_rnn_out, DM, DR, (bf16_t*)(ws + WS_WRO), 32 * (r % nb), nullptr, scr, 64 * (r / nb), 32 * (r % nb), lane); continue; } r -= I2;
        if (r < I3) { const int nb = DM / 32; p0_transpose_item(a.w_attn_out, DM, DM, (bf16_t*)(ws + WS_WAO), 32 * (r % nb), nullptr, scr, 64 * (r / nb), 32 * (r % nb), lane); continue; } r -= I3;
        if (r < I3) { const int nb = DM / 32; p0_transpose_item(a.w_o, DM, DM, (bf16_t*)(ws + WS_WO), 32 * (r % nb), nullptr, scr, 64 * (r / nb), 32 * (r % nb), lane); continue; } r -= I3;
        if (r < I5) { const int nb = 2 * DFF / 32; const int n0 = 32 * (r % nb); const int isu = n0 >= DFF ? 1 : 0; const int j0 = n0 - isu * DFF; const int orow = (j0 >> 7) * 256 + isu * 128 + (j0 & 127);
                      p0_transpose_item(a.w_gu, 2 * DFF, DM, (bf16_t*)(ws + WS_WGU), orow, a.g_ffn, scr, 64 * (r / nb), n0, lane); continue; } r -= I5;
        if (r < I6) { const int nb = DM / 32; p0_transpose_item(a.w_dn, DM, DFF, (bf16_t*)(ws + WS_WDN), 32 * (r % nb), nullptr, scr, 64 * (r / nb), 32 * (r % nb), lane); continue; } r -= I6;
        if (r < I3) { const int nb = DM / 32; p0_transpose_item(a.w_pg, DM, DM, (bf16_t*)(ws + WS_WPG), 32 * (r % nb), a.g_ple, scr, 64 * (r / nb), 32 * (r % nb), lane); continue; } r -= I3;
        { const int nb = DM / 32; p0_transpose_item(a.w_pp, DM, PLE, (bf16_t*)(ws + WS_WPP), 32 * (r % nb), nullptr, scr, 64 * (r / nb), 32 * (r % nb), lane); }
    }
    bf16_t* hb = (bf16_t*)(ws + WS_HB);
    for (int m = gw; m < M; m += ngw) {
        const f32x4* xr = (const f32x4*)(a.x + (size_t)m * DM) + lane; const f32x4* gr = (const f32x4*)a.g_mix + lane;
        f32x4 v[8]; float s = 0.f;
#pragma unroll
        for (int j = 0; j < 8; ++j) { v[j] = xr[64 * j]; s += (v[j][0] * v[j][0] + v[j][1] * v[j][1]) + (v[j][2] * v[j][2] + v[j][3] * v[j][3]); }
        const float rs = 1.0f / sqrtf(wave_sum(s) * (1.0f / DM) + EPS);
        u32x2* o8 = (u32x2*)(hb + (size_t)m * DM) + lane;
#pragma unroll
        for (int j = 0; j < 8; ++j) { const f32x4 g = gr[64 * j]; u32x2 w; w.x = pk2(v[j][0] * rs * g[0], v[j][1] * rs * g[1]); w.y = pk2(v[j][2] * rs * g[2], v[j][3] * rs * g[3]); o8[64 * j] = w; }
    }
    { const f32x4* pp = (const f32x4*)a.p; u32x2* po = (u32x2*)(ws + WS_PB);
      for (int i = gtid; i < M * PLE / 4; i += ngt) { const f32x4 v = pp[i]; u32x2 w; w.x = pk2(v[0], v[1]); w.y = pk2(v[2], v[3]); po[i] = w; } }
    { bf16_t* wra = (bf16_t*)(ws + WS_WRA); bf16_t* wrx = (bf16_t*)(ws + WS_WRX);
      for (int i = gtid; i < NRB * RB * RBP; i += ngt) { const int c = i % RBP, d = (i / RBP) % RB, n = i / (RBP * RB);
          const size_t src = ((size_t)n * RB + (c < RB ? c : 0)) * RB + d;
          wra[i] = c < RB ? f2bf(a.w_rg_a[src]) : (bf16_t)0; wrx[i] = c < RB ? f2bf(a.w_rg_x[src]) : (bf16_t)0; } }
    { float* z = (float*)(ws + WS_SMALL); for (int i = gtid; i < 2 * M; i += ngt) z[i] = 0.f; }
}

__device__ __forceinline__ void conv_phase(const Args& a, int gtid, int ngt) {
    const bf16_t* xr = (const bf16_t*)(a.ws + WS_XR); bf16_t* xc = (bf16_t*)(a.ws + WS_XC);
    constexpr int NCG = DR / 8;
    for (int it = gtid; it < (M / 8) * NCG; it += ngt) {
        const int cg = it % NCG, rg = it / NCG, c0 = cg * 8, m0 = rg * 8;
        f32x4 w[4][2]; f32x4 bb[2];
#pragma unroll
        for (int j = 0; j < 4; ++j) { w[j][0] = *(const f32x4*)(a.conv_w + (size_t)j * DR + c0); w[j][1] = *(const f32x4*)(a.conv_w + (size_t)j * DR + c0 + 4); }
        bb[0] = *(const f32x4*)(a.conv_b + c0); bb[1] = *(const f32x4*)(a.conv_b + c0 + 4);
        f32x4 win[3][2];
        const bool first = (m0 & (SEQ - 1)) == 0;
#pragma unroll
        for (int j = 0; j < 3; ++j) {
            if (first) { win[j][0] = (f32x4){0.f, 0.f, 0.f, 0.f}; win[j][1] = win[j][0]; }
            else { const u32x4 t = *(const u32x4*)(xr + (size_t)(m0 - 3 + j) * DR + c0); win[j][0] = (f32x4){pg8::bflo(t.x), pg8::bfhi(t.x), pg8::bflo(t.y), pg8::bfhi(t.y)}; win[j][1] = (f32x4){pg8::bflo(t.z), pg8::bfhi(t.z), pg8::bflo(t.w), pg8::bfhi(t.w)}; } }
#pragma unroll
        for (int i = 0; i < 8; ++i) {
            const u32x4 t = *(const u32x4*)(xr + (size_t)(m0 + i) * DR + c0);
            const f32x4 c0v = (f32x4){pg8::bflo(t.x), pg8::bfhi(t.x), pg8::bflo(t.y), pg8::bfhi(t.y)}, c1v = (f32x4){pg8::bflo(t.z), pg8::bfhi(t.z), pg8::bflo(t.w), pg8::bfhi(t.w)};
            const f32x4 y0 = bb[0] + w[0][0] * win[0][0] + w[1][0] * win[1][0] + w[2][0] * win[2][0] + w[3][0] * c0v;
            const f32x4 y1 = bb[1] + w[0][1] * win[0][1] + w[1][1] * win[1][1] + w[2][1] * win[2][1] + w[3][1] * c1v;
            *(u32x4*)(xc + (size_t)(m0 + i) * DR + c0) = pg8::pack8(y0, y1);
            win[0][0] = win[1][0]; win[0][1] = win[1][1]; win[1][0] = win[2][0]; win[1][1] = win[2][1]; win[2][0] = c0v; win[2][1] = c1v;
        }
    }
}

typedef short v4i16_t __attribute__((ext_vector_type(4)));
__device__ __forceinline__ s16x4 vtr(const LAS unsigned char* p) { return __builtin_bit_cast(s16x4, __builtin_amdgcn_ds_read_tr16_b64_v4i16((LAS v4i16_t*)p)); }
__device__ __forceinline__ void attn_unit(int b, int hh, int qb, const bf16_t* __restrict__ qn, const bf16_t* __restrict__ kn, const bf16_t* __restrict__ vv, bf16_t* __restrict__ ob, LAS unsigned char* vst, int lane) {
    const int r = lane & 31, h = lane >> 5;
    const size_t rowb = (size_t)b * SEQ;
    const int q0 = qb * 32;
    bf16x8 qf[8];
    { const bf16_t* qp = qn + (rowb + q0 + r) * DM + hh * HD + 8 * h;
#pragma unroll
      for (int ks = 0; ks < 8; ++ks) qf[ks] = *(const bf16x8*)(qp + 16 * ks); }
    f32x16 o[4];
#pragma unroll
    for (int d = 0; d < 4; ++d)
#pragma unroll
        for (int i = 0; i < 16; ++i) o[d][i] = 0.f;
    float R = 0.f;
    const int vrow = lane >> 4, vch = lane & 15;
    const int i16 = lane & 15, tq = i16 >> 2, tp = i16 & 3, blk = (lane >> 4) & 1;
    const LAS unsigned char* trb = vst + (4 * h + tq) * VST_PITCH + (16 * blk + 4 * tp) * 2;
    for (int kb = qb; kb >= 0; --kb) {
        const int k0 = kb * 32;
        bf16x8 kf[8];
        { const bf16_t* kp = kn + (rowb + k0 + r) * DM + hh * HD + 8 * h;
#pragma unroll
          for (int ks = 0; ks < 8; ++ks) kf[ks] = *(const bf16x8*)(kp + 16 * ks); }
        u32x4 vt[8];
        { const bf16_t* vp = vv + (rowb + k0 + vrow) * DM + hh * HD + 8 * vch;
#pragma unroll
          for (int i = 0; i < 8; ++i) vt[i] = *(const u32x4*)(vp + (size_t)(4 * i) * DM); }
#pragma unroll
        for (int i = 0; i < 8; ++i) *(LAS u32x4*)(vst + (vrow + 4 * i) * VST_PITCH + 16 * vch) = vt[i];
        f32x16 x;
#pragma unroll
        for (int i = 0; i < 16; ++i) x[i] = 0.f;
#pragma unroll
        for (int ks = 0; ks < 8; ++ks) x = MFMA32(kf[ks], qf[ks], x);
        const bool diag = (kb == qb);
        float lk[16], zz[16];
#pragma unroll
        for (int i = 0; i < 16; ++i) { const float z = x[i]; const bool valid = !diag || crow(i, h) < r; lk[i] = valid ? -softplusf_(z) : 0.f; zz[i] = valid ? z : -1e30f; }
        float I[16], T[4], To[4];
#pragma unroll
        for (int g = 0; g < 4; ++g) { I[4 * g + 3] = lk[4 * g + 3]; I[4 * g + 2] = I[4 * g + 3] + lk[4 * g + 2]; I[4 * g + 1] = I[4 * g + 2] + lk[4 * g + 1]; I[4 * g] = I[4 * g + 1] + lk[4 * g]; T[g] = I[4 * g]; }
#pragma unroll
        for (int g = 0; g < 4; ++g) To[g] = __shfl_xor(T[g], 32);
        const float U0 = T[0] + To[0], U1 = T[1] + To[1], U2 = T[2] + To[2], U3 = T[3] + To[3];
        float C[4]; C[3] = 0.f; C[2] = U3; C[1] = U3 + U2; C[0] = C[1] + U1;
        const float tot = C[0] + U0;
        float w[16];
#pragma unroll
        for (int g = 0; g < 4; ++g) { const float off = C[g] + (h == 0 ? To[g] : 0.f) + R;
#pragma unroll
            for (int j = 0; j < 4; ++j) w[4 * g + j] = __builtin_amdgcn_exp2f((zz[4 * g + j] + I[4 * g + j] + off) * LOG2E); }
        R += tot;
        bf16x8 xs[2];
#pragma unroll
        for (int s = 0; s < 2; ++s) { u32x4 pw; pw.x = pk2(w[8 * s], w[8 * s + 1]); pw.y = pk2(w[8 * s + 2], w[8 * s + 3]); pw.z = pk2(w[8 * s + 4], w[8 * s + 5]); pw.w = pk2(w[8 * s + 6], w[8 * s + 7]); xs[s] = __builtin_bit_cast(bf16x8, pw); }
#pragma unroll
        for (int db = 0; db < 4; ++db)
#pragma unroll
            for (int s = 0; s < 2; ++s) {
                const s16x4 lo = vtr(trb + (16 * s) * VST_PITCH + db * 64), hi = vtr(trb + (16 * s + 8) * VST_PITCH + db * 64);
                const bf16x8 vf = __builtin_shufflevector(lo, hi, 0, 1, 2, 3, 4, 5, 6, 7);
                o[db] = MFMA32(vf, xs[s], o[db]);
            }
        if (__all(R < -88.0f)) break;
    }
    bf16_t* op = ob + (rowb + q0 + r) * DM + hh * HD + 4 * h;
#pragma unroll
    for (int db = 0; db < 4; ++db)
#pragma unroll
        for (int g = 0; g < 4; ++g) { u32x2 wv; wv.x = pk2(o[db][4 * g], o[db][4 * g + 1]); wv.y = pk2(o[db][4 * g + 2], o[db][4 * g + 3]); *(u32x2*)(op + 32 * db + 8 * g) = wv; }
}

template <bool PASSB>
__device__ __forceinline__ void rnn_unit(int b, int n, int ct, int c, const Args& a, int lane) {
    const bf16_t* xc = (const bf16_t*)(a.ws + WS_XC); const bf16_t* gg = (const bf16_t*)(a.ws + WS_GG); bf16_t* ar = (bf16_t*)(a.ws + WS_AR);
    const bf16_t* wra = (const bf16_t*)(a.ws + WS_WRA); const bf16_t* wrx = (const bf16_t*)(a.ws + WS_WRX); float* summ = (float*)(a.ws + WS_SMALL + SM_SUMM);
    const int r = lane & 31, h = lane >> 5;
    const int chl = ct * 32 + r; const bool chv = chl < RB; const int chc = chv ? chl : RB - 1; const int ch = n * RB + chc;
    bf16x8 wa[11], wx[11];
    { const bf16_t* pa = wra + (size_t)(n * RB + chc) * RBP + 8 * h; const bf16_t* px = wrx + (size_t)(n * RB + chc) * RBP + 8 * h;
#pragma unroll
      for (int ks = 0; ks < 11; ++ks) { wa[ks] = *(const bf16x8*)(pa + 16 * ks); wx[ks] = *(const bf16x8*)(px + 16 * ks); } }
    const float bav = a.b_rg_a[ch], bxv = a.b_rg_x[ch]; const float l = a.lam[ch];
    const float cl = 8.0f * (fmaxf(-l, 0.f) + log1pf(expf(-fabsf(l))));
    float hc = 0.f, Pc = 1.f;
    if (PASSB) { for (int cp = 0; cp < c; ++cp) { const float* sp = summ + ((size_t)(b * NCHUNK + cp) * DR + ch) * 2; hc = sp[0] * hc + sp[1]; } }
    for (int tt = 0; tt < 4; ++tt) {
        const size_t m0 = (size_t)b * SEQ + c * CHUNK + tt * 32;
        f32x16 aa, ax;
#pragma unroll
        for (int i = 0; i < 16; ++i) { aa[i] = 0.f; ax[i] = 0.f; }
        { const bf16_t* ap = xc + (m0 + r) * DR + n * RB + 8 * h;
#pragma unroll
          for (int ks = 0; ks < 11; ++ks) { const bf16x8 af = *(const bf16x8*)(ap + 16 * ks); aa = MFMA32(af, wa[ks], aa); ax = MFMA32(af, wx[ks], ax); } }
        float av[16], uv[16];
#pragma unroll
        for (int i = 0; i < 16; ++i) { const size_t tok = m0 + crow(i, h); const float xv = bf2f(xc[tok * DR + ch]);
            const float rg = sigmoidf_(aa[i] + bav), ig = sigmoidf_(ax[i] + bxv); const float la = -cl * rg; av[i] = __builtin_amdgcn_exp2f(la * LOG2E);
            const float t2 = 2.0f * la;
            const float om = t2 > -0.3f ? -t2 * (1.0f + t2 * (0.5f + t2 * (0.16666667f + t2 * (0.041666667f + t2 * 0.0083333333f)))) : 1.0f - __builtin_amdgcn_exp2f(t2 * LOG2E);
            uv[i] = sqrtf(om) * (ig * xv); }
        float pc[16], hl[16], Pg[4], Hg[4], Pgo[4], Hgo[4];
#pragma unroll
        for (int g = 0; g < 4; ++g) { float P = 1.f, H = 0.f;
#pragma unroll
            for (int j = 0; j < 4; ++j) { H = av[4 * g + j] * H + uv[4 * g + j]; P = P * av[4 * g + j]; pc[4 * g + j] = P; hl[4 * g + j] = H; }
            Pg[g] = P; Hg[g] = H; }
#pragma unroll
        for (int g = 0; g < 4; ++g) { Pgo[g] = __shfl_xor(Pg[g], 32); Hgo[g] = __shfl_xor(Hg[g], 32); }
        float cur = hc, cin[4];
#pragma unroll
        for (int g = 0; g < 4; ++g) { const float P0 = h == 0 ? Pg[g] : Pgo[g], H0 = h == 0 ? Hg[g] : Hgo[g], P1 = h == 0 ? Pgo[g] : Pg[g], H1 = h == 0 ? Hgo[g] : Hg[g];
            const float c0 = cur; cur = P0 * cur + H0; const float c1 = cur; cur = P1 * cur + H1; cin[g] = h == 0 ? c0 : c1; Pc *= P0 * P1; }
        hc = cur;
        if (PASSB) {
#pragma unroll
            for (int i = 0; i < 16; ++i) { const size_t tok = m0 + crow(i, h); const float hv = hl[i] + pc[i] * cin[i >> 2]; const float y = bf2f(gg[tok * DR + ch]) * hv; if (chv) ar[tok * DR + ch] = f2bf(y); } }
    }
    if (!PASSB && chv && h == 0) { float* sp = summ + ((size_t)(b * NCHUNK + c) * DR + ch) * 2; sp[0] = Pc; sp[1] = hc; }
}

namespace cg = cooperative_groups;
__global__ void __launch_bounds__(NTHREADS, 2) fwd(Args a) {
    extern __shared__ __attribute__((aligned(16))) unsigned char lds_raw[];
    LAS unsigned char* lds = (LAS unsigned char*)lds_raw;
    const int tid = threadIdx.x, lane = tid & 63, wave = __builtin_amdgcn_readfirstlane(tid >> 6);
    const int G = gridDim.x, bx = blockIdx.x;
    const int gw = bx * NWAVES + wave, ngw = G * NWAVES, gtid = bx * NTHREADS + tid, ngt = G * NTHREADS;
    unsigned char* ws = a.ws;
    const int lo = a.ph_lo, hi = a.ph_hi, mask = a.mask;
#define IN(k) (lo <= (k) && (k) < hi)
#define SEAM(k) do { if (IN(k) && IN((k) + 1)) cg::this_grid().sync(); } while (0)
    bf16_t* hb = (bf16_t*)(ws + WS_HB); bf16_t* qn = (bf16_t*)(ws + WS_QN); bf16_t* kn = (bf16_t*)(ws + WS_KN); bf16_t* vv = (bf16_t*)(ws + WS_VV); bf16_t* xr = (bf16_t*)(ws + WS_XR);
    bf16_t* gg = (bf16_t*)(ws + WS_GG); bf16_t* sgr = (bf16_t*)(ws + WS_SGR); bf16_t* sga = (bf16_t*)(ws + WS_SGA); bf16_t* pb = (bf16_t*)(ws + WS_PB);
    bf16_t* ob = (bf16_t*)(ws + WS_OB); float* mixa = (float*)(ws + WS_MIXA); float* Pp = (float*)(ws + WS_PP); bf16_t* ar = (bf16_t*)(ws + WS_AR); bf16_t* mixb = (bf16_t*)(ws + WS_MIXB);
    bf16_t* x1b = (bf16_t*)(ws + WS_X1B); bf16_t* x2b = (bf16_t*)(ws + WS_X2B); bf16_t* act = (bf16_t*)(ws + WS_ACT);
    float* ssq1 = (float*)(ws + WS_SMALL + SM_SSQ1); float* ssq2 = (float*)(ws + WS_SMALL + SM_SSQ2);

#ifndef NO_P0
    if (IN(0)) { if (mask & F_P0) p0_prologue(a, lds, gw, ngw, lane, gtid, ngt); }
#endif
    SEAM(0);
    if (PHON(1) && IN(1) && (mask & F_G1)) {
        pg8::Gemm g{hb, (const bf16_t*)(ws + WS_W1), M, DIN, DM}; pg8::StaticOrder S; S.init(M, DIN, G, bx);
        pg8::Epi1 E{xr, gg, qn, kn, vv, sgr, sga, a.q_gain, a.k_gain, (LAS float*)(lds + XCH_OFF)};
        pg8::gemm_phase<pg8::Epi1, pg8::StaticOrder, true, true>(lds, g, S, E);
    }
    SEAM(1);
    if (IN(2)) {
#ifndef NO_CONV
        if (mask & F_CONV) conv_phase(a, gtid, ngt);
#endif
#ifndef NO_ATTN
        if (mask & F_ATTN) { LAS unsigned char* vst = lds + wave * VST_BYTES;
            for (int u = gw; u < NBATCH * NH * (SEQ / 32); u += ngw) attn_unit(u >> 11, (u >> 7) & 15, u & 127, qn, kn, vv, ob, vst, lane); }
#endif
    }
    SEAM(2);
    if (IN(3)) {
#ifndef NO_RNNA
        if (mask & F_RNN) { for (int u = gw; u < NBATCH * NRB * 6 * NCHUNK; u += ngw) { const int nct = u >> 6; rnn_unit<false>((u >> 5) & 1, nct / 6, nct % 6, u & 31, a, lane); } }
#endif
        if (PHON(3) && (mask & F_YA)) {
            __syncthreads();
            { pg8::Gemm g{ob, (const bf16_t*)(ws + WS_WAO), M, DM, DM}; pg8::StaticOrder S; S.init(M, DM, G, bx); pg8::EpiMixA E{mixa, sga, DM};
              pg8::gemm_phase<pg8::EpiMixA, pg8::StaticOrder, true, true>(lds, g, S, E); }
            { pg8::Gemm g{pb, (const bf16_t*)(ws + WS_WPP), M, DM, PLE}; pg8::StaticOrder S; S.init(M, DM, G, bx); pg8::EpiMixA E{Pp, nullptr, DM};
              pg8::gemm_phase<pg8::EpiMixA, pg8::StaticOrder, true, true>(lds, g, S, E); }
        }
    }
    SEAM(3);
#ifndef NO_RNNB
    if (IN(4) && (mask & F_RNN)) { for (int u = gw; u < NBATCH * NRB * 6 * NCHUNK; u += ngw) { const int nct = u >> 6; rnn_unit<true>((u >> 5) & 1, nct / 6, nct % 6, u & 31, a, lane); } }
#endif
    SEAM(4);
    if (PHON(5) && IN(5) && (mask & F_YR)) { pg8::Gemm g{ar, (const bf16_t*)(ws + WS_WRO), M, DM, DR}; pg8::StaticOrder S; S.init(M, DM, G, bx); pg8::EpiMixB E{mixb, mixa, sgr, DM};
        pg8::gemm_phase<pg8::EpiMixB, pg8::StaticOrder, true, true>(lds, g, S, E); }
    SEAM(5);
    if (PHON(6) && IN(6) && (mask & F_WO)) { pg8::Gemm g{mixb, (const bf16_t*)(ws + WS_WO), M, DM, DM}; pg8::StaticOrder S; S.init(M, DM, G, bx); pg8::EpiRes E{a.x, a.out, x1b, ssq1, DM};
        pg8::gemm_phase<pg8::EpiRes, pg8::StaticOrder, true, true>(lds, g, S, E); }
    SEAM(6);
    if (PHON(7) && IN(7) && (mask & F_FFU)) { pg8::Gemm g{x1b, (const bf16_t*)(ws + WS_WGU), M, 2 * DFF, DM}; pg8::StaticOrder S; S.init(M, 2 * DFF, G, bx); pg8::EpiFfn E{act, ssq1, DFF};
        pg8::gemm_phase<pg8::EpiFfn, pg8::StaticOrder, true, true>(lds, g, S, E); }
    SEAM(7);
    if (PHON(8) && IN(8) && (mask & F_FFD)) { pg8::Gemm g{act, (const bf16_t*)(ws + WS_WDN), M, DM, DFF}; pg8::StaticOrder S; S.init(M, DM, G, bx); pg8::EpiRes E{a.out, a.out, x2b, ssq2, DM};
        pg8::gemm_phase<pg8::EpiRes, pg8::StaticOrder, true, true>(lds, g, S, E); }
    SEAM(8);
    if (PHON(9) && IN(9) && (mask & F_PLE)) { pg8::Gemm g{x2b, (const bf16_t*)(ws + WS_WPG), M, DM, DM}; pg8::StaticOrder S; S.init(M, DM, G, bx); pg8::EpiPle E{a.out, Pp, a.out, ssq2, DM};
        pg8::gemm_phase<pg8::EpiPle, pg8::StaticOrder, true, true>(lds, g, S, E); }
#undef IN
#undef SEAM
}

#ifndef FASTMASK
#define FASTMASK F_ALL
#endif
#ifndef ONE_LAUNCH
#define ONE_LAUNCH 1
#endif
extern "C" void kernel_launch(void* const* d_in, const int* in_sizes, int n_in, void* d_out, int out_size, void* d_ws, size_t ws_size, hipStream_t stream) {
    if (n_in != 22 || out_size != M * DM || ws_size < WS_END) { fprintf(stderr, "kernel_launch: unexpected sizes n_in %d out %d ws %zu\n", n_in, out_size, ws_size); return; }
    const float* x = (const float*)d_in[0]; const float* p = (const float*)d_in[1]; const float* g_mix = (const float*)d_in[2]; const float* w_in = (const float*)d_in[3];
    const float* conv_w = (const float*)d_in[4]; const float* conv_b = (const float*)d_in[5]; const float* w_rg_a = (const float*)d_in[6]; const float* b_rg_a = (const float*)d_in[7];
    const float* w_rg_x = (const float*)d_in[8]; const float* b_rg_x = (const float*)d_in[9]; const float* lam = (const float*)d_in[10]; const float* q_gain = (const float*)d_in[11];
    const float* k_gain = (const float*)d_in[12]; const float* w_rnn_out = (const float*)d_in[13]; const float* w_attn_out = (const float*)d_in[14]; const float* w_o = (const float*)d_in[15];
    const float* g_ffn = (const float*)d_in[16]; const float* w_gu = (const float*)d_in[17]; const float* w_dn = (const float*)d_in[18]; const float* g_ple = (const float*)d_in[19];
    const float* w_pg = (const float*)d_in[20]; const float* w_pp = (const float*)d_in[21];
    float* out = (float*)d_out; unsigned char* ws = (unsigned char*)d_ws;
    bf16_t* hb = (bf16_t*)(ws + WS_HB); bf16_t* qn = (bf16_t*)(ws + WS_QN); bf16_t* kn = (bf16_t*)(ws + WS_KN); bf16_t* vv = (bf16_t*)(ws + WS_VV); bf16_t* xr = (bf16_t*)(ws + WS_XR);
    bf16_t* gg = (bf16_t*)(ws + WS_GG); bf16_t* sgr = (bf16_t*)(ws + WS_SGR); bf16_t* sga = (bf16_t*)(ws + WS_SGA); bf16_t* pb = (bf16_t*)(ws + WS_PB); bf16_t* xc = (bf16_t*)(ws + WS_XC);
    bf16_t* ob = (bf16_t*)(ws + WS_OB); float* mixa = (float*)(ws + WS_MIXA); float* Pp = (float*)(ws + WS_PP); bf16_t* ar = (bf16_t*)(ws + WS_AR); bf16_t* mixb = (bf16_t*)(ws + WS_MIXB);
    bf16_t* x1b = (bf16_t*)(ws + WS_X1B); bf16_t* x2b = (bf16_t*)(ws + WS_X2B); bf16_t* act = (bf16_t*)(ws + WS_ACT);
    float* ssq1 = (float*)(ws + WS_SMALL + SM_SSQ1); float* ssq2 = (float*)(ws + WS_SMALL + SM_SSQ2);

    static int grid = 0;
    if (grid == 0) {
        int dev = 0, cus = 0, per_cu = 0;
        if (hipGetDevice(&dev) != hipSuccess || hipDeviceGetAttribute(&cus, hipDeviceAttributeMultiprocessorCount, dev) != hipSuccess) { fprintf(stderr, "kernel_launch: device query failed\n"); grid = -1; return; }
        if (hipFuncSetAttribute((const void*)fwd, hipFuncAttributeMaxDynamicSharedMemorySize, LDS_BYTES) != hipSuccess) { fprintf(stderr, "kernel_launch: hipFuncSetAttribute failed\n"); grid = -1; return; }
        if (hipOccupancyMaxActiveBlocksPerMultiprocessor(&per_cu, (const void*)fwd, NTHREADS, LDS_BYTES) != hipSuccess || per_cu < 1) { fprintf(stderr, "kernel_launch: occupancy query says %d blocks per CU\n", per_cu); (void)hipGetLastError(); grid = -1; return; }
        grid = cus;
    }
    if (grid < 0) return;
    Args a{};
    a.x = x; a.p = p; a.g_mix = g_mix; a.w_in = w_in; a.conv_w = conv_w; a.conv_b = conv_b; a.w_rg_a = w_rg_a; a.b_rg_a = b_rg_a; a.w_rg_x = w_rg_x; a.b_rg_x = b_rg_x; a.lam = lam;
    a.q_gain = q_gain; a.k_gain = k_gain; a.w_rnn_out = w_rnn_out; a.w_attn_out = w_attn_out; a.w_o = w_o; a.g_ffn = g_ffn; a.w_gu = w_gu; a.w_dn = w_dn; a.g_ple = g_ple; a.w_pg = w_pg; a.w_pp = w_pp;
    a.out = out; a.ws = ws;
#if ONE_LAUNCH
    a.ph_lo = 0; a.ph_hi = 10; a.mask = F_ALL;
    void* kargs[] = {&a};
    hipError_t e = hipLaunchCooperativeKernel((const void*)fwd, dim3(grid), dim3(NTHREADS), kargs, LDS_BYTES, stream);
    if (e != hipSuccess) fprintf(stderr, "kernel_launch: cooperative launch failed: %s (grid %d)\n", hipGetErrorString(e), grid);
#else
    constexpr int FM = FASTMASK;
    auto fast = [&](int ph, int mask) { if (!mask) return; a.ph_lo = ph; a.ph_hi = ph + 1; a.mask = mask; hipLaunchKernelGGL(fwd, dim3(grid), dim3(NTHREADS), LDS_BYTES, stream, a); };
    auto gemm1 = [&](const bf16_t* A, int lda, const float* W, int ldw, int wcol, const float* ks, int K, int N, NvEpi e) {
        nv_gemm<1><<<dim3(N / 64, M / 64), 256, 0, stream>>>(A, lda, W + wcol, nullptr, ldw, ks, K, e); };
    NvEpi e{};
    fast(0, F_P0);
    if (!(FM & F_P0)) { nv_rmsnorm<<<M / 4, 256, 0, stream>>>(x, g_mix, hb); nv_cvt<<<2048, 256, 0, stream>>>(p, pb, M * PLE); }
    if (FM & F_G1) fast(1, F_G1);
    else {
        e = NvEpi{}; e.mode = 0; e.O = xr; e.ldo = DR; gemm1(hb, DM, w_in, DIN, 0, nullptr, DM, DR, e);
        e = NvEpi{}; e.mode = 1; e.O = gg; e.ldo = DR; gemm1(hb, DM, w_in, DIN, DR, nullptr, DM, DR, e);
        e = NvEpi{}; e.mode = 0; e.O = qn; e.ldo = DM; gemm1(hb, DM, w_in, DIN, 2 * DR, nullptr, DM, DM, e);
        e = NvEpi{}; e.mode = 0; e.O = kn; e.ldo = DM; gemm1(hb, DM, w_in, DIN, 2 * DR + DM, nullptr, DM, DM, e);
        e = NvEpi{}; e.mode = 0; e.O = vv; e.ldo = DM; gemm1(hb, DM, w_in, DIN, 2 * DR + 2 * DM, nullptr, DM, DM, e);
        e = NvEpi{}; e.mode = 2; e.O = sgr; e.ldo = DM; gemm1(hb, DM, w_in, DIN, 2 * DR + 3 * DM, nullptr, DM, DM, e);
        e = NvEpi{}; e.mode = 2; e.O = sga; e.ldo = DM; gemm1(hb, DM, w_in, DIN, 2 * DR + 4 * DM, nullptr, DM, DM, e);
        nv_headnorm<<<M * NH / 4, 256, 0, stream>>>(qn, q_gain, 0.08838834764831845f);
        nv_headnorm<<<M * NH / 4, 256, 0, stream>>>(kn, k_gain, 1.0f);
    }
    fast(2, FM & (F_CONV | F_ATTN));
    if (!(FM & F_CONV)) nv_conv<<<4096, 256, 0, stream>>>(xr, conv_w, conv_b, xc);
    if (!(FM & F_ATTN)) nv_attn<<<NBATCH * NH * SEQ / 4, 256, 0, stream>>>(qn, kn, vv, ob);
    fast(3, FM & (F_RNN | F_YA));
    if (!(FM & F_YA)) {
        e = NvEpi{}; e.mode = 3; e.F = mixa; e.ldf = DM; e.G = sga; e.ldg = DM; gemm1(ob, DM, w_attn_out, DM, 0, nullptr, DM, DM, e);
        e = NvEpi{}; e.mode = 4; e.F = Pp; e.ldf = DM; gemm1(pb, PLE, w_pp, DM, 0, nullptr, PLE, DM, e);
    }
    if (FM & F_RNN) fast(4, F_RNN);
    else nv_rnn<<<NBATCH * NRB, 192, 0, stream>>>(xc, gg, w_rg_a, b_rg_a, w_rg_x, b_rg_x, lam, ar);
    if (FM & F_YR) fast(5, F_YR);
    else { e = NvEpi{}; e.mode = 5; e.O = mixb; e.ldo = DM; e.F = mixa; e.ldf = DM; e.G = sgr; e.ldg = DM; gemm1(ar, DR, w_rnn_out, DM, 0, nullptr, DR, DM, e); }
    if (FM & F_WO) fast(6, F_WO);
    else { e = NvEpi{}; e.mode = 6; e.O = x1b; e.ldo = DM; e.F = out; e.ldf = DM; e.X = x; gemm1(mixb, DM, w_o, DM, 0, nullptr, DM, DM, e); nv_rowssq<<<M / 4, 256, 0, stream>>>(out, ssq1); }
    if (FM & F_FFU) fast(7, F_FFU);
    else { e = NvEpi{}; e.mode = 7; e.O = act; e.ldo = DFF; e.ssq = ssq1; nv_gemm<2><<<dim3(DFF / 64, M / 64), 256, 0, stream>>>(x1b, DM, w_gu, w_gu + DFF, 2 * DFF, g_ffn, DM, e); }
    if (FM & F_FFD) fast(8, F_FFD);
    else { e = NvEpi{}; e.mode = 6; e.O = x2b; e.ldo = DM; e.F = out; e.ldf = DM; e.X = out; gemm1(act, DFF, w_dn, DM, 0, nullptr, DFF, DM, e); nv_rowssq<<<M / 4, 256, 0, stream>>>(out, ssq2); }
    if (FM & F_PLE) fast(9, F_PLE);
    else { e = NvEpi{}; e.mode = 8; e.F = out; e.ldf = DM; e.X = out; e.P = Pp; e.ssq = ssq2; gemm1(x2b, DM, w_pg, DM, 0, g_ple, DM, DM, e); }
#endif
}
```

```cpp
#include <hip/hip_runtime.h>
#include <hip/hip_cooperative_groups.h>
#include <cstdio>
#include <cstdint>

typedef unsigned short bf16_t;
typedef float f32x4 __attribute__((ext_vector_type(4)));
typedef unsigned u32x4 __attribute__((ext_vector_type(4)));
typedef unsigned u32x2 __attribute__((ext_vector_type(2)));
typedef short bf16x8 __attribute__((ext_vector_type(8)));
typedef short s16x4 __attribute__((ext_vector_type(4)));
typedef float f32x16 __attribute__((ext_vector_type(16)));
#define LAS __attribute__((address_space(3)))

constexpr int SEQ = 4096, NBATCH = 2, M = NBATCH * SEQ, DM = 2048, DR = 2816, DIN = 15872, DFF = 5632, PLE = 256, NH = 16, HD = 128;
constexpr int NRB = 16, RB = 176, RBP = 192, NCHUNK = 32, CHUNK = 128;
constexpr float EPS = 1e-6f;
constexpr float LOG2E = 1.4426950408889634f, LN2 = 0.6931471805599453f;

constexpr size_t MiB = (size_t)1 << 20;
constexpr size_t WS_WRO = 0, WS_WAO = 11 * MiB, WS_WO = 19 * MiB, WS_WGU = 27 * MiB, WS_WDN = 71 * MiB, WS_WPG = 93 * MiB, WS_WPP = 101 * MiB, WS_WRA = 102 * MiB, WS_WRX = 102 * MiB + 1536 * 1024;
constexpr size_t WS_W1 = 106 * MiB, WS_HB = 168 * MiB, WS_QN = 200 * MiB, WS_KN = 232 * MiB, WS_VV = 264 * MiB, WS_XR = 296 * MiB, WS_GG = 340 * MiB, WS_SGR = 384 * MiB, WS_SGA = 416 * MiB, WS_PB = 448 * MiB, WS_SMALL = 460 * MiB, WS_END = 464 * MiB;
constexpr size_t WS_XC = WS_W1, WS_OB = WS_HB, WS_MIXA = WS_QN, WS_PP = WS_VV, WS_AR = WS_SGA, WS_MIXB = WS_W1, WS_X1B = WS_GG, WS_X2B = WS_GG, WS_ACT = WS_W1;
constexpr size_t SM_SSQ1 = 0, SM_SSQ2 = 32768, SM_SUMM = 65536;

__device__ __forceinline__ float bf2f(bf16_t b) { return __uint_as_float((unsigned)b << 16); }
__device__ __forceinline__ bf16_t f2bf(float f) { unsigned u = __float_as_uint(f); return (bf16_t)((u + 0x7fffu + ((u >> 16) & 1u)) >> 16); }
__device__ __forceinline__ float rbf(float f) { return bf2f(f2bf(f)); }
__device__ __forceinline__ float sigmoidf_(float x) { return __builtin_amdgcn_rcpf(1.0f + __builtin_amdgcn_exp2f(-x * LOG2E)); }
__device__ __forceinline__ float gelu_tanh(float x) { const float y = 0.7978845608028654f * (x + 0.044715f * x * x * x); return x * __builtin_amdgcn_rcpf(1.0f + __builtin_amdgcn_exp2f(-2.0f * LOG2E * y)); }
__device__ __forceinline__ float softplusf_(float z) { return fmaxf(z, 0.f) + LN2 * __builtin_amdgcn_logf(1.0f + __builtin_amdgcn_exp2f(-fabsf(z) * LOG2E)); }
__device__ __forceinline__ float wave_sum(float v) {
#pragma unroll
    for (int o = 1; o < 64; o <<= 1) v += __shfl_xor(v, o);
    return v;
}

__global__ __launch_bounds__(256) void nv_rmsnorm(const float* __restrict__ x, const float* __restrict__ g, bf16_t* __restrict__ out) {
    const int row = blockIdx.x * 4 + (threadIdx.x >> 6), lane = threadIdx.x & 63;
    const float* xr = x + (size_t)row * DM;
    float s = 0.f;
    for (int c = lane; c < DM; c += 64) { const float v = xr[c]; s += v * v; }
    s = wave_sum(s);
    const float rs = 1.0f / sqrtf(s * (1.0f / DM) + EPS);
    for (int c = lane; c < DM; c += 64) out[(size_t)row * DM + c] = f2bf(xr[c] * rs * g[c]);
}
__global__ __launch_bounds__(256) void nv_cvt(const float* __restrict__ in, bf16_t* __restrict__ out, int n) {
    for (int i = blockIdx.x * 256 + threadIdx.x; i < n; i += gridDim.x * 256) out[i] = f2bf(in[i]);
}
__global__ __launch_bounds__(256) void nv_rowssq(const float* __restrict__ x, float* __restrict__ ssq) {
    const int row = blockIdx.x * 4 + (threadIdx.x >> 6), lane = threadIdx.x & 63;
    float s = 0.f;
    for (int c = lane; c < DM; c += 64) { const float v = x[(size_t)row * DM + c]; s += v * v; }
    s = wave_sum(s);
    if (lane == 0) ssq[row] = s;
}

struct NvEpi {
    int mode;
    bf16_t* O; int ldo;
    float* F; int ldf;
    const bf16_t* G; int ldg;
    const float* X;
    const float* P;
    const float* ssq;
    __device__ __forceinline__ void operator()(int m, int n, float a0, float a1) const {
        switch (mode) {
            case 0: O[(size_t)m * ldo + n] = f2bf(a0); break;
            case 1: O[(size_t)m * ldo + n] = f2bf(gelu_tanh(a0)); break;
            case 2: O[(size_t)m * ldo + n] = f2bf(sigmoidf_(a0)); break;
            case 3: F[(size_t)m * ldf + n] = bf2f(G[(size_t)m * ldg + n]) * a0; break;
            case 4: F[(size_t)m * ldf + n] = a0; break;
            case 5: O[(size_t)m * ldo + n] = f2bf(F[(size_t)m * ldf + n] + bf2f(G[(size_t)m * ldg + n]) * a0); break;
            case 6: { const float v = X[(size_t)m * ldf + n] + a0; F[(size_t)m * ldf + n] = v; O[(size_t)m * ldo + n] = f2bf(v); } break;
            case 7: { const float rs = 1.0f / sqrtf(ssq[m] * (1.0f / DM) + EPS); const float g = rs * a0, u = rs * a1; O[(size_t)m * ldo + n] = f2bf(g * sigmoidf_(g) * u); } break;
            case 8: { const float rs = 1.0f / sqrtf(ssq[m] * (1.0f / DM) + EPS); F[(size_t)m * ldf + n] = X[(size_t)m * ldf + n] + sigmoidf_(rs * a0) * P[(size_t)m * ldf + n]; } break;
        }
    }
};
template <int NB>
__global__ __launch_bounds__(256) void nv_gemm(const bf16_t* __restrict__ A, int lda, const float* __restrict__ W0, const float* __restrict__ W1, int ldw, const float* __restrict__ ks, int K, NvEpi epi) {
    __shared__ float As[16][68];
    __shared__ float Bs[NB][16][68];
    const int tid = threadIdx.x, tx = tid & 15, ty = tid >> 4;
    const int m0 = blockIdx.y * 64, n0 = blockIdx.x * 64;
    float acc[NB][4][4];
#pragma unroll
    for (int b = 0; b < NB; ++b)
#pragma unroll
        for (int i = 0; i < 4; ++i)
#pragma unroll
            for (int j = 0; j < 4; ++j) acc[b][i][j] = 0.f;
    for (int k0 = 0; k0 < K; k0 += 16) {
        { const int r = tid >> 2, kk = (tid & 3) * 4; const bf16_t* ap = A + (size_t)(m0 + r) * lda + k0 + kk;
#pragma unroll
          for (int j = 0; j < 4; ++j) As[kk + j][r] = bf2f(ap[j]); }
        { const int kk = tid >> 4, nn = (tid & 15) * 4; const float sc = ks ? ks[k0 + kk] : 1.0f;
          const f32x4 w0 = *(const f32x4*)(W0 + (size_t)(k0 + kk) * ldw + n0 + nn);
#pragma unroll
          for (int j = 0; j < 4; ++j) Bs[0][kk][nn + j] = rbf(w0[j] * sc);
          if (NB == 2) { const f32x4 w1 = *(const f32x4*)(W1 + (size_t)(k0 + kk) * ldw + n0 + nn);
#pragma unroll
              for (int j = 0; j < 4; ++j) Bs[NB - 1][kk][nn + j] = rbf(w1[j] * sc); } }
        __syncthreads();
#pragma unroll
        for (int kk = 0; kk < 16; ++kk) {
            const f32x4 a = *(const f32x4*)&As[kk][ty * 4];
#pragma unroll
            for (int b = 0; b < NB; ++b) { const f32x4 w = *(const f32x4*)&Bs[b][kk][tx * 4];
#pragma unroll
                for (int i = 0; i < 4; ++i)
#pragma unroll
                    for (int j = 0; j < 4; ++j) acc[b][i][j] += a[i] * w[j]; }
        }
        __syncthreads();
    }
#pragma unroll
    for (int i = 0; i < 4; ++i)
#pragma unroll
        for (int j = 0; j < 4; ++j) epi(m0 + ty * 4 + i, n0 + tx * 4 + j, acc[0][i][j], acc[NB - 1][i][j]);
}
__global__ __launch_bounds__(256) void nv_headnorm(bf16_t* __restrict__ q, const float* __restrict__ gain, float extra) {
    const int idx = blockIdx.x * 4 + (threadIdx.x >> 6), lane = threadIdx.x & 63;
    bf16_t* p = q + (size_t)idx * HD;
    const float a = bf2f(p[lane]), b = bf2f(p[lane + 64]);
    const float s = wave_sum(a * a + b * b);
    const float rs = 1.0f / sqrtf(s * (1.0f / HD) + EPS) * extra;
    p[lane] = f2bf(a * rs * gain[lane]); p[lane + 64] = f2bf(b * rs * gain[lane + 64]);
}
__global__ __launch_bounds__(256) void nv_conv(const bf16_t* __restrict__ xr, const float* __restrict__ cw, const float* __restrict__ cb, bf16_t* __restrict__ xc) {
    const size_t total = (size_t)M * DR;
    for (size_t i = (size_t)blockIdx.x * 256 + threadIdx.x; i < total; i += (size_t)gridDim.x * 256) {
        const int m = (int)(i / DR), c = (int)(i % DR), s = m & (SEQ - 1);
        float acc = cb[c];
#pragma unroll
        for (int j = 0; j < 4; ++j) { const int sj = s - 3 + j; if (sj >= 0) acc += cw[j * DR + c] * bf2f(xr[(size_t)(m - 3 + j) * DR + c]); }
        xc[i] = f2bf(acc);
    }
}
__global__ __launch_bounds__(256) void nv_attn(const bf16_t* __restrict__ qn, const bf16_t* __restrict__ kn, const bf16_t* __restrict__ vv, bf16_t* __restrict__ ob) {
    const int gw = blockIdx.x * 4 + (threadIdx.x >> 6), lane = threadIdx.x & 63;
    const int t = gw & (SEQ - 1), h = (gw >> 12) & 15, b = gw >> 16;
    const size_t rowb = (size_t)b * SEQ;
    const bf16_t* qp = qn + (rowb + t) * DM + h * HD;
    const float q0 = bf2f(qp[lane]), q1 = bf2f(qp[lane + 64]);
    float o0 = 0.f, o1 = 0.f, R = 0.f;
    for (int s = t - 1; s >= 0; --s) {
        const bf16_t* kp = kn + (rowb + s) * DM + h * HD;
        const float z = wave_sum(q0 * bf2f(kp[lane]) + q1 * bf2f(kp[lane + 64]));
        const float sp = softplusf_(z);
        const float w = __builtin_amdgcn_exp2f((z - sp + R) * LOG2E);
        const bf16_t* vp = vv + (rowb + s) * DM + h * HD;
        const float wb = rbf(w);
        o0 += wb * bf2f(vp[lane]); o1 += wb * bf2f(vp[lane + 64]);
        R -= sp;
        if (R < -88.0f) break;
    }
    bf16_t* op = ob + (rowb + t) * DM + h * HD;
    op[lane] = f2bf(o0); op[lane + 64] = f2bf(o1);
}
__global__ __launch_bounds__(192) void nv_rnn(const bf16_t* __restrict__ xc, const bf16_t* __restrict__ gg, const float* __restrict__ wa, const float* __restrict__ ba, const float* __restrict__ wx, const float* __restrict__ bx,
                                              const float* __restrict__ lam, bf16_t* __restrict__ ar) {
    __shared__ float xs[RB];
    const int b = blockIdx.x >> 4, n = blockIdx.x & 15, d = threadIdx.x;
    const bool act = d < RB;
    const int ch = n * RB + (act ? d : 0);
    const float* wap = wa + (size_t)n * RB * RB + (act ? d : 0);
    const float* wxp = wx + (size_t)n * RB * RB + (act ? d : 0);
    const float bav = ba[ch], bxv = bx[ch];
    const float l = lam[ch];
    const float cl = 8.0f * (fmaxf(-l, 0.f) + log1pf(expf(-fabsf(l))));
    float h = 0.f;
    for (int s = 0; s < SEQ; ++s) {
        const size_t m = (size_t)b * SEQ + s;
        __syncthreads();
        if (act) xs[d] = bf2f(xc[m * DR + n * RB + d]);
        __syncthreads();
        float sa = 0.f, sx = 0.f;
        for (int c = 0; c < RB; ++c) { const float xv = xs[c]; sa += xv * rbf(wap[(size_t)c * RB]); sx += xv * rbf(wxp[(size_t)c * RB]); }
        const float r = sigmoidf_(sa + bav), ig = sigmoidf_(sx + bxv);
        const float la = -cl * r;
        const float a = expf(la);
        const float u = sqrtf(-expm1f(2.0f * la)) * (ig * xs[act ? d : 0]);
        h = a * h + u;
        if (act) ar[m * DR + ch] = f2bf(bf2f(gg[m * DR + ch]) * h);
    }
}

#define ONE_LAUNCH 1
#define FASTMASK 2047
namespace pg8 {
#define PG8_LAS __attribute__((address_space(3)))
typedef unsigned short bf16_t;
typedef short bf16x8 __attribute__((ext_vector_type(8)));
typedef float f32x4 __attribute__((ext_vector_type(4)));
typedef unsigned u32x4 __attribute__((ext_vector_type(4)));
constexpr int BM = 256, BK = 64, HALF = 128, HTB = HALF * BK * 2  , STAGE_BYTES = 8 * HTB, NXCD = 8, WGM = 8;

__host__ __device__ __forceinline__ int lds_byte(int r, int c) { const int st = (r >> 4) * 2 + (c >> 5), rr = r & 15, cc = c & 31, ob = rr * 64 + cc * 2; return st * 1024 + (ob ^ (((ob >> 9) & 1) << 5)); }
__host__ __device__ __forceinline__ void stage_rc(int b, int& R, int& C) { const int st = b / 1024, sb = b % 1024, swz = sb ^ (((sb >> 9) & 1) << 5); R = (st >> 1) * 16 + swz / 64; C = (st & 1) * 32 + (swz % 64) / 2; }
__host__ __device__ __forceinline__ int perm32(int rho) { const int n = rho >> 4, i = rho & 15; return 8 * (i >> 2) + 4 * n + (i & 3); }

struct Unit { int pm, pn; };
struct Gemm { const bf16_t* A; const bf16_t* Bt; int M, N, K; };

struct StaticOrder {
    int nM, nN, nwg, G, c;
    __host__ __device__ void init(int M, int N, int G_, int c_) { nM = M / BM; nN = N / BM; nwg = nM * nN; G = G_; c = c_; }
    __host__ __device__ bool next(int i, Unit& u) const {
        const long L = (long)i * G + c; if (L >= nwg) return false;
        int wgid = (int)L; { const int q = nwg / NXCD, r = nwg % NXCD, xcd = wgid % NXCD, off = wgid / NXCD; wgid = (xcd < r ? xcd * (q + 1) : r * (q + 1) + (xcd - r) * q) + off; }
        const int nig = WGM * nN, gid = wgid / nig, fm = gid * WGM, gsz = (nM - fm) < WGM ? (nM - fm) : WGM;
        u.pm = fm + ((wgid % nig) % gsz); u.pn = (wgid % nig) / gsz; return true;
    }
    __device__ __forceinline__ void a_ready(const Unit&) const {}
    __device__ __forceinline__ void done(const Unit&) const {}
};


__device__ __forceinline__ unsigned cvt_pk_bf16(float lo, float hi) { unsigned r; asm volatile("v_cvt_pk_bf16_f32 %0, %1, %2" : "=v"(r) : "v"(lo), "v"(hi)); return r; }
__device__ __forceinline__ float bflo(unsigned w) { return __uint_as_float(w << 16); }
__device__ __forceinline__ float bfhi(unsigned w) { return __uint_as_float(w & 0xffff0000u); }
__device__ __forceinline__ float sig_(float x) { return __builtin_amdgcn_rcpf(1.0f + __builtin_amdgcn_exp2f(-x * 1.4426950408889634f)); }
__device__ __forceinline__ float gelu_t(float x) { const float y = 0.7978845608028654f * (x + 0.044715f * x * x * x); return x * __builtin_amdgcn_rcpf(1.0f + __builtin_amdgcn_exp2f(-2.0f * 1.4426950408889634f * y)); }
__device__ __forceinline__ u32x4 pack8(const f32x4& v0, const f32x4& v1) { u32x4 w; w.x = cvt_pk_bf16(v0[0], v0[1]); w.y = cvt_pk_bf16(v0[2], v0[3]); w.z = cvt_pk_bf16(v1[0], v1[1]); w.w = cvt_pk_bf16(v1[2], v1[3]); return w; }

struct Epi1 {
    static constexpr bool PERM = true, AFTER_DRAIN = false;
    bf16_t *xr, *gg, *qn, *kn, *vv, *sgr, *sga; const float *qgain, *kgain; PG8_LAS float* xch; float kscale;
    __device__ __forceinline__ void operator()(const f32x4 (&acc)[2][2][4][2], const Unit& u, int wr, int wc, int fr, int fq) const {
        const int pn = u.pn;
        int kind, ld, colt; bf16_t* base;
        if (pn < 11) { kind = 0; base = xr; ld = 2816; colt = pn * 256; }
        else if (pn < 22) { kind = 1; base = gg; ld = 2816; colt = (pn - 11) * 256; }
        else if (pn < 30) { kind = 2; base = qn; ld = 2048; colt = (pn - 22) * 256; }
        else if (pn < 38) { kind = 3; base = kn; ld = 2048; colt = (pn - 30) * 256; }
        else if (pn < 46) { kind = 0; base = vv; ld = 2048; colt = (pn - 38) * 256; }
        else if (pn < 54) { kind = 4; base = sgr; ld = 2048; colt = (pn - 46) * 256; }
        else { kind = 4; base = sga; ld = 2048; colt = (pn - 54) * 256; }
        float rst[2][4][2]; f32x4 gv[2];
#pragma unroll
        for (int ai = 0; ai < 2; ++ai)
#pragma unroll
            for (int m = 0; m < 4; ++m) { rst[ai][m][0] = 1.f; rst[ai][m][1] = 1.f; }
        gv[0] = (f32x4){1.f, 1.f, 1.f, 1.f}; gv[1] = gv[0];
        if (kind == 2 || kind == 3) {
#pragma unroll
            for (int ai = 0; ai < 2; ++ai)
#pragma unroll
                for (int m = 0; m < 4; ++m)
#pragma unroll
                    for (int bj = 0; bj < 2; ++bj) { const f32x4 a = acc[ai][bj][m][0] * kscale, b = acc[ai][bj][m][1] * kscale;
                        float s = (a[0] * a[0] + a[1] * a[1]) + (a[2] * a[2] + a[3] * a[3]) + (b[0] * b[0] + b[1] * b[1]) + (b[2] * b[2] + b[3] * b[3]);
                        s += __shfl_xor(s, 16); s += __shfl_xor(s, 32);
                        if (fq == 0) xch[((ai * HALF + wr * 64 + m * 16 + fr) * 2 + bj) * 4 + wc] = s; }
            asm volatile("s_waitcnt lgkmcnt(0)" ::: "memory"); __builtin_amdgcn_s_barrier(); asm volatile("" ::: "memory");
            const float extra = kind == 2 ? 0.08838834764831845f : 1.0f;
#pragma unroll
            for (int ai = 0; ai < 2; ++ai)
#pragma unroll
                for (int m = 0; m < 4; ++m)
#pragma unroll
                    for (int bj = 0; bj < 2; ++bj) { const f32x4 t = *(const PG8_LAS f32x4*)&xch[((ai * HALF + wr * 64 + m * 16 + fr) * 2 + bj) * 4];
                        rst[ai][m][bj] = extra * __builtin_amdgcn_rsqf(((t[0] + t[1]) + (t[2] + t[3])) * (1.0f / 128.0f) + 1e-6f); }
            const float* gp = (kind == 2 ? qgain : kgain) + wc * 32 + 8 * fq; gv[0] = *(const f32x4*)gp; gv[1] = *(const f32x4*)(gp + 4);
        }
        bf16_t* rowp = base + (size_t)(u.pm * BM + wr * 64 + fr) * ld + colt + wc * 32 + 8 * fq;
        const size_t step16 = (size_t)16 * ld;
#define EPI1_LOOP(BODY) _Pragma("unroll") for (int ai = 0; ai < 2; ++ai) { _Pragma("unroll") for (int m = 0; m < 4; ++m) { _Pragma("unroll") for (int bj = 0; bj < 2; ++bj) { \
            f32x4 v0 = acc[ai][bj][m][0] * kscale, v1 = acc[ai][bj][m][1] * kscale; BODY; *(u32x4*)(rowp + bj * HALF) = pack8(v0, v1); } \
            rowp += step16; __builtin_amdgcn_sched_barrier(0); } rowp += step16 * 4; }
        if (kind == 0) { EPI1_LOOP((void)0) }
        else if (kind == 1) { EPI1_LOOP(_Pragma("unroll") for (int j = 0; j < 4; ++j) { v0[j] = gelu_t(v0[j]); v1[j] = gelu_t(v1[j]); }) }
        else if (kind == 4) { EPI1_LOOP(_Pragma("unroll") for (int j = 0; j < 4; ++j) { v0[j] = sig_(v0[j]); v1[j] = sig_(v1[j]); }) }
        else { EPI1_LOOP(v0 = v0 * rst[ai][m][bj] * gv[0]; v1 = v1 * rst[ai][m][bj] * gv[1]) }
#undef EPI1_LOOP
    }
};
struct EpiMixA {
    static constexpr bool PERM = false, AFTER_DRAIN = false;
    float* F; const bf16_t* G; int ld;
    __device__ __forceinline__ void operator()(const f32x4 (&acc)[2][2][4][2], const Unit& u, int wr, int wc, int fr, int fq) const {
        const int row0 = u.pm * BM + wr * 64 + fr, col0 = u.pn * BM + wc * 32 + 4 * fq;
        u32x2 g[2][4][2][2];
        if (G) {
#pragma unroll
            for (int ai = 0; ai < 2; ++ai)
#pragma unroll
                for (int m = 0; m < 4; ++m)
#pragma unroll
                    for (int bj = 0; bj < 2; ++bj)
#pragma unroll
                        for (int n = 0; n < 2; ++n) g[ai][m][bj][n] = *(const u32x2*)(G + (size_t)(row0 + ai * HALF + m * 16) * ld + col0 + bj * HALF + n * 16);
            asm volatile("" ::: "memory");
        }
#pragma unroll
        for (int ai = 0; ai < 2; ++ai)
#pragma unroll
            for (int m = 0; m < 4; ++m) { const size_t off = (size_t)(row0 + ai * HALF + m * 16) * ld + col0;
#pragma unroll
                for (int bj = 0; bj < 2; ++bj)
#pragma unroll
                    for (int n = 0; n < 2; ++n) { f32x4 v = acc[ai][bj][m][n];
                        if (G) { const u32x2 gg_ = g[ai][m][bj][n]; v = v * (f32x4){bflo(gg_.x), bfhi(gg_.x), bflo(gg_.y), bfhi(gg_.y)}; }
                        *(f32x4*)(F + off + bj * HALF + n * 16) = v; } }
    }
};
struct EpiMixB {
    static constexpr bool PERM = true, AFTER_DRAIN = false;
    bf16_t* O; const float* F; const bf16_t* G; int ld;
    __device__ __forceinline__ void operator()(const f32x4 (&acc)[2][2][4][2], const Unit& u, int wr, int wc, int fr, int fq) const {
        const int row0 = u.pm * BM + wr * 64 + fr, col0 = u.pn * BM + wc * 32 + 8 * fq;
#pragma unroll
        for (int ai = 0; ai < 2; ++ai)
#pragma unroll
            for (int mp = 0; mp < 2; ++mp) {
                f32x4 f[2][2][2]; u32x4 g[2][2];
#pragma unroll
                for (int mm = 0; mm < 2; ++mm)
#pragma unroll
                    for (int bj = 0; bj < 2; ++bj) { const size_t o = (size_t)(row0 + ai * HALF + (2 * mp + mm) * 16) * ld + col0 + bj * HALF;
                        f[mm][bj][0] = *(const f32x4*)(F + o); f[mm][bj][1] = *(const f32x4*)(F + o + 4); g[mm][bj] = *(const u32x4*)(G + o); }
                asm volatile("" ::: "memory");
#pragma unroll
                for (int mm = 0; mm < 2; ++mm)
#pragma unroll
                    for (int bj = 0; bj < 2; ++bj) { const int m = 2 * mp + mm; const size_t o = (size_t)(row0 + ai * HALF + m * 16) * ld + col0 + bj * HALF; const u32x4 gg_ = g[mm][bj];
                        const f32x4 v0 = f[mm][bj][0] + acc[ai][bj][m][0] * (f32x4){bflo(gg_.x), bfhi(gg_.x), bflo(gg_.y), bfhi(gg_.y)};
                        const f32x4 v1 = f[mm][bj][1] + acc[ai][bj][m][1] * (f32x4){bflo(gg_.z), bfhi(gg_.z), bflo(gg_.w), bfhi(gg_.w)};
                        *(u32x4*)(O + o) = pack8(v0, v1); }
                asm volatile("" ::: "memory"); }
    }
};
struct EpiRes {
    static constexpr bool PERM = false, AFTER_DRAIN = false;
    const float* X; float* Fout; bf16_t* O; float* ssq; int ld;
    __device__ __forceinline__ void operator()(const f32x4 (&acc)[2][2][4][2], const Unit& u, int wr, int wc, int fr, int fq) const {
        const int row0 = u.pm * BM + wr * 64 + fr, col0 = u.pn * BM + wc * 32 + 4 * fq;
#pragma unroll
        for (int ai = 0; ai < 2; ++ai) {
            f32x4 xv[4][2][2];
#pragma unroll
            for (int m = 0; m < 4; ++m)
#pragma unroll
                for (int bj = 0; bj < 2; ++bj)
#pragma unroll
                    for (int n = 0; n < 2; ++n) xv[m][bj][n] = *(const f32x4*)(X + (size_t)(row0 + ai * HALF + m * 16) * ld + col0 + bj * HALF + n * 16);
            asm volatile("" ::: "memory");
#pragma unroll
            for (int m = 0; m < 4; ++m) { const int row = row0 + ai * HALF + m * 16; const size_t off = (size_t)row * ld + col0; float s = 0.f;
#pragma unroll
                for (int bj = 0; bj < 2; ++bj)
#pragma unroll
                    for (int n = 0; n < 2; ++n) { const size_t o = off + bj * HALF + n * 16; const f32x4 v = xv[m][bj][n] + acc[ai][bj][m][n];
                        *(f32x4*)(Fout + o) = v; u32x2 w; w.x = cvt_pk_bf16(v[0], v[1]); w.y = cvt_pk_bf16(v[2], v[3]); *(u32x2*)(O + o) = w;
                        s += (v[0] * v[0] + v[1] * v[1]) + (v[2] * v[2] + v[3] * v[3]); }
                s += __shfl_xor(s, 16); s += __shfl_xor(s, 32);
                if (fq == 0) unsafeAtomicAdd(ssq + row, s); }
            asm volatile("" ::: "memory"); }
    }
};
struct EpiFfn {
    static constexpr bool PERM = true, AFTER_DRAIN = false;
    bf16_t* O; const float* ssq; int ldo; float kscale;
    __device__ __forceinline__ void operator()(const f32x4 (&acc)[2][2][4][2], const Unit& u, int wr, int wc, int fr, int fq) const {
        const int row0 = u.pm * BM + wr * 64 + fr, col0 = u.pn * HALF + wc * 32 + 8 * fq;
        float sq[2][4];
#pragma unroll
        for (int ai = 0; ai < 2; ++ai)
#pragma unroll
            for (int m = 0; m < 4; ++m) sq[ai][m] = ssq[row0 + ai * HALF + m * 16];
        asm volatile("" ::: "memory");
#pragma unroll
        for (int ai = 0; ai < 2; ++ai)
#pragma unroll
            for (int m = 0; m < 4; ++m) { const int row = row0 + ai * HALF + m * 16; const float rs = kscale * __builtin_amdgcn_rsqf(sq[ai][m] * (1.0f / 2048.0f) + 1e-6f);
                f32x4 v[2];
#pragma unroll
                for (int n = 0; n < 2; ++n)
#pragma unroll
                    for (int j = 0; j < 4; ++j) { const float g = rs * acc[ai][0][m][n][j], uu = rs * acc[ai][1][m][n][j]; v[n][j] = g * sig_(g) * uu; }
                *(u32x4*)(O + (size_t)row * ldo + col0) = pack8(v[0], v[1]); }
    }
};
struct EpiPle {
    static constexpr bool PERM = false, AFTER_DRAIN = false;
    const float* X; const float* P; float* out; const float* ssq; int ld;
    __device__ __forceinline__ void operator()(const f32x4 (&acc)[2][2][4][2], const Unit& u, int wr, int wc, int fr, int fq) const {
        const int row0 = u.pm * BM + wr * 64 + fr, col0 = u.pn * BM + wc * 32 + 4 * fq;
        float sq[2][4];
#pragma unroll
        for (int ai = 0; ai < 2; ++ai)
#pragma unroll
            for (int m = 0; m < 4; ++m) sq[ai][m] = ssq[row0 + ai * HALF + m * 16];
#pragma unroll
        for (int ai = 0; ai < 2; ++ai)
#pragma unroll
            for (int mp = 0; mp < 2; ++mp) {
                f32x4 xv[2][2][2], pv[2][2][2];
#pragma unroll
                for (int mm = 0; mm < 2; ++mm)
#pragma unroll
                    for (int bj = 0; bj < 2; ++bj)
#pragma unroll
                        for (int n = 0; n < 2; ++n) { const size_t o = (size_t)(row0 + ai * HALF + (2 * mp + mm) * 16) * ld + col0 + bj * HALF + n * 16; xv[mm][bj][n] = *(const f32x4*)(X + o); pv[mm][bj][n] = *(const f32x4*)(P + o); }
                asm volatile("" ::: "memory");
#pragma unroll
                for (int mm = 0; mm < 2; ++mm) { const int m = 2 * mp + mm; const float rs = __builtin_amdgcn_rsqf(sq[ai][m] * (1.0f / 2048.0f) + 1e-6f);
#pragma unroll
                    for (int bj = 0; bj < 2; ++bj)
#pragma unroll
                        for (int n = 0; n < 2; ++n) { const size_t o = (size_t)(row0 + ai * HALF + m * 16) * ld + col0 + bj * HALF + n * 16; f32x4 r;
#pragma unroll
                            for (int j = 0; j < 4; ++j) r[j] = xv[mm][bj][n][j] + sig_(rs * acc[ai][bj][m][n][j]) * pv[mm][bj][n][j];
                            *(f32x4*)(out + o) = r; } }
                asm volatile("" ::: "memory"); }
    }
};
template <class Epi, class Sched, bool ALIGN_EPI = false, bool SP2 = false, int KREP = 1, int EREP = 1>
__device__ __forceinline__ void gemm_phase(PG8_LAS unsigned char* lds, const Gemm g, const Sched& S, const Epi& E) {
    const int tid = threadIdx.x, wid = __builtin_amdgcn_readfirstlane(tid >> 6), lane = tid & 63, wr = wid >> 2, wc = wid & 3, fr = lane & 15, fq = lane >> 4;
    const int K = g.K, nt = K / BK;
    unsigned voffA[2], voffB[2];
#pragma unroll
    for (int i = 0; i < 2; ++i) { int R, C; stage_rc(tid * 16 + i * 8192, R, C); const int Rb = Epi::PERM ? ((R & ~31) + perm32(R & 31)) : R;
        voffA[i] = (unsigned)(R * K + C) * 2u; voffB[i] = (unsigned)(Rb * K + C) * 2u; }
    const size_t kstep = (size_t)(BK * 2);
    const size_t hstep = (size_t)HALF * K * 2;
    const size_t tstep = 2 * hstep;
    const unsigned ldsw = (unsigned)wid * 1024u;
    const int aoff = lds_byte(wr * 64 + fr, fq * 8), boff = lds_byte(wc * 32 + fr, fq * 8);
#define PG8_SA(b, h) (((b) * 2 + (h)) * HTB)
#define PG8_SB(b, h) ((4 + (b) * 2 + (h)) * HTB)
#define PG8_STAGE(bufoff, gbase, voff) do { _Pragma("unroll") for (int _i = 0; _i < 2; ++_i) \
        __builtin_amdgcn_global_load_lds((const unsigned*)((const char*)(gbase) + (voff)[_i]), (PG8_LAS unsigned*)(lds + (bufoff) + ldsw + _i * 8192), 16, 0, 0); } while (0)
#define PG8_LDA(dst, b, h) do { _Pragma("unroll") for (int m = 0; m < 4; ++m) _Pragma("unroll") for (int k = 0; k < 2; ++k) dst[m][k] = *(const PG8_LAS bf16x8*)(lds + PG8_SA(b, h) + aoff + m * 2048 + k * 1024); } while (0)
#define PG8_LDB(dst, b, h) do { _Pragma("unroll") for (int n = 0; n < 2; ++n) _Pragma("unroll") for (int k = 0; k < 2; ++k) dst[n][k] = *(const PG8_LAS bf16x8*)(lds + PG8_SB(b, h) + boff + n * 2048 + k * 1024); } while (0)
#define PG8_MMA(ai, bj, At, Bt) do { __builtin_amdgcn_s_setprio(1); _Pragma("unroll") for (int m = 0; m < 4; ++m) _Pragma("unroll") for (int n = 0; n < 2; ++n) _Pragma("unroll") for (int k = 0; k < 2; ++k) \
        acc[ai][bj][m][n] = __builtin_amdgcn_mfma_f32_16x16x32_bf16(Bt[n][k], At[m][k], acc[ai][bj][m][n], 0, 0, 0); __builtin_amdgcn_s_setprio(0); } while (0)
#define PG8_WAIT_V(n) asm volatile("s_waitcnt vmcnt(" #n ")" ::: "memory")
#define PG8_WAIT_L(n) asm volatile("s_waitcnt lgkmcnt(" #n ")" ::: "memory")
#define PG8_BAR __builtin_amdgcn_s_barrier()
#define PG8_SCHED __builtin_amdgcn_sched_barrier(0)
    Unit cur, nxt; int ui = 0;
    if (!S.next(0, cur)) return;
    f32x4 acc[2][2][4][2];
#pragma unroll
    for (int a = 0; a < 2; ++a)
#pragma unroll
        for (int b = 0; b < 2; ++b)
#pragma unroll
            for (int m = 0; m < 4; ++m)
#pragma unroll
                for (int n = 0; n < 2; ++n) acc[a][b][m][n] = (f32x4){0.f, 0.f, 0.f, 0.f};
    bf16x8 At[4][2], B0[2][2], B1[2][2];
    const char* cA = (const char*)g.A + (size_t)cur.pm * tstep; const char* cB = (const char*)g.Bt + (size_t)cur.pn * tstep;
    S.a_ready(cur);
    if constexpr (SP2) {
        PG8_STAGE(PG8_SB(0, 0), cB, voffB); PG8_STAGE(PG8_SB(0, 1), cB + hstep, voffB); PG8_STAGE(PG8_SA(0, 0), cA, voffA); PG8_STAGE(PG8_SA(0, 1), cA + hstep, voffA);
        if (wr == 1) PG8_BAR;
        PG8_WAIT_V(2); PG8_BAR;
        PG8_STAGE(PG8_SB(1, 0), cB + kstep, voffB); PG8_STAGE(PG8_SA(1, 0), cA + kstep, voffA); PG8_STAGE(PG8_SB(1, 1), cB + hstep + kstep, voffB);
        PG8_WAIT_V(6); PG8_BAR;
    } else {
        PG8_STAGE(PG8_SB(0, 0), cB, voffB); PG8_STAGE(PG8_SA(0, 0), cA, voffA); PG8_STAGE(PG8_SB(0, 1), cB + hstep, voffB); PG8_STAGE(PG8_SA(0, 1), cA + hstep, voffA);
        if (wr == 1) PG8_BAR;
        PG8_WAIT_V(4); PG8_BAR;
        PG8_STAGE(PG8_SB(1, 0), cB + kstep, voffB); PG8_STAGE(PG8_SA(1, 0), cA + kstep, voffA); PG8_STAGE(PG8_SB(1, 1), cB + hstep + kstep, voffB);
        PG8_WAIT_V(6); PG8_BAR;
    }
    for (;;) {
        const bool has_next = S.next(ui + 1, nxt);
        const char* nA = has_next ? (const char*)g.A + (size_t)nxt.pm * tstep : cA; const char* nB = has_next ? (const char*)g.Bt + (size_t)nxt.pn * tstep : cB;
        for (int pass = 0; pass < KREP; ++pass)
        for (int t = 0; t < nt; t += 2) {
            const bool lastpass = (pass == KREP - 1);
            const bool last = (t == nt - 2);
            const char* a1 = cA + (size_t)(t + 1) * kstep;
            const char* a2 = last ? (lastpass ? nA : cA) : cA + (size_t)(t + 2) * kstep; const char* b2 = last ? (lastpass ? nB : cB) : cB + (size_t)(t + 2) * kstep;
            const char* a3 = a2 + kstep; const char* b3 = b2 + kstep;
            if (last && has_next && lastpass) S.a_ready(nxt);
            if constexpr (SP2) {
            PG8_LDB(B0, 0, 0); PG8_LDB(B1, 0, 1); PG8_SCHED; PG8_LDA(At, 0, 0); PG8_STAGE(PG8_SA(1, 1), a1 + hstep, voffA);
            PG8_WAIT_V(8); PG8_WAIT_L(0); PG8_BAR; PG8_MMA(0, 0, At, B0); PG8_MMA(0, 1, At, B1); PG8_BAR; PG8_SCHED;
            PG8_LDA(At, 0, 1); PG8_STAGE(PG8_SB(0, 0), b2, voffB); PG8_STAGE(PG8_SB(0, 1), b2 + hstep, voffB); PG8_STAGE(PG8_SA(0, 0), a2, voffA);
            PG8_WAIT_V(8); PG8_WAIT_L(0); PG8_BAR; PG8_MMA(1, 0, At, B0); PG8_MMA(1, 1, At, B1); PG8_BAR; PG8_SCHED;
            PG8_LDB(B0, 1, 0); PG8_LDB(B1, 1, 1); PG8_SCHED; PG8_LDA(At, 1, 0); PG8_STAGE(PG8_SA(0, 1), a2 + hstep, voffA);
            PG8_WAIT_V(8); PG8_WAIT_L(0); PG8_BAR; PG8_MMA(0, 0, At, B0); PG8_MMA(0, 1, At, B1); PG8_BAR; PG8_SCHED;
            PG8_LDA(At, 1, 1); PG8_STAGE(PG8_SB(1, 0), b3, voffB); PG8_STAGE(PG8_SB(1, 1), b3 + hstep, voffB); PG8_STAGE(PG8_SA(1, 0), a3, voffA);
            PG8_WAIT_V(8); PG8_WAIT_L(0); PG8_BAR; PG8_MMA(1, 0, At, B0); PG8_MMA(1, 1, At, B1); PG8_BAR; PG8_SCHED;
            } else {
            PG8_LDB(B0, 0, 0); PG8_SCHED; PG8_LDA(At, 0, 0); PG8_STAGE(PG8_SA(1, 1), a1 + hstep, voffA);
            PG8_WAIT_L(8); PG8_BAR; PG8_WAIT_L(0); PG8_MMA(0, 0, At, B0); PG8_BAR; PG8_SCHED;
            PG8_LDB(B1, 0, 1); PG8_STAGE(PG8_SB(0, 0), b2, voffB);
            PG8_BAR; PG8_WAIT_L(0); PG8_MMA(0, 1, At, B1); PG8_BAR;
            PG8_LDA(At, 0, 1); PG8_STAGE(PG8_SA(0, 0), a2, voffA);
            PG8_BAR; PG8_WAIT_L(0); PG8_MMA(1, 0, At, B0); PG8_BAR; PG8_SCHED;
            PG8_STAGE(PG8_SB(0, 1), b2 + hstep, voffB);
            PG8_WAIT_V(6); PG8_BAR; PG8_MMA(1, 1, At, B1); PG8_BAR;
            PG8_LDB(B0, 1, 0); PG8_SCHED; PG8_LDA(At, 1, 0); PG8_STAGE(PG8_SA(0, 1), a2 + hstep, voffA);
            PG8_WAIT_L(8); PG8_BAR; PG8_WAIT_L(0); PG8_MMA(0, 0, At, B0); PG8_BAR; PG8_SCHED;
            PG8_LDB(B1, 1, 1); PG8_STAGE(PG8_SB(1, 0), b3, voffB);
            PG8_BAR; PG8_WAIT_L(0); PG8_MMA(0, 1, At, B1); PG8_BAR;
            PG8_LDA(At, 1, 1); PG8_STAGE(PG8_SA(1, 0), a3, voffA);
            PG8_BAR; PG8_WAIT_L(0); PG8_MMA(1, 0, At, B0); PG8_BAR; PG8_SCHED;
            PG8_STAGE(PG8_SB(1, 1), b3 + hstep, voffB);
            PG8_WAIT_V(6); PG8_BAR; PG8_MMA(1, 1, At, B1); PG8_BAR;
            }
        }
        if constexpr (ALIGN_EPI) { if (wr == 0) PG8_BAR; }
        if constexpr (!Epi::AFTER_DRAIN) { for (int er = 0; er < EREP; ++er) E(acc, cur, wr, wc, fr, fq); S.done(cur); }
        if (!has_next) break;
#pragma unroll
        for (int a = 0; a < 2; ++a)
#pragma unroll
            for (int b = 0; b < 2; ++b)
#pragma unroll
                for (int m = 0; m < 4; ++m)
#pragma unroll
                    for (int n = 0; n < 2; ++n) acc[a][b][m][n] = (f32x4){0.f, 0.f, 0.f, 0.f};
        cur = nxt; cA = nA; cB = nB; ++ui;
        if constexpr (ALIGN_EPI) { if (wr == 1) PG8_BAR; }
    }
    PG8_WAIT_V(0);
    if constexpr (!ALIGN_EPI) { if (wr == 0) PG8_BAR; }
    PG8_BAR;
    if constexpr (Epi::AFTER_DRAIN) { E.fused(acc, cur, wr, wc, fr, fq, lds, wid, lane); S.done(cur); }
#undef PG8_SA
#undef PG8_SB
#undef PG8_STAGE
#undef PG8_LDA
#undef PG8_LDB
#undef PG8_MMA
#undef PG8_WAIT_V
#undef PG8_WAIT_L
#undef PG8_BAR
#undef PG8_SCHED
}
}

#define GAS __attribute__((address_space(1)))
#define RLX_AGENT __ATOMIC_RELAXED, __HIP_MEMORY_SCOPE_AGENT
#define XB_TMO      128
#define XB_XCNT(j)  (256  + 64 * (j))
#define XB_XSUB(j)  (1280 + 64 * (j))
#define XB_XGEN(j)  (2304 + 64 * (j))
#define XB_TOP      3328
#define XB_TOPGEN   3392
#define XCD_BAR_WORDS 3456
#define XB_SPIN_CAP (1u << 18)

__device__ __forceinline__ unsigned xb_ld(unsigned* p)              { return __hip_atomic_load(p, __ATOMIC_RELAXED, __HIP_MEMORY_SCOPE_AGENT); }
__device__ __forceinline__ unsigned xb_add(unsigned* p, unsigned v) { return __hip_atomic_fetch_add(p, v, __ATOMIC_RELAXED, __HIP_MEMORY_SCOPE_AGENT); }
__device__ __forceinline__ unsigned xb_xcc_id() { return (unsigned)__builtin_amdgcn_s_getreg((3 << 11) | 20) & 0xFu; }
#define XB_SPIN(cond, bar) do { unsigned _sp = 0; while (cond) { __builtin_amdgcn_s_sleep(1); \
    if ((++_sp & 255u) == 0u) { if (xb_ld(&(bar)[XB_TMO])) break; if (_sp > XB_SPIN_CAP) { atomicAdd(&(bar)[XB_TMO], 1u); break; } } } } while (0)

struct XcdBarrier {
    unsigned* bar; unsigned x;
    volatile LAS unsigned* st;
};

__device__ __forceinline__ XcdBarrier xcd_barrier_post(unsigned* bar, volatile LAS unsigned* st) {
    XcdBarrier b; b.bar = bar; b.x = xb_xcc_id(); b.st = st;
    if (threadIdx.x == 0) (void)xb_add(&bar[XB_XCNT(b.x)], 1u);
    return b;
}
__device__ __forceinline__ void xcd_barrier_complete(unsigned* bar, unsigned x, unsigned& nloc, unsigned& nx) {
    const unsigned G = gridDim.x * gridDim.y * gridDim.z;
    unsigned sum, cnt, mine, sp = 0u;
    for (;;) {
        sum = 0u; cnt = 0u; mine = 0u;
#pragma unroll
        for (unsigned j = 0; j < 16; ++j) { const unsigned c = xb_ld(&bar[XB_XCNT(j)]); sum += c; cnt += (c > 0u) ? 1u : 0u; mine = (j == x) ? c : mine; }
        if (sum == G) break;
        __builtin_amdgcn_s_sleep(1);
        if ((++sp & 255u) == 0u) { if (xb_ld(&bar[XB_TMO])) break; if (sp > XB_SPIN_CAP) { atomicAdd(&bar[XB_TMO], 1u); break; } }
    }
    nloc = mine > 0u ? mine : 1u; nx = cnt > 0u ? cnt : 1u;
}

__device__ __forceinline__ void xcd_barrier(const XcdBarrier& b) {
    asm volatile("s_waitcnt vmcnt(0)" ::: "memory");
    __syncthreads();
    if (threadIdx.x == 0) {
        unsigned* bar = b.bar;
        __builtin_amdgcn_s_waitcnt(0);
        unsigned nloc = b.st[0], nx = b.st[1];
        if (nloc == 0u) { xcd_barrier_complete(bar, b.x, nloc, nx); b.st[0] = nloc; b.st[1] = nx; }
        const unsigned old = xb_add(&bar[XB_XSUB(b.x)], 1u);
        const unsigned gen = old / nloc;
        if (old + 1u == (gen + 1u) * nloc) {
            __builtin_amdgcn_fence(__ATOMIC_RELEASE, "agent");
            asm volatile("s_waitcnt vmcnt(0)" ::: "memory");
            const unsigned og = xb_add(&bar[XB_TOP], 1u);
            const unsigned tg = og / nx;
            if (og + 1u == (tg + 1u) * nx) xb_add(&bar[XB_TOPGEN], 1u);
            else XB_SPIN(xb_ld(&bar[XB_TOPGEN]) == tg, bar);
            __builtin_amdgcn_fence(__ATOMIC_ACQUIRE, "agent");
            xb_add(&bar[XB_XGEN(b.x)], 1u);
            asm volatile("s_waitcnt vmcnt(0)" ::: "memory");
        } else {
            XB_SPIN(xb_ld(&bar[XB_XGEN(b.x)]) == gen, bar);
            __builtin_amdgcn_fence(__ATOMIC_ACQUIRE, "agent");
            asm volatile("s_waitcnt vmcnt(0)" ::: "memory");
        }
    }
    __syncthreads();
}


#ifndef ONLYP
#define ONLYP -1
#endif
constexpr int ONLY = ONLYP;
#define PHON(k) (ONLY < 0 || ONLY == (k))
#ifndef P7_KREP
#define P7_KREP 1
#endif
#ifndef P7_EREP
#define P7_EREP 1
#endif
#ifndef P1_KREP
#define P1_KREP 1
#endif
#ifndef P1_EREP
#define P1_EREP 1
#endif
#ifndef USE_CG_SYNC
#define USE_CG_SYNC 0
#endif
#ifndef DUPMASK
#define DUPMASK 0
#endif
#define NREP(k) (((DUPMASK >> (k)) & 1) + 1)
constexpr size_t SM_DUMMY = 2 * MiB;
constexpr int NWAVES = 8, NTHREADS = NWAVES * 64;
constexpr int RING_BYTES = 131072, XCH_OFF = RING_BYTES, XCH_BYTES = 8192, MISC_OFF = XCH_OFF + XCH_BYTES, LDS_BYTES = 147456;
static_assert(MISC_OFF + 64 <= LDS_BYTES, "LDS map");
constexpr size_t SM_CTL = 3 * MiB, CTL_BYTES = 65536;
constexpr int VST_PITCH = 320, VST_BYTES = 32 * VST_PITCH;
static_assert(NWAVES * VST_BYTES <= RING_BYTES, "attention scratch");

enum { F_P0 = 1, F_G1 = 2, F_CONV = 4, F_ATTN = 8, F_RNN = 16, F_YA = 32, F_YR = 64, F_WO = 128, F_FFU = 256, F_FFD = 512, F_PLE = 1024, F_ALL = 2047 };

struct Args {
    const float *x, *p, *g_mix, *w_in, *conv_w, *conv_b, *w_rg_a, *b_rg_a, *w_rg_x, *b_rg_x, *lam, *q_gain, *k_gain, *w_rnn_out, *w_attn_out, *w_o, *g_ffn, *w_gu, *w_dn, *g_ple, *w_pg, *w_pp;
    float* out; unsigned char* ws; int ph_lo, ph_hi, mask, pad;
};

__device__ __forceinline__ int crow(int reg, int h) { return (reg & 3) + 8 * (reg >> 2) + 4 * h; }
#define MFMA32(a, b, c) __builtin_amdgcn_mfma_f32_32x32x16_bf16((a), (b), (c), 0, 0, 0)
__device__ __forceinline__ unsigned pk2(float lo, float hi) { return (unsigned)f2bf(lo) | ((unsigned)f2bf(hi) << 16); }

__device__ __forceinline__ void p0_transpose_item(const float* __restrict__ W, int ldw, int Kdim, bf16_t* __restrict__ WT, int orow0, const float* __restrict__ ks, LAS float* scr, int k0, int n0, int lane) {
#pragma unroll 8
    for (int i = 0; i < 32; ++i) { const int kk = 2 * i + (lane >> 5); float v = W[(size_t)(k0 + kk) * ldw + n0 + (lane & 31)]; if (ks) v *= ks[k0 + kk]; scr[kk * 33 + (lane & 31)] = v; }
    asm volatile("s_waitcnt lgkmcnt(0)" ::: "memory");
    const int c = lane & 7;
#pragma unroll
    for (int j = 0; j < 4; ++j) { const int n = (lane >> 3) + 8 * j; const LAS float* s = scr + (8 * c) * 33 + n;
        u32x4 o; o.x = pk2(s[0 * 33], s[1 * 33]); o.y = pk2(s[2 * 33], s[3 * 33]); o.z = pk2(s[4 * 33], s[5 * 33]); o.w = pk2(s[6 * 33], s[7 * 33]);
        *(u32x4*)(WT + (size_t)(orow0 + n) * Kdim + k0 + 8 * c) = o; }
    asm volatile("s_waitcnt lgkmcnt(0)" ::: "memory");
}
__device__ __forceinline__ void p0_prologue(const Args& a, LAS unsigned char* lds, int gw, int ngw, int lane, int gtid, int ngt) {
    unsigned char* ws = a.ws;
    LAS float* scr = (LAS float*)(lds + (threadIdx.x >> 6) * 16384);
    constexpr int I1 = (DM / 64) * (DIN / 32), I2 = (DR / 64) * (DM / 32), I3 = (DM / 64) * (DM / 32), I5 = (DM / 64) * (2 * DFF / 32), I6 = (DFF / 64) * (DM / 32), I8 = (PLE / 64) * (DM / 32);
    constexpr int NIT = I1 + I2 + I3 + I3 + I5 + I6 + I3 + I8;
    for (int it = gw; it < NIT; it += ngw) {
        int r = it;
        if (r < I1) { const int nb = DIN / 32; p0_transpose_item(a.w_in, DIN, DM, (bf16_t*)(ws + WS_W1), 32 * (r % nb), nullptr, scr, 64 * (r / nb), 32 * (r % nb), lane); continue; } r -= I1;
        if (r < I2) { const int nb = DM / 32; p0_transpose_item(a.w_rnn_out, DM, DR, (bf16_t*)(ws + WS_WRO), 32 * (r % nb), nullptr, scr, 64 * (r / nb), 32 * (r % nb), lane); continue; } r -= I2;
        if (r < I3) { const int nb = DM / 32; p0_transpose_item(a.w_attn_out, DM, DM, (bf16_t*)(ws + WS_WAO), 32 * (r % nb), nullptr, scr, 64 * (r / nb), 32 * (r % nb), lane); continue; } r -= I3;
        if (r < I3) { const int nb = DM / 32; p0_transpose_item(a.w_o, DM, DM, (bf16_t*)(ws + WS_WO), 32 * (r % nb), nullptr, scr, 64 * (r / nb), 32 * (r % nb), lane); continue; } r -= I3;
        if (r < I5) { const int nb = 2 * DFF / 32; const int n0 = 32 * (r % nb); const int isu = n0 >= DFF ? 1 : 0; const int j0 = n0 - isu * DFF; const int orow = (j0 >> 7) * 256 + isu * 128 + (j0 & 127);
                      p0_transpose_item(a.w_gu, 2 * DFF, DM, (bf16_t*)(ws + WS_WGU), orow, a.g_ffn, scr, 64 * (r / nb), n0, lane); continue; } r -= I5;
        if (r < I6) { const int nb = DM / 32; p0_transpose_item(a.w_dn, DM, DFF, (bf16_t*)(ws + WS_WDN), 32 * (r % nb), nullptr, scr, 64 * (r / nb), 32 * (r % nb), lane); continue; } r -= I6;
        if (r < I3) { const int nb = DM / 32; p0_transpose_item(a.w_pg, DM, DM, (bf16_t*)(ws + WS_WPG), 32 * (r % nb), a.g_ple, scr, 64 * (r / nb), 32 * (r % nb), lane); continue; } r -= I3;
        { const int nb = DM / 32; p0_transpose_item(a.w_pp, DM, PLE, (bf16_t*)(ws + WS_WPP), 32 * (r % nb), nullptr, scr, 64 * (r / nb), 32 * (r % nb), lane); }
    }
    bf16_t* hb = (bf16_t*)(ws + WS_HB);
    for (int m = gw; m < M; m += ngw) {
        const f32x4* xr = (const f32x4*)(a.x + (size_t)m * DM) + lane; const f32x4* gr = (const f32x4*)a.g_mix + lane;
        f32x4 v[8]; float s = 0.f;
#pragma unroll
        for (int j = 0; j < 8; ++j) { v[j] = xr[64 * j]; s += (v[j][0] * v[j][0] + v[j][1] * v[j][1]) + (v[j][2] * v[j][2] + v[j][3] * v[j][3]); }
        const float rs = 1.0f / sqrtf(wave_sum(s) * (1.0f / DM) + EPS);
        u32x2* o8 = (u32x2*)(hb + (size_t)m * DM) + lane;
#pragma unroll
        for (int j = 0; j < 8; ++j) { const f32x4 g = gr[64 * j]; u32x2 w; w.x = pk2(v[j][0] * rs * g[0], v[j][1] * rs * g[1]); w.y = pk2(v[j][2] * rs * g[2], v[j][3] * rs * g[3]); o8[64 * j] = w; }
    }
    { const f32x4* pp = (const f32x4*)a.p; u32x2* po = (u32x2*)(ws + WS_PB);
      for (int i = gtid; i < M * PLE / 4; i += ngt) { const f32x4 v = pp[i]; u32x2 w; w.x = pk2(v[0], v[1]); w.y = pk2(v[2], v[3]); po[i] = w; } }
    { bf16_t* wra = (bf16_t*)(ws + WS_WRA); bf16_t* wrx = (bf16_t*)(ws + WS_WRX);
      for (int i = gtid; i < NRB * RB * RBP; i += ngt) { const int c = i % RBP, d = (i / RBP) % RB, n = i / (RBP * RB);
          const size_t src = ((size_t)n * RB + (c < RB ? c : 0)) * RB + d;
          wra[i] = c < RB ? f2bf(a.w_rg_a[src]) : (bf16_t)0; wrx[i] = c < RB ? f2bf(a.w_rg_x[src]) : (bf16_t)0; } }
    { float* z = (float*)(ws + WS_SMALL); for (int i = gtid; i < 2 * M; i += ngt) z[i] = 0.f; }
}

__device__ __forceinline__ void conv_phase(const Args& a, int gtid, int ngt) {
    const bf16_t* xr = (const bf16_t*)(a.ws + WS_XR); bf16_t* xc = (bf16_t*)(a.ws + WS_XC);
    constexpr int NCG = DR / 8;
    for (int it = gtid; it < (M / 8) * NCG; it += ngt) {
        const int cg = it % NCG, rg = it / NCG, c0 = cg * 8, m0 = rg * 8;
        f32x4 w[4][2]; f32x4 bb[2];
#pragma unroll
        for (int j = 0; j < 4; ++j) { w[j][0] = *(const f32x4*)(a.conv_w + (size_t)j * DR + c0); w[j][1] = *(const f32x4*)(a.conv_w + (size_t)j * DR + c0 + 4); }
        bb[0] = *(const f32x4*)(a.conv_b + c0); bb[1] = *(const f32x4*)(a.conv_b + c0 + 4);
        f32x4 win[3][2];
        const bool first = (m0 & (SEQ - 1)) == 0;
#pragma unroll
        for (int j = 0; j < 3; ++j) {
            if (first) { win[j][0] = (f32x4){0.f, 0.f, 0.f, 0.f}; win[j][1] = win[j][0]; }
            else { const u32x4 t = *(const u32x4*)(xr + (size_t)(m0 - 3 + j) * DR + c0); win[j][0] = (f32x4){pg8::bflo(t.x), pg8::bfhi(t.x), pg8::bflo(t.y), pg8::bfhi(t.y)}; win[j][1] = (f32x4){pg8::bflo(t.z), pg8::bfhi(t.z), pg8::bflo(t.w), pg8::bfhi(t.w)}; } }
#pragma unroll
        for (int i = 0; i < 8; ++i) {
            const u32x4 t = *(const u32x4*)(xr + (size_t)(m0 + i) * DR + c0);
            const f32x4 c0v = (f32x4){pg8::bflo(t.x), pg8::bfhi(t.x), pg8::bflo(t.y), pg8::bfhi(t.y)}, c1v = (f32x4){pg8::bflo(t.z), pg8::bfhi(t.z), pg8::bflo(t.w), pg8::bfhi(t.w)};
            const f32x4 y0 = bb[0] + w[0][0] * win[0][0] + w[1][0] * win[1][0] + w[2][0] * win[2][0] + w[3][0] * c0v;
            const f32x4 y1 = bb[1] + w[0][1] * win[0][1] + w[1][1] * win[1][1] + w[2][1] * win[2][1] + w[3][1] * c1v;
            *(u32x4*)(xc + (size_t)(m0 + i) * DR + c0) = pg8::pack8(y0, y1);
            win[0][0] = win[1][0]; win[0][1] = win[1][1]; win[1][0] = win[2][0]; win[1][1] = win[2][1]; win[2][0] = c0v; win[2][1] = c1v;
        }
    }
}

typedef short v4i16_t __attribute__((ext_vector_type(4)));
__device__ __forceinline__ s16x4 vtr(const LAS unsigned char* p) { return __builtin_bit_cast(s16x4, __builtin_amdgcn_ds_read_tr16_b64_v4i16((LAS v4i16_t*)p)); }
__device__ __forceinline__ void attn_unit(int b, int hh, int qb, const bf16_t* __restrict__ qn, const bf16_t* __restrict__ kn, const bf16_t* __restrict__ vv, bf16_t* __restrict__ ob, LAS unsigned char* vst, int lane) {
    const int r = lane & 31, h = lane >> 5;
    const size_t rowb = (size_t)b * SEQ;
    const int q0 = qb * 32;
    bf16x8 qf[8];
    { const bf16_t* qp = qn + (rowb + q0 + r) * DM + hh * HD + 8 * h;
#pragma unroll
      for (int ks = 0; ks < 8; ++ks) qf[ks] = *(const bf16x8*)(qp + 16 * ks); }
    f32x16 o[4];
#pragma unroll
    for (int d = 0; d < 4; ++d)
#pragma unroll
        for (int i = 0; i < 16; ++i) o[d][i] = 0.f;
    float R = 0.f;
    const int vrow = lane >> 4, vch = lane & 15;
    const int i16 = lane & 15, tq = i16 >> 2, tp = i16 & 3, blk = (lane >> 4) & 1;
    const LAS unsigned char* trb = vst + (4 * h + tq) * VST_PITCH + (16 * blk + 4 * tp) * 2;
    for (int kb = qb; kb >= 0; --kb) {
        const int k0 = kb * 32;
        bf16x8 kf[8];
        { const bf16_t* kp = kn + (rowb + k0 + r) * DM + hh * HD + 8 * h;
#pragma unroll
          for (int ks = 0; ks < 8; ++ks) kf[ks] = *(const bf16x8*)(kp + 16 * ks); }
        u32x4 vt[8];
        { const bf16_t* vp = vv + (rowb + k0 + vrow) * DM + hh * HD + 8 * vch;
#pragma unroll
          for (int i = 0; i < 8; ++i) vt[i] = *(const u32x4*)(vp + (size_t)(4 * i) * DM); }
#pragma unroll
        for (int i = 0; i < 8; ++i) *(LAS u32x4*)(vst + (vrow + 4 * i) * VST_PITCH + 16 * vch) = vt[i];
        f32x16 x;
#pragma unroll
        for (int i = 0; i < 16; ++i) x[i] = 0.f;
#pragma unroll
        for (int ks = 0; ks < 8; ++ks) x = MFMA32(kf[ks], qf[ks], x);
        const bool diag = (kb == qb);
        float lk[16], zz[16];
#pragma unroll
        for (int i = 0; i < 16; ++i) { const float z = x[i]; const bool valid = !diag || crow(i, h) < r; lk[i] = valid ? -softplusf_(z) : 0.f; zz[i] = valid ? z : -1e30f; }
        float I[16], T[4], To[4];
#pragma unroll
        for (int g = 0; g < 4; ++g) { I[4 * g + 3] = lk[4 * g + 3]; I[4 * g + 2] = I[4 * g + 3] + lk[4 * g + 2]; I[4 * g + 1] = I[4 * g + 2] + lk[4 * g + 1]; I[4 * g] = I[4 * g + 1] + lk[4 * g]; T[g] = I[4 * g]; }
#pragma unroll
        for (int g = 0; g < 4; ++g) To[g] = __shfl_xor(T[g], 32);
        const float U0 = T[0] + To[0], U1 = T[1] + To[1], U2 = T[2] + To[2], U3 = T[3] + To[3];
        float C[4]; C[3] = 0.f; C[2] = U3; C[1] = U3 + U2; C[0] = C[1] + U1;
        const float tot = C[0] + U0;
        float w[16];
#pragma unroll
        for (int g = 0; g < 4; ++g) { const float off = C[g] + (h == 0 ? To[g] : 0.f) + R;
#pragma unroll
            for (int j = 0; j < 4; ++j) w[4 * g + j] = __builtin_amdgcn_exp2f((zz[4 * g + j] + I[4 * g + j] + off) * LOG2E); }
        R += tot;
        bf16x8 xs[2];
#pragma unroll
        for (int s = 0; s < 2; ++s) { u32x4 pw; pw.x = pk2(w[8 * s], w[8 * s + 1]); pw.y = pk2(w[8 * s + 2], w[8 * s + 3]); pw.z = pk2(w[8 * s + 4], w[8 * s + 5]); pw.w = pk2(w[8 * s + 6], w[8 * s + 7]); xs[s] = __builtin_bit_cast(bf16x8, pw); }
#pragma unroll
        for (int db = 0; db < 4; ++db)
#pragma unroll
            for (int s = 0; s < 2; ++s) {
                const s16x4 lo = vtr(trb + (16 * s) * VST_PITCH + db * 64), hi = vtr(trb + (16 * s + 8) * VST_PITCH + db * 64);
                const bf16x8 vf = __builtin_shufflevector(lo, hi, 0, 1, 2, 3, 4, 5, 6, 7);
                o[db] = MFMA32(vf, xs[s], o[db]);
            }
        if (__all(R < -88.0f)) break;
    }
    bf16_t* op = ob + (rowb + q0 + r) * DM + hh * HD + 4 * h;
#pragma unroll
    for (int db = 0; db < 4; ++db)
#pragma unroll
        for (int g = 0; g < 4; ++g) { u32x2 wv; wv.x = pk2(o[db][4 * g], o[db][4 * g + 1]); wv.y = pk2(o[db][4 * g + 2], o[db][4 * g + 3]); *(u32x2*)(op + 32 * db + 8 * g) = wv; }
}

template <bool PASSB>
__device__ __forceinline__ void rnn_unit(int b, int n, int ct, int c, const Args& a, int lane) {
    const bf16_t* xc = (const bf16_t*)(a.ws + WS_XC); const bf16_t* gg = (const bf16_t*)(a.ws + WS_GG); bf16_t* ar = (bf16_t*)(a.ws + WS_AR);
    const bf16_t* wra = (const bf16_t*)(a.ws + WS_WRA); const bf16_t* wrx = (const bf16_t*)(a.ws + WS_WRX); float* summ = (float*)(a.ws + WS_SMALL + SM_SUMM);
    const int r = lane & 31, h = lane >> 5;
    const int chl = ct * 32 + r; const bool chv = chl < RB; const int chc = chv ? chl : RB - 1; const int ch = n * RB + chc;
    bf16x8 wa[11], wx[11];
    { const bf16_t* pa = wra + (size_t)(n * RB + chc) * RBP + 8 * h; const bf16_t* px = wrx + (size_t)(n * RB + chc) * RBP + 8 * h;
#pragma unroll
      for (int ks = 0; ks < 11; ++ks) { wa[ks] = *(const bf16x8*)(pa + 16 * ks); wx[ks] = *(const bf16x8*)(px + 16 * ks); } }
    const float bav = a.b_rg_a[ch], bxv = a.b_rg_x[ch]; const float l = a.lam[ch];
    const float cl = 8.0f * (fmaxf(-l, 0.f) + log1pf(expf(-fabsf(l))));
    float hc = 0.f, Pc = 1.f;
    if (PASSB) { for (int cp = 0; cp < c; ++cp) { const float* sp = summ + ((size_t)(b * NCHUNK + cp) * DR + ch) * 2; hc = sp[0] * hc + sp[1]; } }
    for (int tt = 0; tt < 4; ++tt) {
        const size_t m0 = (size_t)b * SEQ + c * CHUNK + tt * 32;
        f32x16 aa, ax;
#pragma unroll
        for (int i = 0; i < 16; ++i) { aa[i] = 0.f; ax[i] = 0.f; }
        { const bf16_t* ap = xc + (m0 + r) * DR + n * RB + 8 * h;
#pragma unroll
          for (int ks = 0; ks < 11; ++ks) { const bf16x8 af = *(const bf16x8*)(ap + 16 * ks); aa = MFMA32(af, wa[ks], aa); ax = MFMA32(af, wx[ks], ax); } }
        float av[16], uv[16];
#pragma unroll
        for (int i = 0; i < 16; ++i) { const size_t tok = m0 + crow(i, h); const float xv = bf2f(xc[tok * DR + ch]);
            const float rg = sigmoidf_(aa[i] + bav), ig = sigmoidf_(ax[i] + bxv); const float la = -cl * rg; av[i] = __builtin_amdgcn_exp2f(la * LOG2E);
            const float t2 = 2.0f * la;
            const float om = t2 > -0.3f ? -t2 * (1.0f + t2 * (0.5f + t2 * (0.16666667f + t2 * (0.041666667f + t2 * 0.0083333333f)))) : 1.0f - __builtin_amdgcn_exp2f(t2 * LOG2E);
            uv[i] = sqrtf(om) * (ig * xv); }
        float pc[16], hl[16], Pg[4], Hg[4], Pgo[4], Hgo[4];
#pragma unroll
        for (int g = 0; g < 4; ++g) { float P = 1.f, H = 0.f;
#pragma unroll
            for (int j = 0; j < 4; ++j) { H = av[4 * g + j] * H + uv[4 * g + j]; P = P * av[4 * g + j]; pc[4 * g + j] = P; hl[4 * g + j] = H; }
            Pg[g] = P; Hg[g] = H; }
#pragma unroll
        for (int g = 0; g < 4; ++g) { Pgo[g] = __shfl_xor(Pg[g], 32); Hgo[g] = __shfl_xor(Hg[g], 32); }
        float cur = hc, cin[4];
#pragma unroll
        for (int g = 0; g < 4; ++g) { const float P0 = h == 0 ? Pg[g] : Pgo[g], H0 = h == 0 ? Hg[g] : Hgo[g], P1 = h == 0 ? Pgo[g] : Pg[g], H1 = h == 0 ? Hgo[g] : Hg[g];
            const float c0 = cur; cur = P0 * cur + H0; const float c1 = cur; cur = P1 * cur + H1; cin[g] = h == 0 ? c0 : c1; Pc *= P0 * P1; }
        hc = cur;
        if (PASSB) {
#pragma unroll
            for (int i = 0; i < 16; ++i) { const size_t tok = m0 + crow(i, h); const float hv = hl[i] + pc[i] * cin[i >> 2]; const float y = bf2f(gg[tok * DR + ch]) * hv; if (chv) ar[tok * DR + ch] = f2bf(y); } }
    }
    if (!PASSB && chv && h == 0) { float* sp = summ + ((size_t)(b * NCHUNK + c) * DR + ch) * 2; sp[0] = Pc; sp[1] = hc; }
}

namespace cg = cooperative_groups;
__global__ void __launch_bounds__(NTHREADS, 2) fwd(Args a) {
    extern __shared__ __attribute__((aligned(16))) unsigned char lds_raw[];
    LAS unsigned char* lds = (LAS unsigned char*)lds_raw;
    const int tid = threadIdx.x, lane = tid & 63, wave = __builtin_amdgcn_readfirstlane(tid >> 6);
    const int G = gridDim.x, bx = blockIdx.x;
    const int gw = bx * NWAVES + wave, ngw = G * NWAVES, gtid = bx * NTHREADS + tid, ngt = G * NTHREADS;
    unsigned char* ws = a.ws;
    const int lo = a.ph_lo, hi = a.ph_hi, mask = a.mask;
#define IN(k) (lo <= (k) && (k) < hi)
    { volatile LAS unsigned* misc = (volatile LAS unsigned*)(lds + MISC_OFF); if (tid < 16) misc[tid] = 0u; }
    __syncthreads();
    XcdBarrier bar = xcd_barrier_post((unsigned*)(ws + WS_SMALL + SM_CTL), (volatile LAS unsigned*)(lds + MISC_OFF));
#if USE_CG_SYNC
#define SEAM(k) do { if (IN(k) && IN((k) + 1)) cg::this_grid().sync(); } while (0)
#else
#define SEAM(k) do { if (IN(k) && IN((k) + 1)) { if ((k) == 0) cg::this_grid().sync(); else xcd_barrier(bar); } } while (0)
#endif
    bf16_t* hb = (bf16_t*)(ws + WS_HB); bf16_t* qn = (bf16_t*)(ws + WS_QN); bf16_t* kn = (bf16_t*)(ws + WS_KN); bf16_t* vv = (bf16_t*)(ws + WS_VV); bf16_t* xr = (bf16_t*)(ws + WS_XR);
    bf16_t* gg = (bf16_t*)(ws + WS_GG); bf16_t* sgr = (bf16_t*)(ws + WS_SGR); bf16_t* sga = (bf16_t*)(ws + WS_SGA); bf16_t* pb = (bf16_t*)(ws + WS_PB);
    bf16_t* ob = (bf16_t*)(ws + WS_OB); float* mixa = (float*)(ws + WS_MIXA); float* Pp = (float*)(ws + WS_PP); bf16_t* ar = (bf16_t*)(ws + WS_AR); bf16_t* mixb = (bf16_t*)(ws + WS_MIXB);
    bf16_t* x1b = (bf16_t*)(ws + WS_X1B); bf16_t* x2b = (bf16_t*)(ws + WS_X2B); bf16_t* act = (bf16_t*)(ws + WS_ACT);
    float* ssq1 = (float*)(ws + WS_SMALL + SM_SSQ1); float* ssq2 = (float*)(ws + WS_SMALL + SM_SSQ2);

#ifndef NO_P0
    if (IN(0)) { for (int rep = 0; rep < NREP(0); ++rep) if (mask & F_P0) p0_prologue(a, lds, gw, ngw, lane, gtid, ngt); }
#endif
    SEAM(0);
    if (PHON(1) && IN(1) && (mask & F_G1)) for (int rep = 0; rep < NREP(1); ++rep) {
        pg8::Gemm g{hb, (const bf16_t*)(ws + WS_W1), M, DIN, DM}; pg8::StaticOrder S; S.init(M, DIN, G, bx);
        pg8::Epi1 E{xr, gg, qn, kn, vv, sgr, sga, a.q_gain, a.k_gain, (LAS float*)(lds + XCH_OFF), 1.0f / P1_KREP};
        pg8::gemm_phase<pg8::Epi1, pg8::StaticOrder, true, true, P1_KREP, P1_EREP>(lds, g, S, E);
    }
    SEAM(1);
    if (IN(2)) for (int rep = 0; rep < NREP(2); ++rep) {
#ifndef NO_CONV
        if (mask & F_CONV) conv_phase(a, gtid, ngt);
#endif
#ifndef NO_ATTN
        if (mask & F_ATTN) { LAS unsigned char* vst = lds + wave * VST_BYTES;
            for (int u = gw; u < NBATCH * NH * (SEQ / 32); u += ngw) attn_unit(u >> 11, (u >> 7) & 15, u & 127, qn, kn, vv, ob, vst, lane); }
#endif
    }
    SEAM(2);
    if (IN(3)) for (int rep = 0; rep < NREP(3); ++rep) {
#ifndef NO_RNNA
        if (mask & F_RNN) { for (int u = gw; u < NBATCH * NRB * 6 * NCHUNK; u += ngw) { const int nct = u >> 6; rnn_unit<false>((u >> 5) & 1, nct / 6, nct % 6, u & 31, a, lane); } }
#endif
        if (PHON(3) && (mask & F_YA)) {
            __syncthreads();
            { pg8::Gemm g{ob, (const bf16_t*)(ws + WS_WAO), M, DM, DM}; pg8::StaticOrder S; S.init(M, DM, G, bx); pg8::EpiMixA E{mixa, sga, DM};
              pg8::gemm_phase<pg8::EpiMixA, pg8::StaticOrder, true, true>(lds, g, S, E); }
            { pg8::Gemm g{pb, (const bf16_t*)(ws + WS_WPP), M, DM, PLE}; pg8::StaticOrder S; S.init(M, DM, G, bx); pg8::EpiMixA E{Pp, nullptr, DM};
              pg8::gemm_phase<pg8::EpiMixA, pg8::StaticOrder, true, true>(lds, g, S, E); }
        }
    }
    SEAM(3);
#ifndef NO_RNNB
    if (IN(4) && (mask & F_RNN)) for (int rep = 0; rep < NREP(4); ++rep) { for (int u = gw; u < NBATCH * NRB * 6 * NCHUNK; u += ngw) { const int nct = u >> 6; rnn_unit<true>((u >> 5) & 1, nct / 6, nct % 6, u & 31, a, lane); } }
#endif
    SEAM(4);
    if (PHON(5) && IN(5) && (mask & F_YR)) for (int rep = 0; rep < NREP(5); ++rep) { pg8::Gemm g{ar, (const bf16_t*)(ws + WS_WRO), M, DM, DR}; pg8::StaticOrder S; S.init(M, DM, G, bx); pg8::EpiMixB E{mixb, mixa, sgr, DM};
        pg8::gemm_phase<pg8::EpiMixB, pg8::StaticOrder, true, true>(lds, g, S, E); }
    SEAM(5);
    if (PHON(6) && IN(6) && (mask & F_WO)) for (int rep = 0; rep < NREP(6); ++rep) { pg8::Gemm g{mixb, (const bf16_t*)(ws + WS_WO), M, DM, DM}; pg8::StaticOrder S; S.init(M, DM, G, bx); pg8::EpiRes E{a.x, a.out, x1b, (rep + 1 < NREP(6)) ? (float*)(ws + WS_SMALL + SM_DUMMY) : ssq1, DM};
        pg8::gemm_phase<pg8::EpiRes, pg8::StaticOrder, true, true>(lds, g, S, E); }
    SEAM(6);
    if (PHON(7) && IN(7) && (mask & F_FFU)) for (int rep = 0; rep < NREP(7); ++rep) { pg8::Gemm g{x1b, (const bf16_t*)(ws + WS_WGU), M, 2 * DFF, DM}; pg8::StaticOrder S; S.init(M, 2 * DFF, G, bx); pg8::EpiFfn E{act, ssq1, DFF, 1.0f / P7_KREP};
        pg8::gemm_phase<pg8::EpiFfn, pg8::StaticOrder, true, true, P7_KREP, P7_EREP>(lds, g, S, E); }
    SEAM(7);
    if (PHON(8) && IN(8) && (mask & F_FFD)) for (int rep = 0; rep < NREP(8); ++rep) { pg8::Gemm g{act, (const bf16_t*)(ws + WS_WDN), M, DM, DFF}; pg8::StaticOrder S; S.init(M, DM, G, bx); const bool dmy = rep + 1 < NREP(8); pg8::EpiRes E{a.out, dmy ? mixa : a.out, x2b, dmy ? (float*)(ws + WS_SMALL + SM_DUMMY) : ssq2, DM};
        pg8::gemm_phase<pg8::EpiRes, pg8::StaticOrder, true, true>(lds, g, S, E); }
    SEAM(8);
    if (PHON(9) && IN(9) && (mask & F_PLE)) for (int rep = 0; rep < NREP(9); ++rep) { pg8::Gemm g{x2b, (const bf16_t*)(ws + WS_WPG), M, DM, DM}; pg8::StaticOrder S; S.init(M, DM, G, bx); pg8::EpiPle E{a.out, Pp, (rep + 1 < NREP(9)) ? mixa : a.out, ssq2, DM};
        pg8::gemm_phase<pg8::EpiPle, pg8::StaticOrder, true, true>(lds, g, S, E); }
#undef IN
#undef SEAM
}

#ifndef FASTMASK
#define FASTMASK F_ALL
#endif
#ifndef ONE_LAUNCH
#define ONE_LAUNCH 1
#endif
extern "C" void kernel_launch(void* const* d_in, const int* in_sizes, int n_in, void* d_out, int out_size, void* d_ws, size_t ws_size, hipStream_t stream) {
    if (n_in != 22 || out_size != M * DM || ws_size < WS_END) { fprintf(stderr, "kernel_launch: unexpected sizes n_in %d out %d ws %zu\n", n_in, out_size, ws_size); return; }
    const float* x = (const float*)d_in[0]; const float* p = (const float*)d_in[1]; const float* g_mix = (const float*)d_in[2]; const float* w_in = (const float*)d_in[3];
    const float* conv_w = (const float*)d_in[4]; const float* conv_b = (const float*)d_in[5]; const float* w_rg_a = (const float*)d_in[6]; const float* b_rg_a = (const float*)d_in[7];
    const float* w_rg_x = (const float*)d_in[8]; const float* b_rg_x = (const float*)d_in[9]; const float* lam = (const float*)d_in[10]; const float* q_gain = (const float*)d_in[11];
    const float* k_gain = (const float*)d_in[12]; const float* w_rnn_out = (const float*)d_in[13]; const float* w_attn_out = (const float*)d_in[14]; const float* w_o = (const float*)d_in[15];
    const float* g_ffn = (const float*)d_in[16]; const float* w_gu = (const float*)d_in[17]; const float* w_dn = (const float*)d_in[18]; const float* g_ple = (const float*)d_in[19];
    const float* w_pg = (const float*)d_in[20]; const float* w_pp = (const float*)d_in[21];
    float* out = (float*)d_out; unsigned char* ws = (unsigned char*)d_ws;
    bf16_t* hb = (bf16_t*)(ws + WS_HB); bf16_t* qn = (bf16_t*)(ws + WS_QN); bf16_t* kn = (bf16_t*)(ws + WS_KN); bf16_t* vv = (bf16_t*)(ws + WS_VV); bf16_t* xr = (bf16_t*)(ws + WS_XR);
    bf16_t* gg = (bf16_t*)(ws + WS_GG); bf16_t* sgr = (bf16_t*)(ws + WS_SGR); bf16_t* sga = (bf16_t*)(ws + WS_SGA); bf16_t* pb = (bf16_t*)(ws + WS_PB); bf16_t* xc = (bf16_t*)(ws + WS_XC);
    bf16_t* ob = (bf16_t*)(ws + WS_OB); float* mixa = (float*)(ws + WS_MIXA); float* Pp = (float*)(ws + WS_PP); bf16_t* ar = (bf16_t*)(ws + WS_AR); bf16_t* mixb = (bf16_t*)(ws + WS_MIXB);
    bf16_t* x1b = (bf16_t*)(ws + WS_X1B); bf16_t* x2b = (bf16_t*)(ws + WS_X2B); bf16_t* act = (bf16_t*)(ws + WS_ACT);
    float* ssq1 = (float*)(ws + WS_SMALL + SM_SSQ1); float* ssq2 = (float*)(ws + WS_SMALL + SM_SSQ2);

    static int grid = 0;
    if (grid == 0) {
        int dev = 0, cus = 0, per_cu = 0;
        if (hipGetDevice(&dev) != hipSuccess || hipDeviceGetAttribute(&cus, hipDeviceAttributeMultiprocessorCount, dev) != hipSuccess) { fprintf(stderr, "kernel_launch: device query failed\n"); grid = -1; return; }
        if (hipFuncSetAttribute((const void*)fwd, hipFuncAttributeMaxDynamicSharedMemorySize, LDS_BYTES) != hipSuccess) { fprintf(stderr, "kernel_launch: hipFuncSetAttribute failed\n"); grid = -1; return; }
        if (hipOccupancyMaxActiveBlocksPerMultiprocessor(&per_cu, (const void*)fwd, NTHREADS, LDS_BYTES) != hipSuccess || per_cu < 1) { fprintf(stderr, "kernel_launch: occupancy query says %d blocks per CU\n", per_cu); (void)hipGetLastError(); grid = -1; return; }
        grid = cus;
    }
    if (grid < 0) return;
    Args a{};
    a.x = x; a.p = p; a.g_mix = g_mix; a.w_in = w_in; a.conv_w = conv_w; a.conv_b = conv_b; a.w_rg_a = w_rg_a; a.b_rg_a = b_rg_a; a.w_rg_x = w_rg_x; a.b_rg_x = b_rg_x; a.lam = lam;
    a.q_gain = q_gain; a.k_gain = k_gain; a.w_rnn_out = w_rnn_out; a.w_attn_out = w_attn_out; a.w_o = w_o; a.g_ffn = g_ffn; a.w_gu = w_gu; a.w_dn = w_dn; a.g_ple = g_ple; a.w_pg = w_pg; a.w_pp = w_pp;
    a.out = out; a.ws = ws;
    if (hipMemsetAsync(ws + WS_SMALL + SM_CTL, 0, CTL_BYTES, stream) != hipSuccess) { fprintf(stderr, "kernel_launch: memset failed\n"); return; }
#if ONE_LAUNCH
    a.ph_lo = 0; a.ph_hi = 10; a.mask = F_ALL;
    void* kargs[] = {&a};
    hipError_t e = hipLaunchCooperativeKernel((const void*)fwd, dim3(grid), dim3(NTHREADS), kargs, LDS_BYTES, stream);
    if (e != hipSuccess) fprintf(stderr, "kernel_launch: cooperative launch failed: %s (grid %d)\n", hipGetErrorString(e), grid);
#else
    constexpr int FM = FASTMASK;
#ifndef HDUP
#define HDUP 0
#endif
    auto fast = [&](int ph, int mask) { if (!mask) return; a.ph_lo = ph; a.ph_hi = ph + 1; a.mask = mask; for (int rep = 0; rep < ((HDUP >> ph) & 1) + 1; ++rep) hipLaunchKernelGGL(fwd, dim3(grid), dim3(NTHREADS), LDS_BYTES, stream, a); };
    auto gemm1 = [&](const bf16_t* A, int lda, const float* W, int ldw, int wcol, const float* ks, int K, int N, NvEpi e) {
        nv_gemm<1><<<dim3(N / 64, M / 64), 256, 0, stream>>>(A, lda, W + wcol, nullptr, ldw, ks, K, e); };
    NvEpi e{};
    fast(0, F_P0);
    if (!(FM & F_P0)) { nv_rmsnorm<<<M / 4, 256, 0, stream>>>(x, g_mix, hb); nv_cvt<<<2048, 256, 0, stream>>>(p, pb, M * PLE); }
    if (FM & F_G1) fast(1, F_G1);
    else {
        e = NvEpi{}; e.mode = 0; e.O = xr; e.ldo = DR; gemm1(hb, DM, w_in, DIN, 0, nullptr, DM, DR, e);
        e = NvEpi{}; e.mode = 1; e.O = gg; e.ldo = DR; gemm1(hb, DM, w_in, DIN, DR, nullptr, DM, DR, e);
        e = NvEpi{}; e.mode = 0; e.O = qn; e.ldo = DM; gemm1(hb, DM, w_in, DIN, 2 * DR, nullptr, DM, DM, e);
        e = NvEpi{}; e.mode = 0; e.O = kn; e.ldo = DM; gemm1(hb, DM, w_in, DIN, 2 * DR + DM, nullptr, DM, DM, e);
        e = NvEpi{}; e.mode = 0; e.O = vv; e.ldo = DM; gemm1(hb, DM, w_in, DIN, 2 * DR + 2 * DM, nullptr, DM, DM, e);
        e = NvEpi{}; e.mode = 2; e.O = sgr; e.ldo = DM; gemm1(hb, DM, w_in, DIN, 2 * DR + 3 * DM, nullptr, DM, DM, e);
        e = NvEpi{}; e.mode = 2; e.O = sga; e.ldo = DM; gemm1(hb, DM, w_in, DIN, 2 * DR + 4 * DM, nullptr, DM, DM, e);
        nv_headnorm<<<M * NH / 4, 256, 0, stream>>>(qn, q_gain, 0.08838834764831845f);
        nv_headnorm<<<M * NH / 4, 256, 0, stream>>>(kn, k_gain, 1.0f);
    }
    fast(2, FM & (F_CONV | F_ATTN));
    if (!(FM & F_CONV)) nv_conv<<<4096, 256, 0, stream>>>(xr, conv_w, conv_b, xc);
    if (!(FM & F_ATTN)) nv_attn<<<NBATCH * NH * SEQ / 4, 256, 0, stream>>>(qn, kn, vv, ob);
    fast(3, FM & (F_RNN | F_YA));
    if (!(FM & F_YA)) {
        e = NvEpi{}; e.mode = 3; e.F = mixa; e.ldf = DM; e.G = sga; e.ldg = DM; gemm1(ob, DM, w_attn_out, DM, 0, nullptr, DM, DM, e);
        e = NvEpi{}; e.mode = 4; e.F = Pp; e.ldf = DM; gemm1(pb, PLE, w_pp, DM, 0, nullptr, PLE, DM, e);
    }
    if (FM & F_RNN) fast(4, F_RNN);
    else nv_rnn<<<NBATCH * NRB, 192, 0, stream>>>(xc, gg, w_rg_a, b_rg_a, w_rg_x, b_rg_x, lam, ar);
    if (FM & F_YR) fast(5, F_YR);
    else { e = NvEpi{}; e.mode = 5; e.O = mixb; e.ldo = DM; e.F = mixa; e.ldf = DM; e.G = sgr; e.ldg = DM; gemm1(ar, DR, w_rnn_out, DM, 0, nullptr, DR, DM, e); }
    if (FM & F_WO) fast(6, F_WO);
    else { e = NvEpi{}; e.mode = 6; e.O = x1b; e.ldo = DM; e.F = out; e.ldf = DM; e.X = x; gemm1(mixb, DM, w_o, DM, 0, nullptr, DM, DM, e); nv_rowssq<<<M / 4, 256, 0, stream>>>(out, ssq1); }
    if (FM & F_FFU) fast(7, F_FFU);
    else { e = NvEpi{}; e.mode = 7; e.O = act; e.ldo = DFF; e.ssq = ssq1; nv_gemm<2><<<dim3(DFF / 64, M / 64), 256, 0, stream>>>(x1b, DM, w_gu, w_gu + DFF, 2 * DFF, g_ffn, DM, e); }
    if (FM & F_FFD) fast(8, F_FFD);
    else { e = NvEpi{}; e.mode = 6; e.O = x2b; e.ldo = DM; e.F = out; e.ldf = DM; e.X = out; gemm1(act, DFF, w_dn, DM, 0, nullptr, DFF, DM, e); nv_rowssq<<<M / 4, 256, 0, stream>>>(out, ssq2); }
    if (FM & F_PLE) fast(9, F_PLE);
    else { e = NvEpi{}; e.mode = 8; e.F = out; e.ldf = DM; e.X = out; e.P = Pp; e.ssq = ssq2; gemm1(x2b, DM, w_pg, DM, 0, g_ple, DM, DM, e); }
#endif
}
```

```cpp
#include <hip/hip_runtime.h>
#include <hip/hip_cooperative_groups.h>
#include <cstdio>
#include <cstdint>

typedef unsigned short bf16_t;
typedef float f32x4 __attribute__((ext_vector_type(4)));
typedef unsigned u32x4 __attribute__((ext_vector_type(4)));
typedef unsigned u32x2 __attribute__((ext_vector_type(2)));
typedef short bf16x8 __attribute__((ext_vector_type(8)));
typedef short s16x4 __attribute__((ext_vector_type(4)));
typedef float f32x16 __attribute__((ext_vector_type(16)));
#define LAS __attribute__((address_space(3)))

constexpr int SEQ = 4096, NBATCH = 2, M = NBATCH * SEQ, DM = 2048, DR = 2816, DIN = 15872, DFF = 5632, PLE = 256, NH = 16, HD = 128;
constexpr int NRB = 16, RB = 176, RBP = 192, NCHUNK = 32, CHUNK = 128;
constexpr float EPS = 1e-6f;
constexpr float LOG2E = 1.4426950408889634f, LN2 = 0.6931471805599453f;

constexpr size_t MiB = (size_t)1 << 20;
constexpr size_t WS_WRO = 0, WS_WAO = 11 * MiB, WS_WO = 19 * MiB, WS_WGU = 27 * MiB, WS_WDN = 71 * MiB, WS_WPG = 93 * MiB, WS_WPP = 101 * MiB, WS_WRA = 102 * MiB, WS_WRX = 102 * MiB + 1536 * 1024;
constexpr size_t WS_W1 = 106 * MiB, WS_HB = 168 * MiB, WS_QN = 200 * MiB, WS_KN = 232 * MiB, WS_VV = 264 * MiB, WS_XR = 296 * MiB, WS_GG = 340 * MiB, WS_SGR = 384 * MiB, WS_SGA = 416 * MiB, WS_SMALL = 460 * MiB, WS_PB = 464 * MiB, WS_END = 468 * MiB;
constexpr size_t WS_XC = WS_W1, WS_OB = WS_HB, WS_MIXA = WS_QN, WS_PP = WS_VV, WS_AR = WS_SGA, WS_MIXB = WS_W1, WS_X1B = WS_GG, WS_X2B = WS_GG, WS_ACT = WS_W1;
constexpr size_t SM_SSQ1 = 0, SM_SSQ2 = 32768, SM_SUMM = 65536;

__device__ __forceinline__ float bf2f(bf16_t b) { return __uint_as_float((unsigned)b << 16); }
__device__ __forceinline__ bf16_t f2bf(float f) { unsigned u = __float_as_uint(f); return (bf16_t)((u + 0x7fffu + ((u >> 16) & 1u)) >> 16); }
__device__ __forceinline__ float rbf(float f) { return bf2f(f2bf(f)); }
__device__ __forceinline__ float sigmoidf_(float x) { return __builtin_amdgcn_rcpf(1.0f + __builtin_amdgcn_exp2f(-x * LOG2E)); }
__device__ __forceinline__ float gelu_tanh(float x) { const float y = 0.7978845608028654f * (x + 0.044715f * x * x * x); return x * __builtin_amdgcn_rcpf(1.0f + __builtin_amdgcn_exp2f(-2.0f * LOG2E * y)); }
__device__ __forceinline__ float softplusf_(float z) { return fmaxf(z, 0.f) + LN2 * __builtin_amdgcn_logf(1.0f + __builtin_amdgcn_exp2f(-fabsf(z) * LOG2E)); }
__device__ __forceinline__ float wave_sum(float v) {
#pragma unroll
    for (int o = 1; o < 64; o <<= 1) v += __shfl_xor(v, o);
    return v;
}

#define ONE_LAUNCH 1
#define FASTMASK 2047
namespace pg8 {
#define PG8_LAS __attribute__((address_space(3)))
typedef unsigned short bf16_t;
typedef short bf16x8 __attribute__((ext_vector_type(8)));
typedef float f32x4 __attribute__((ext_vector_type(4)));
typedef unsigned u32x4 __attribute__((ext_vector_type(4)));
constexpr int BM = 256, BK = 64, HALF = 128, HTB = HALF * BK * 2  , STAGE_BYTES = 8 * HTB, NXCD = 8, WGM = 8;

__host__ __device__ __forceinline__ int lds_byte(int r, int c) { const int st = (r >> 4) * 2 + (c >> 5), rr = r & 15, cc = c & 31, ob = rr * 64 + cc * 2; return st * 1024 + (ob ^ (((ob >> 9) & 1) << 5)); }
__host__ __device__ __forceinline__ void stage_rc(int b, int& R, int& C) { const int st = b / 1024, sb = b % 1024, swz = sb ^ (((sb >> 9) & 1) << 5); R = (st >> 1) * 16 + swz / 64; C = (st & 1) * 32 + (swz % 64) / 2; }
__host__ __device__ __forceinline__ int perm32(int rho) { const int n = rho >> 4, i = rho & 15; return 8 * (i >> 2) + 4 * n + (i & 3); }

struct Unit { int pm, pn; };
struct Gemm { const bf16_t* A; const bf16_t* Bt; int M, N, K; };

struct StaticOrder {
    int nM, nN, nwg, G, c;
    __host__ __device__ void init(int M, int N, int G_, int c_) { nM = M / BM; nN = N / BM; nwg = nM * nN; G = G_; c = c_; }
    __host__ __device__ bool next(int i, Unit& u) const {
        const long L = (long)i * G + c; if (L >= nwg) return false;
        int wgid = (int)L; { const int q = nwg / NXCD, r = nwg % NXCD, xcd = wgid % NXCD, off = wgid / NXCD; wgid = (xcd < r ? xcd * (q + 1) : r * (q + 1) + (xcd - r) * q) + off; }
        const int nig = WGM * nN, gid = wgid / nig, fm = gid * WGM, gsz = (nM - fm) < WGM ? (nM - fm) : WGM;
        u.pm = fm + ((wgid % nig) % gsz); u.pn = (wgid % nig) / gsz; return true;
    }
    __device__ __forceinline__ void a_ready(const Unit&) const {}
    __device__ __forceinline__ void done(const Unit&) const {}
};
template <int kind> struct Order {
    StaticOrder so;
    __device__ __forceinline__ void init(int M, int N, int G, int c, bool local, int xs, int rk) { so.init(M, N, G, c); if (local) { so.nwg = -1; so.G = xs; so.c = rk; } }
    __device__ __forceinline__ bool next(int i, Unit& u) const {
        if (so.nwg >= 0) return so.next(i, u);
        const int xs = so.G, rk = so.c;
        if (kind == 0) { if (i > 0) return false; u.pm = 4 * xs + (rk >> 3); u.pn = rk & 7; return true; }
        if (kind == 1) { const int j = i * 32 + rk; if (j >= 176) return false; u.pm = 4 * xs + (j & 3); u.pn = j >> 2; return true; }
        if (i >= 2 || rk < 16) return false;
        const int j = (rk - 16) * 2 + i; u.pm = 4 * xs + (j >> 3); u.pn = j & 7; return true;
    }
    __device__ __forceinline__ void a_ready(const Unit&) const {}
    __device__ __forceinline__ void done(const Unit&) const {}
};

__device__ __forceinline__ unsigned cvt_pk_bf16(float lo, float hi) { unsigned r; asm volatile("v_cvt_pk_bf16_f32 %0, %1, %2" : "=v"(r) : "v"(lo), "v"(hi)); return r; }
__device__ __forceinline__ float bflo(unsigned w) { return __uint_as_float(w << 16); }
__device__ __forceinline__ float bfhi(unsigned w) { return __uint_as_float(w & 0xffff0000u); }
__device__ __forceinline__ float sig_(float x) { return __builtin_amdgcn_rcpf(1.0f + __builtin_amdgcn_exp2f(-x * 1.4426950408889634f)); }
__device__ __forceinline__ float gelu_t(float x) { const float y = 0.7978845608028654f * (x + 0.044715f * x * x * x); return x * __builtin_amdgcn_rcpf(1.0f + __builtin_amdgcn_exp2f(-2.0f * 1.4426950408889634f * y)); }
__device__ __forceinline__ u32x4 pack8(const f32x4& v0, const f32x4& v1) { u32x4 w; w.x = cvt_pk_bf16(v0[0], v0[1]); w.y = cvt_pk_bf16(v0[2], v0[3]); w.z = cvt_pk_bf16(v1[0], v1[1]); w.w = cvt_pk_bf16(v1[2], v1[3]); return w; }

#ifndef EPI_NT
#define EPI_NT 0
#endif
#if EPI_NT
#define EPI_ST16(p, v) st_nt16((p), (v))
#else
#define EPI_ST16(p, v) (*(u32x4*)(p) = (v))
#endif
__device__ __forceinline__ void st_nt16(void* p, const u32x4& v) { __builtin_nontemporal_store(v, (u32x4*)p); }
struct Epi1 {
    static constexpr bool PERM = true, AFTER_DRAIN = false;
    bf16_t *xr, *gg, *qn, *kn, *vv, *sgr, *sga; const float *qgain, *kgain; PG8_LAS float* xch; float kscale;
    __device__ __forceinline__ void operator()(const f32x4 (&acc)[2][2][4][2], const Unit& u, int wr, int wc, int fr, int fq) const {
        const int pn = u.pn;
        int kind, ld, colt; bf16_t* base;
        if (pn < 11) { kind = 0; base = xr; ld = 2816; colt = pn * 256; }
        else if (pn < 22) { kind = 1; base = gg; ld = 2816; colt = (pn - 11) * 256; }
        else if (pn < 30) { kind = 2; base = qn; ld = 2048; colt = (pn - 22) * 256; }
        else if (pn < 38) { kind = 3; base = kn; ld = 2048; colt = (pn - 30) * 256; }
        else if (pn < 46) { kind = 0; base = vv; ld = 2048; colt = (pn - 38) * 256; }
        else if (pn < 54) { kind = 4; base = sgr; ld = 2048; colt = (pn - 46) * 256; }
        else { kind = 4; base = sga; ld = 2048; colt = (pn - 54) * 256; }
        float rst[2][4][2]; f32x4 gv[2];
#pragma unroll
        for (int ai = 0; ai < 2; ++ai)
#pragma unroll
            for (int m = 0; m < 4; ++m) { rst[ai][m][0] = 1.f; rst[ai][m][1] = 1.f; }
        gv[0] = (f32x4){1.f, 1.f, 1.f, 1.f}; gv[1] = gv[0];
        if (kind == 2 || kind == 3) {
#pragma unroll
            for (int ai = 0; ai < 2; ++ai)
#pragma unroll
                for (int m = 0; m < 4; ++m)
#pragma unroll
                    for (int bj = 0; bj < 2; ++bj) { const f32x4 a = acc[ai][bj][m][0] * kscale, b = acc[ai][bj][m][1] * kscale;
                        float s = (a[0] * a[0] + a[1] * a[1]) + (a[2] * a[2] + a[3] * a[3]) + (b[0] * b[0] + b[1] * b[1]) + (b[2] * b[2] + b[3] * b[3]);
                        s += __shfl_xor(s, 16); s += __shfl_xor(s, 32);
                        if (fq == 0) xch[((ai * HALF + wr * 64 + m * 16 + fr) * 2 + bj) * 4 + wc] = s; }
            asm volatile("s_waitcnt lgkmcnt(0)" ::: "memory"); __builtin_amdgcn_s_barrier(); asm volatile("" ::: "memory");
            const float extra = kind == 2 ? 0.08838834764831845f : 1.0f;
#pragma unroll
            for (int ai = 0; ai < 2; ++ai)
#pragma unroll
                for (int m = 0; m < 4; ++m)
#pragma unroll
                    for (int bj = 0; bj < 2; ++bj) { const f32x4 t = *(const PG8_LAS f32x4*)&xch[((ai * HALF + wr * 64 + m * 16 + fr) * 2 + bj) * 4];
                        rst[ai][m][bj] = extra * __builtin_amdgcn_rsqf(((t[0] + t[1]) + (t[2] + t[3])) * (1.0f / 128.0f) + 1e-6f); }
            const float* gp = (kind == 2 ? qgain : kgain) + wc * 32 + 8 * fq; gv[0] = *(const f32x4*)gp; gv[1] = *(const f32x4*)(gp + 4);
        }
        bf16_t* rowp = base + (size_t)(u.pm * BM + wr * 64 + fr) * ld + colt + wc * 32 + 8 * fq;
        const size_t step16 = (size_t)16 * ld;
#define EPI1_LOOP(BODY) _Pragma("unroll") for (int ai = 0; ai < 2; ++ai) { _Pragma("unroll") for (int m = 0; m < 4; ++m) { _Pragma("unroll") for (int bj = 0; bj < 2; ++bj) { \
            f32x4 v0 = acc[ai][bj][m][0] * kscale, v1 = acc[ai][bj][m][1] * kscale; BODY; EPI_ST16(rowp + bj * HALF, pack8(v0, v1)); } \
            rowp += step16; __builtin_amdgcn_sched_barrier(0); } rowp += step16 * 4; }
        if (kind == 0) { EPI1_LOOP((void)0) }
        else if (kind == 1) { EPI1_LOOP(_Pragma("unroll") for (int j = 0; j < 4; ++j) { v0[j] = gelu_t(v0[j]); v1[j] = gelu_t(v1[j]); }) }
        else if (kind == 4) { EPI1_LOOP(_Pragma("unroll") for (int j = 0; j < 4; ++j) { v0[j] = sig_(v0[j]); v1[j] = sig_(v1[j]); }) }
        else { EPI1_LOOP(v0 = v0 * rst[ai][m][bj] * gv[0]; v1 = v1 * rst[ai][m][bj] * gv[1]) }
#undef EPI1_LOOP
    }
};
__device__ __forceinline__ void unpack8(const u32x4& g, f32x4& a, f32x4& b) { a = (f32x4){bflo(g.x), bfhi(g.x), bflo(g.y), bfhi(g.y)}; b = (f32x4){bflo(g.z), bfhi(g.z), bflo(g.w), bfhi(g.w)}; }
struct EpiMixA {
    static constexpr bool PERM = true, AFTER_DRAIN = false;
    bf16_t* O; const bf16_t* G; int ld;
    __device__ __forceinline__ void operator()(const f32x4 (&acc)[2][2][4][2], const Unit& u, int wr, int wc, int fr, int fq) const {
        const int row0 = u.pm * BM + wr * 64 + fr, col0 = u.pn * BM + wc * 32 + 8 * fq;
        u32x4 g[2][4][2];
        if (G) {
#pragma unroll
            for (int ai = 0; ai < 2; ++ai)
#pragma unroll
                for (int m = 0; m < 4; ++m)
#pragma unroll
                    for (int bj = 0; bj < 2; ++bj) g[ai][m][bj] = *(const u32x4*)(G + (size_t)(row0 + ai * HALF + m * 16) * ld + col0 + bj * HALF);
            asm volatile("" ::: "memory");
        }
#pragma unroll
        for (int ai = 0; ai < 2; ++ai)
#pragma unroll
            for (int m = 0; m < 4; ++m)
#pragma unroll
                for (int bj = 0; bj < 2; ++bj) { f32x4 v0 = acc[ai][bj][m][0], v1 = acc[ai][bj][m][1];
                    if (G) { f32x4 g0, g1; unpack8(g[ai][m][bj], g0, g1); v0 = v0 * g0; v1 = v1 * g1; }
                    *(u32x4*)(O + (size_t)(row0 + ai * HALF + m * 16) * ld + col0 + bj * HALF) = pack8(v0, v1); }
    }
};
struct EpiMixB {
    static constexpr bool PERM = true, AFTER_DRAIN = false;
    bf16_t* O; const bf16_t* F; const bf16_t* G; int ld;
    __device__ __forceinline__ void operator()(const f32x4 (&acc)[2][2][4][2], const Unit& u, int wr, int wc, int fr, int fq) const {
        const int row0 = u.pm * BM + wr * 64 + fr, col0 = u.pn * BM + wc * 32 + 8 * fq;
#pragma unroll
        for (int ai = 0; ai < 2; ++ai) {
            u32x4 f[4][2], g[4][2];
#pragma unroll
            for (int m = 0; m < 4; ++m)
#pragma unroll
                for (int bj = 0; bj < 2; ++bj) { const size_t o = (size_t)(row0 + ai * HALF + m * 16) * ld + col0 + bj * HALF; f[m][bj] = *(const u32x4*)(F + o); g[m][bj] = *(const u32x4*)(G + o); }
            asm volatile("" ::: "memory");
#pragma unroll
            for (int m = 0; m < 4; ++m)
#pragma unroll
                for (int bj = 0; bj < 2; ++bj) { const size_t o = (size_t)(row0 + ai * HALF + m * 16) * ld + col0 + bj * HALF; f32x4 f0, f1, g0, g1; unpack8(f[m][bj], f0, f1); unpack8(g[m][bj], g0, g1);
                    *(u32x4*)(O + o) = pack8(f0 + acc[ai][bj][m][0] * g0, f1 + acc[ai][bj][m][1] * g1); }
            asm volatile("" ::: "memory"); }
    }
};
template <bool XBF> struct EpiRes {
    static constexpr bool PERM = true, AFTER_DRAIN = false;
    const void* X; bf16_t* O; float* ssq; int ld;
    __device__ __forceinline__ void operator()(const f32x4 (&acc)[2][2][4][2], const Unit& u, int wr, int wc, int fr, int fq) const {
        const int row0 = u.pm * BM + wr * 64 + fr, col0 = u.pn * BM + wc * 32 + 8 * fq;
#pragma unroll
        for (int ai = 0; ai < 2; ++ai) {
            f32x4 xv[4][2][2];
#pragma unroll
            for (int m = 0; m < 4; ++m)
#pragma unroll
                for (int bj = 0; bj < 2; ++bj) { const size_t o = (size_t)(row0 + ai * HALF + m * 16) * ld + col0 + bj * HALF;
                    if (XBF) { const u32x4 t = *(const u32x4*)((const bf16_t*)X + o); unpack8(t, xv[m][bj][0], xv[m][bj][1]); }
                    else { xv[m][bj][0] = *(const f32x4*)((const float*)X + o); xv[m][bj][1] = *(const f32x4*)((const float*)X + o + 4); } }
            asm volatile("" ::: "memory");
#pragma unroll
            for (int m = 0; m < 4; ++m) { const int row = row0 + ai * HALF + m * 16; float s = 0.f;
#pragma unroll
                for (int bj = 0; bj < 2; ++bj) { const f32x4 v0 = xv[m][bj][0] + acc[ai][bj][m][0], v1 = xv[m][bj][1] + acc[ai][bj][m][1];
                    *(u32x4*)(O + (size_t)row * ld + col0 + bj * HALF) = pack8(v0, v1);
                    s += (v0[0] * v0[0] + v0[1] * v0[1]) + (v0[2] * v0[2] + v0[3] * v0[3]) + (v1[0] * v1[0] + v1[1] * v1[1]) + (v1[2] * v1[2] + v1[3] * v1[3]); }
                s += __shfl_xor(s, 16); s += __shfl_xor(s, 32);
                if (fq == 0) unsafeAtomicAdd(ssq + row, s); }
            asm volatile("" ::: "memory"); }
    }
};
struct EpiFfn {
    static constexpr bool PERM = true, AFTER_DRAIN = false;
    bf16_t* O; const float* ssq; int ldo; float kscale;
    __device__ __forceinline__ void operator()(const f32x4 (&acc)[2][2][4][2], const Unit& u, int wr, int wc, int fr, int fq) const {
        const int row0 = u.pm * BM + wr * 64 + fr, col0 = u.pn * HALF + wc * 32 + 8 * fq;
        float sq[2][4];
#pragma unroll
        for (int ai = 0; ai < 2; ++ai)
#pragma unroll
            for (int m = 0; m < 4; ++m) sq[ai][m] = ssq[row0 + ai * HALF + m * 16];
        asm volatile("" ::: "memory");
#pragma unroll
        for (int ai = 0; ai < 2; ++ai)
#pragma unroll
            for (int m = 0; m < 4; ++m) { const int row = row0 + ai * HALF + m * 16; const float rs = kscale * __builtin_amdgcn_rsqf(sq[ai][m] * (1.0f / 2048.0f) + 1e-6f);
                f32x4 v[2];
#pragma unroll
                for (int n = 0; n < 2; ++n)
#pragma unroll
                    for (int j = 0; j < 4; ++j) { const float g = rs * acc[ai][0][m][n][j], uu = rs * acc[ai][1][m][n][j]; v[n][j] = g * sig_(g) * uu; }
                EPI_ST16(O + (size_t)row * ldo + col0, pack8(v[0], v[1])); }
    }
};
struct EpiPle {
    static constexpr bool PERM = true, AFTER_DRAIN = false;
    const bf16_t* X; const bf16_t* P; float* out; const float* ssq; int ld;
    __device__ __forceinline__ void operator()(const f32x4 (&acc)[2][2][4][2], const Unit& u, int wr, int wc, int fr, int fq) const {
        const int row0 = u.pm * BM + wr * 64 + fr, col0 = u.pn * BM + wc * 32 + 8 * fq;
        float sq[2][4];
#pragma unroll
        for (int ai = 0; ai < 2; ++ai)
#pragma unroll
            for (int m = 0; m < 4; ++m) sq[ai][m] = ssq[row0 + ai * HALF + m * 16];
#pragma unroll
        for (int ai = 0; ai < 2; ++ai) {
            u32x4 xv[4][2], pv[4][2];
#pragma unroll
            for (int m = 0; m < 4; ++m)
#pragma unroll
                for (int bj = 0; bj < 2; ++bj) { const size_t o = (size_t)(row0 + ai * HALF + m * 16) * ld + col0 + bj * HALF; xv[m][bj] = *(const u32x4*)(X + o); pv[m][bj] = *(const u32x4*)(P + o); }
            asm volatile("" ::: "memory");
#pragma unroll
            for (int m = 0; m < 4; ++m) { const float rs = __builtin_amdgcn_rsqf(sq[ai][m] * (1.0f / 2048.0f) + 1e-6f);
#pragma unroll
                for (int bj = 0; bj < 2; ++bj) { const size_t o = (size_t)(row0 + ai * HALF + m * 16) * ld + col0 + bj * HALF; f32x4 x0, x1, p0, p1, r0, r1; unpack8(xv[m][bj], x0, x1); unpack8(pv[m][bj], p0, p1);
#pragma unroll
                    for (int j = 0; j < 4; ++j) { r0[j] = x0[j] + sig_(rs * acc[ai][bj][m][0][j]) * p0[j]; r1[j] = x1[j] + sig_(rs * acc[ai][bj][m][1][j]) * p1[j]; }
                    *(f32x4*)(out + o) = r0; *(f32x4*)(out + o + 4) = r1; } }
            asm volatile("" ::: "memory"); }
    }
};
template <class Epi, class Sched, bool ALIGN_EPI = false, bool SP2 = false, int KREP = 1, int EREP = 1>
__device__ __forceinline__ void gemm_phase(PG8_LAS unsigned char* lds, const Gemm g, const Sched& S, const Epi& E) {
    const int tid = threadIdx.x, wid = __builtin_amdgcn_readfirstlane(tid >> 6), lane = tid & 63, wr = wid >> 2, wc = wid & 3, fr = lane & 15, fq = lane >> 4;
    const int K = g.K, nt = K / BK;
    unsigned voffA[2], voffB[2];
#pragma unroll
    for (int i = 0; i < 2; ++i) { int R, C; stage_rc(tid * 16 + i * 8192, R, C); const int Rb = Epi::PERM ? ((R & ~31) + perm32(R & 31)) : R;
        voffA[i] = (unsigned)(R * K + C) * 2u; voffB[i] = (unsigned)(Rb * K + C) * 2u; }
    const size_t kstep = (size_t)(BK * 2);
    const size_t hstep = (size_t)HALF * K * 2;
    const size_t tstep = 2 * hstep;
    const unsigned ldsw = (unsigned)wid * 1024u;
    const int aoff = lds_byte(wr * 64 + fr, fq * 8), boff = lds_byte(wc * 32 + fr, fq * 8);
#define PG8_SA(b, h) (((b) * 2 + (h)) * HTB)
#define PG8_SB(b, h) ((4 + (b) * 2 + (h)) * HTB)
#define PG8_STAGE(bufoff, gbase, voff) do { _Pragma("unroll") for (int _i = 0; _i < 2; ++_i) \
        __builtin_amdgcn_global_load_lds((const unsigned*)((const char*)(gbase) + (voff)[_i]), (PG8_LAS unsigned*)(lds + (bufoff) + ldsw + _i * 8192), 16, 0, 0); } while (0)
#define PG8_LDA(dst, b, h) do { _Pragma("unroll") for (int m = 0; m < 4; ++m) _Pragma("unroll") for (int k = 0; k < 2; ++k) dst[m][k] = *(const PG8_LAS bf16x8*)(lds + PG8_SA(b, h) + aoff + m * 2048 + k * 1024); } while (0)
#define PG8_LDB(dst, b, h) do { _Pragma("unroll") for (int n = 0; n < 2; ++n) _Pragma("unroll") for (int k = 0; k < 2; ++k) dst[n][k] = *(const PG8_LAS bf16x8*)(lds + PG8_SB(b, h) + boff + n * 2048 + k * 1024); } while (0)
#define PG8_MMA(ai, bj, At, Bt) do { __builtin_amdgcn_s_setprio(1); _Pragma("unroll") for (int m = 0; m < 4; ++m) _Pragma("unroll") for (int n = 0; n < 2; ++n) _Pragma("unroll") for (int k = 0; k < 2; ++k) \
        acc[ai][bj][m][n] = __builtin_amdgcn_mfma_f32_16x16x32_bf16(Bt[n][k], At[m][k], acc[ai][bj][m][n], 0, 0, 0); __builtin_amdgcn_s_setprio(0); } while (0)
#define PG8_WAIT_V(n) asm volatile("s_waitcnt vmcnt(" #n ")" ::: "memory")
#define PG8_WAIT_L(n) asm volatile("s_waitcnt lgkmcnt(" #n ")" ::: "memory")
#define PG8_BAR __builtin_amdgcn_s_barrier()
#define PG8_SCHED __builtin_amdgcn_sched_barrier(0)
    Unit cur, nxt; int ui = 0;
    if (!S.next(0, cur)) return;
    f32x4 acc[2][2][4][2];
#pragma unroll
    for (int a = 0; a < 2; ++a)
#pragma unroll
        for (int b = 0; b < 2; ++b)
#pragma unroll
            for (int m = 0; m < 4; ++m)
#pragma unroll
                for (int n = 0; n < 2; ++n) acc[a][b][m][n] = (f32x4){0.f, 0.f, 0.f, 0.f};
    bf16x8 At[4][2], B0[2][2], B1[2][2];
    const char* cA = (const char*)g.A + (size_t)cur.pm * tstep; const char* cB = (const char*)g.Bt + (size_t)cur.pn * tstep;
    S.a_ready(cur);
    if constexpr (SP2) {
        PG8_STAGE(PG8_SB(0, 0), cB, voffB); PG8_STAGE(PG8_SB(0, 1), cB + hstep, voffB); PG8_STAGE(PG8_SA(0, 0), cA, voffA); PG8_STAGE(PG8_SA(0, 1), cA + hstep, voffA);
        if (wr == 1) PG8_BAR;
        PG8_WAIT_V(2); PG8_BAR;
        PG8_STAGE(PG8_SB(1, 0), cB + kstep, voffB); PG8_STAGE(PG8_SA(1, 0), cA + kstep, voffA); PG8_STAGE(PG8_SB(1, 1), cB + hstep + kstep, voffB);
        PG8_WAIT_V(6); PG8_BAR;
    } else {
        PG8_STAGE(PG8_SB(0, 0), cB, voffB); PG8_STAGE(PG8_SA(0, 0), cA, voffA); PG8_STAGE(PG8_SB(0, 1), cB + hstep, voffB); PG8_STAGE(PG8_SA(0, 1), cA + hstep, voffA);
        if (wr == 1) PG8_BAR;
        PG8_WAIT_V(4); PG8_BAR;
        PG8_STAGE(PG8_SB(1, 0), cB + kstep, voffB); PG8_STAGE(PG8_SA(1, 0), cA + kstep, voffA); PG8_STAGE(PG8_SB(1, 1), cB + hstep + kstep, voffB);
        PG8_WAIT_V(6); PG8_BAR;
    }
    for (;;) {
        const bool has_next = S.next(ui + 1, nxt);
        const char* nA = has_next ? (const char*)g.A + (size_t)nxt.pm * tstep : cA; const char* nB = has_next ? (const char*)g.Bt + (size_t)nxt.pn * tstep : cB;
        for (int pass = 0; pass < KREP; ++pass)
        for (int t = 0; t < nt; t += 2) {
            const bool lastpass = (pass == KREP - 1);
            const bool last = (t == nt - 2);
            const char* a1 = cA + (size_t)(t + 1) * kstep;
            const char* a2 = last ? (lastpass ? nA : cA) : cA + (size_t)(t + 2) * kstep; const char* b2 = last ? (lastpass ? nB : cB) : cB + (size_t)(t + 2) * kstep;
            const char* a3 = a2 + kstep; const char* b3 = b2 + kstep;
            if (last && has_next && lastpass) S.a_ready(nxt);
            if constexpr (SP2) {
            PG8_LDB(B0, 0, 0); PG8_LDB(B1, 0, 1); PG8_SCHED; PG8_LDA(At, 0, 0); PG8_STAGE(PG8_SA(1, 1), a1 + hstep, voffA);
            PG8_WAIT_V(8); PG8_WAIT_L(0); PG8_BAR; PG8_MMA(0, 0, At, B0); PG8_MMA(0, 1, At, B1); PG8_BAR; PG8_SCHED;
            PG8_LDA(At, 0, 1); PG8_STAGE(PG8_SB(0, 0), b2, voffB); PG8_STAGE(PG8_SB(0, 1), b2 + hstep, voffB); PG8_STAGE(PG8_SA(0, 0), a2, voffA);
            PG8_WAIT_V(8); PG8_WAIT_L(0); PG8_BAR; PG8_MMA(1, 0, At, B0); PG8_MMA(1, 1, At, B1); PG8_BAR; PG8_SCHED;
            PG8_LDB(B0, 1, 0); PG8_LDB(B1, 1, 1); PG8_SCHED; PG8_LDA(At, 1, 0); PG8_STAGE(PG8_SA(0, 1), a2 + hstep, voffA);
            PG8_WAIT_V(8); PG8_WAIT_L(0); PG8_BAR; PG8_MMA(0, 0, At, B0); PG8_MMA(0, 1, At, B1); PG8_BAR; PG8_SCHED;
            PG8_LDA(At, 1, 1); PG8_STAGE(PG8_SB(1, 0), b3, voffB); PG8_STAGE(PG8_SB(1, 1), b3 + hstep, voffB); PG8_STAGE(PG8_SA(1, 0), a3, voffA);
            PG8_WAIT_V(8); PG8_WAIT_L(0); PG8_BAR; PG8_MMA(1, 0, At, B0); PG8_MMA(1, 1, At, B1); PG8_BAR; PG8_SCHED;
            } else {
            PG8_LDB(B0, 0, 0); PG8_SCHED; PG8_LDA(At, 0, 0); PG8_STAGE(PG8_SA(1, 1), a1 + hstep, voffA);
            PG8_WAIT_L(8); PG8_BAR; PG8_WAIT_L(0); PG8_MMA(0, 0, At, B0); PG8_BAR; PG8_SCHED;
            PG8_LDB(B1, 0, 1); PG8_STAGE(PG8_SB(0, 0), b2, voffB);
            PG8_BAR; PG8_WAIT_L(0); PG8_MMA(0, 1, At, B1); PG8_BAR;
            PG8_LDA(At, 0, 1); PG8_STAGE(PG8_SA(0, 0), a2, voffA);
            PG8_BAR; PG8_WAIT_L(0); PG8_MMA(1, 0, At, B0); PG8_BAR; PG8_SCHED;
            PG8_STAGE(PG8_SB(0, 1), b2 + hstep, voffB);
            PG8_WAIT_V(6); PG8_BAR; PG8_MMA(1, 1, At, B1); PG8_BAR;
            PG8_LDB(B0, 1, 0); PG8_SCHED; PG8_LDA(At, 1, 0); PG8_STAGE(PG8_SA(0, 1), a2 + hstep, voffA);
            PG8_WAIT_L(8); PG8_BAR; PG8_WAIT_L(0); PG8_MMA(0, 0, At, B0); PG8_BAR; PG8_SCHED;
            PG8_LDB(B1, 1, 1); PG8_STAGE(PG8_SB(1, 0), b3, voffB);
            PG8_BAR; PG8_WAIT_L(0); PG8_MMA(0, 1, At, B1); PG8_BAR;
            PG8_LDA(At, 1, 1); PG8_STAGE(PG8_SA(1, 0), a3, voffA);
            PG8_BAR; PG8_WAIT_L(0); PG8_MMA(1, 0, At, B0); PG8_BAR; PG8_SCHED;
            PG8_STAGE(PG8_SB(1, 1), b3 + hstep, voffB);
            PG8_WAIT_V(6); PG8_BAR; PG8_MMA(1, 1, At, B1); PG8_BAR;
            }
        }
        if constexpr (ALIGN_EPI) { if (wr == 0) PG8_BAR; }
        if constexpr (!Epi::AFTER_DRAIN) { for (int er = 0; er < EREP; ++er) E(acc, cur, wr, wc, fr, fq); S.done(cur); }
        if (!has_next) break;
#pragma unroll
        for (int a = 0; a < 2; ++a)
#pragma unroll
            for (int b = 0; b < 2; ++b)
#pragma unroll
                for (int m = 0; m < 4; ++m)
#pragma unroll
                    for (int n = 0; n < 2; ++n) acc[a][b][m][n] = (f32x4){0.f, 0.f, 0.f, 0.f};
        cur = nxt; cA = nA; cB = nB; ++ui;
        if constexpr (ALIGN_EPI) { if (wr == 1) PG8_BAR; }
    }
    PG8_WAIT_V(0);
    if constexpr (!ALIGN_EPI) { if (wr == 0) PG8_BAR; }
    PG8_BAR;
    if constexpr (Epi::AFTER_DRAIN) { E.fused(acc, cur, wr, wc, fr, fq, lds, wid, lane); S.done(cur); }
#undef PG8_SA
#undef PG8_SB
#undef PG8_STAGE
#undef PG8_LDA
#undef PG8_LDB
#undef PG8_MMA
#undef PG8_WAIT_V
#undef PG8_WAIT_L
#undef PG8_BAR
#undef PG8_SCHED
}
}

#define GAS __attribute__((address_space(1)))
#define RLX_AGENT __ATOMIC_RELAXED, __HIP_MEMORY_SCOPE_AGENT
#define XB_TMO      128
#define XB_XCNT(j)  (256  + 64 * (j))
#define XB_XSUB(j)  (1280 + 64 * (j))
#define XB_XGEN(j)  (2304 + 64 * (j))
#define XB_TOP      3328
#define XB_TOPGEN   3392
#define XCD_BAR_WORDS 3456
#define XB_SPIN_CAP (1u << 18)

__device__ __forceinline__ unsigned xb_ld(unsigned* p)              { return __hip_atomic_load(p, __ATOMIC_RELAXED, __HIP_MEMORY_SCOPE_AGENT); }
__device__ __forceinline__ unsigned xb_add(unsigned* p, unsigned v) { return __hip_atomic_fetch_add(p, v, __ATOMIC_RELAXED, __HIP_MEMORY_SCOPE_AGENT); }
__device__ __forceinline__ unsigned xb_xcc_id() { return (unsigned)__builtin_amdgcn_s_getreg((3 << 11) | 20) & 0xFu; }
#define XB_SPIN(cond, bar) do { unsigned _sp = 0; while (cond) { __builtin_amdgcn_s_sleep(1); \
    if ((++_sp & 255u) == 0u) { if (xb_ld(&(bar)[XB_TMO])) break; if (_sp > XB_SPIN_CAP) { atomicAdd(&(bar)[XB_TMO], 1u); break; } } } } while (0)

struct XcdBarrier {
    unsigned* bar; unsigned x;
    volatile LAS unsigned* st;
};

__device__ __forceinline__ XcdBarrier xcd_barrier_post(unsigned* bar, volatile LAS unsigned* st) {
    XcdBarrier b; b.bar = bar; b.x = xb_xcc_id(); b.st = st;
    if (threadIdx.x == 0) st[2] = xb_add(&bar[XB_XCNT(b.x)], 1u);
    return b;
}
__device__ __forceinline__ void xcd_barrier_complete(unsigned* bar, unsigned x, unsigned& nloc, unsigned& nx) {
    const unsigned G = gridDim.x * gridDim.y * gridDim.z;
    unsigned sum, cnt, mine, sp = 0u;
    for (;;) {
        sum = 0u; cnt = 0u; mine = 0u;
#pragma unroll
        for (unsigned j = 0; j < 16; ++j) { const unsigned c = xb_ld(&bar[XB_XCNT(j)]); sum += c; cnt += (c > 0u) ? 1u : 0u; mine = (j == x) ? c : mine; }
        if (sum == G) break;
        __builtin_amdgcn_s_sleep(1);
        if ((++sp & 255u) == 0u) { if (xb_ld(&bar[XB_TMO])) break; if (sp > XB_SPIN_CAP) { atomicAdd(&bar[XB_TMO], 1u); break; } }
    }
    nloc = mine > 0u ? mine : 1u; nx = cnt > 0u ? cnt : 1u;
}

__device__ __forceinline__ void xcd_barrier(const XcdBarrier& b) {
    asm volatile("s_waitcnt vmcnt(0)" ::: "memory");
    __syncthreads();
    if (threadIdx.x == 0) {
        unsigned* bar = b.bar;
        __builtin_amdgcn_s_waitcnt(0);
        unsigned nloc = b.st[0], nx = b.st[1];
        if (nloc == 0u) { xcd_barrier_complete(bar, b.x, nloc, nx); b.st[0] = nloc; b.st[1] = nx; }
        const unsigned old = xb_add(&bar[XB_XSUB(b.x)], 1u);
        const unsigned gen = old / nloc;
        if (old + 1u == (gen + 1u) * nloc) {
            __builtin_amdgcn_fence(__ATOMIC_RELEASE, "agent");
            asm volatile("s_waitcnt vmcnt(0)" ::: "memory");
            const unsigned og = xb_add(&bar[XB_TOP], 1u);
            const unsigned tg = og / nx;
            if (og + 1u == (tg + 1u) * nx) xb_add(&bar[XB_TOPGEN], 1u);
            else XB_SPIN(xb_ld(&bar[XB_TOPGEN]) == tg, bar);
            __builtin_amdgcn_fence(__ATOMIC_ACQUIRE, "agent");
            xb_add(&bar[XB_XGEN(b.x)], 1u);
            asm volatile("s_waitcnt vmcnt(0)" ::: "memory");
        } else {
            XB_SPIN(xb_ld(&bar[XB_XGEN(b.x)]) == gen, bar);
            __builtin_amdgcn_fence(__ATOMIC_ACQUIRE, "agent");
            asm volatile("s_waitcnt vmcnt(0)" ::: "memory");
        }
    }
    __syncthreads();
}


__device__ __forceinline__ void xcd_local_barrier(unsigned* bar2, unsigned x, unsigned nloc) {
    asm volatile("s_waitcnt vmcnt(0)" ::: "memory");
    __syncthreads();
    if (threadIdx.x == 0) {
        __builtin_amdgcn_s_waitcnt(0);
        const unsigned old = xb_add(&bar2[XB_XSUB(x)], 1u);
        const unsigned gen = old / nloc;
        if (old + 1u == (gen + 1u) * nloc) xb_add(&bar2[XB_XGEN(x)], 1u);
        else XB_SPIN(xb_ld(&bar2[XB_XGEN(x)]) == gen, bar2);
        __builtin_amdgcn_fence(__ATOMIC_ACQUIRE, "agent");
        asm volatile("s_waitcnt vmcnt(0)" ::: "memory");
    }
    __syncthreads();
}

#ifndef ONLYP
#define ONLYP -1
#endif
constexpr int ONLY = ONLYP;
#define PHON(k) (ONLY < 0 || ONLY == (k))
#ifndef P7_ALIGN
#define P7_ALIGN true
#endif
#ifndef P7_SP2
#define P7_SP2 true
#endif
#ifndef P7_KREP
#define P7_KREP 1
#endif
#ifndef P7_EREP
#define P7_EREP 1
#endif
#ifndef P1_KREP
#define P1_KREP 1
#endif
#ifndef P1_EREP
#define P1_EREP 1
#endif
#ifndef USE_CG_SYNC
#define USE_CG_SYNC 0
#endif
#ifndef LATE_CONV
#define LATE_CONV 1
#endif
#ifndef LC_P2
#define LC_P2 0
#endif
#ifndef LC_P4
#define LC_P4 0
#endif
#ifndef LC_WAO_TAIL
#define LC_WAO_TAIL 1
#endif
#ifndef LC_P7TAIL
#define LC_P7TAIL 1
#endif
#ifndef LC_P1TAIL
#define LC_P1TAIL 1
#endif
#ifndef TAIL_EXTRA
#define TAIL_EXTRA 0
#endif
#ifndef P2_SWAP
#define P2_SWAP 1
#endif
#ifndef DUPMASK
#define DUPMASK 0
#endif
#define NREP(k) (((DUPMASK >> (k)) & 1) + 1)
constexpr size_t SM_DUMMY = 2 * MiB;
constexpr int NWAVES = 8, NTHREADS = NWAVES * 64;
constexpr int RING_BYTES = 131072, XCH_OFF = RING_BYTES, XCH_BYTES = 8192, MISC_OFF = XCH_OFF + XCH_BYTES, LDS_BYTES = 147456;
static_assert(MISC_OFF + 64 <= LDS_BYTES, "LDS map");
constexpr size_t SM_CTL = 3 * MiB, CTL_BYTES = 65536;
constexpr int VST_PITCH = 320, VST_BYTES = 32 * VST_PITCH;
static_assert(NWAVES * VST_BYTES <= RING_BYTES, "attention scratch");

enum { F_P0 = 1, F_G1 = 2, F_CONV = 4, F_ATTN = 8, F_RNN = 16, F_YA = 32, F_YR = 64, F_WO = 128, F_FFU = 256, F_FFD = 512, F_PLE = 1024, F_ALL = 2047 };

struct Args {
    const float *x, *p, *g_mix, *w_in, *conv_w, *conv_b, *w_rg_a, *b_rg_a, *w_rg_x, *b_rg_x, *lam, *q_gain, *k_gain, *w_rnn_out, *w_attn_out, *w_o, *g_ffn, *w_gu, *w_dn, *g_ple, *w_pg, *w_pp;
    float* out; unsigned char* ws; int ph_lo, ph_hi, mask, pad;
};

__device__ __forceinline__ int crow(int reg, int h) { return (reg & 3) + 8 * (reg >> 2) + 4 * h; }
#define MFMA32(a, b, c) __builtin_amdgcn_mfma_f32_32x32x16_bf16((a), (b), (c), 0, 0, 0)
__device__ __forceinline__ unsigned pk2(float lo, float hi) { unsigned r; asm("v_cvt_pk_bf16_f32 %0, %1, %2" : "=v"(r) : "v"(lo), "v"(hi)); return r; }
__device__ __forceinline__ unsigned short f2bf_hw(float f) { return (unsigned short)pk2(f, f); }

constexpr int CI_W1 = (DM / 64) * (DIN / 64), CI_WAO = (DM / 64) * (DM / 64), CI_WRO = (DR / 64) * (DM / 64), CI_WO = CI_WAO, CI_WGU = (DM / 64) * (2 * DFF / 64), CI_WDN = (DFF / 64) * (DM / 64), CI_WPG = CI_WAO, CI_WPP = (PLE / 64) * (DM / 64);
constexpr int CI_P0 = 0, CI_P2 = CI_P0 + CI_W1 + CI_WAO, CI_P3 = CI_P2 + CI_WRO + CI_WO, CI_P4 = CI_P3 + CI_WGU, CI_END = CI_P4 + CI_WDN + CI_WPG + CI_WPP;
struct CvtItem { const float* wp; const float* ks; bf16_t* out; int ldw, Kdim; };
__device__ __forceinline__ CvtItem cvt_decode(const Args& a, int it, int lane) {
    unsigned char* ws = a.ws; int r = it; const float* W; const float* ks = nullptr; bf16_t* WT; int ldw, Kdim, nb; bool gu = false;
    if (r < CI_W1) { W = a.w_in; ldw = DIN; Kdim = DM; WT = (bf16_t*)(ws + WS_W1); nb = DIN / 64; }
    else if ((r -= CI_W1) < CI_WAO) { W = a.w_attn_out; ldw = DM; Kdim = DM; WT = (bf16_t*)(ws + WS_WAO); nb = DM / 64; }
    else if ((r -= CI_WAO) < CI_WRO) { W = a.w_rnn_out; ldw = DM; Kdim = DR; WT = (bf16_t*)(ws + WS_WRO); nb = DM / 64; }
    else if ((r -= CI_WRO) < CI_WO) { W = a.w_o; ldw = DM; Kdim = DM; WT = (bf16_t*)(ws + WS_WO); nb = DM / 64; }
    else if ((r -= CI_WO) < CI_WGU) { W = a.w_gu; ldw = 2 * DFF; Kdim = DM; WT = (bf16_t*)(ws + WS_WGU); nb = 2 * DFF / 64; ks = a.g_ffn; gu = true; }
    else if ((r -= CI_WGU) < CI_WDN) { W = a.w_dn; ldw = DM; Kdim = DFF; WT = (bf16_t*)(ws + WS_WDN); nb = DM / 64; }
    else if ((r -= CI_WDN) < CI_WPG) { W = a.w_pg; ldw = DM; Kdim = DM; WT = (bf16_t*)(ws + WS_WPG); nb = DM / 64; ks = a.g_ple; }
    else { r -= CI_WPG; W = a.w_pp; ldw = DM; Kdim = PLE; WT = (bf16_t*)(ws + WS_WPP); nb = DM / 64; }
    const int k0 = 64 * (r / nb), n0 = 64 * (r % nb);
    int orow = n0;
    if (gu) { const int isu = n0 >= DFF ? 1 : 0; const int j0 = n0 - isu * DFF; orow = (j0 >> 7) * 256 + isu * 128 + (j0 & 127); }
    CvtItem d; d.wp = W + (size_t)k0 * ldw + n0 + lane; d.ks = ks ? ks + k0 : nullptr; d.out = WT + (size_t)orow * Kdim + k0; d.ldw = ldw; d.Kdim = Kdim; return d;
}
__device__ __forceinline__ void cvt_load(const CvtItem& d, float (&v)[64]) {
#pragma unroll
    for (int i = 0; i < 64; ++i) v[i] = __builtin_nontemporal_load(d.wp + (size_t)i * d.ldw);
}
__device__ __forceinline__ void cvt_finish(const CvtItem& d, float (&v)[64], LAS unsigned* scr, int lane) {
    if (d.ks) {
#pragma unroll
        for (int i = 0; i < 64; ++i) v[i] *= d.ks[i]; }
#pragma unroll
    for (int i = 0; i < 32; ++i) scr[i * 65 + lane] = pk2(v[2 * i], v[2 * i + 1]);
    asm volatile("s_waitcnt lgkmcnt(0)" ::: "memory");
    const int c = lane & 7;
#pragma unroll
    for (int j = 0; j < 8; ++j) { const int nn = (lane >> 3) + 8 * j; const LAS unsigned* s = scr + (4 * c) * 65 + nn;
        u32x4 o; o.x = s[0]; o.y = s[65]; o.z = s[130]; o.w = s[195];
        *(u32x4*)(d.out + (size_t)nn * d.Kdim + 8 * c) = o; }
    asm volatile("s_waitcnt lgkmcnt(0)" ::: "memory");
}
__device__ __forceinline__ void convert_range(const Args& a, LAS unsigned char* wl, int lane, int lo, int hi, int gw, int ngw) {
    LAS unsigned* scr = (LAS unsigned*)wl;
    int it = lo + gw; if (it >= hi) return;
    float va[64], vb[64];
    CvtItem da = cvt_decode(a, it, lane), db = da; cvt_load(da, va);
    for (;;) {
        it += ngw; const bool hb_ = it < hi; if (hb_) { db = cvt_decode(a, it, lane); cvt_load(db, vb); }
        cvt_finish(da, va, scr, lane); if (!hb_) break;
        it += ngw; const bool ha_ = it < hi; if (ha_) { da = cvt_decode(a, it, lane); cvt_load(da, va); }
        cvt_finish(db, vb, scr, lane); if (!ha_) break;
    }
}
__device__ __forceinline__ void p0_prologue(const Args& a, LAS unsigned char* lds, int gw, int ngw, int lane, int gtid, int ngt) {
    unsigned char* ws = a.ws;
    { const f32x4* pp = (const f32x4*)a.p; u32x2* po = (u32x2*)(ws + WS_PB);
      for (int i = gtid; i < M * PLE / 4; i += ngt) { const f32x4 v = __builtin_nontemporal_load(pp + i); u32x2 w; w.x = pk2(v[0], v[1]); w.y = pk2(v[2], v[3]); po[i] = w; } }
    { bf16_t* wra = (bf16_t*)(ws + WS_WRA); bf16_t* wrx = (bf16_t*)(ws + WS_WRX);
      for (int i = gtid; i < NRB * RB * RBP; i += ngt) { const int c = i % RBP, d = (i / RBP) % RB, n = i / (RBP * RB);
          const size_t src = ((size_t)n * RB + (c < RB ? c : 0)) * RB + d;
          wra[i] = c < RB ? f2bf_hw(a.w_rg_a[src]) : (bf16_t)0; wrx[i] = c < RB ? f2bf_hw(a.w_rg_x[src]) : (bf16_t)0; } }
    { float* z = (float*)(ws + WS_SMALL); for (int i = gtid; i < 2 * M; i += ngt) z[i] = 0.f; }
    if (LATE_CONV && !LC_P4) convert_range(a, lds + (threadIdx.x >> 6) * 16384, lane, (LC_P7TAIL && gridDim.x == 256) ? CI_P4 + CI_WDN + CI_WPG : CI_P4, CI_END, gw, ngw);
    convert_range(a, lds + (threadIdx.x >> 6) * 16384, lane, CI_P0, LATE_CONV ? ((LC_WAO_TAIL && gridDim.x == 256) ? CI_W1 : CI_P2) : CI_END, gw, ngw);
    bf16_t* hb = (bf16_t*)(ws + WS_HB);
    for (int m = gw; m < M; m += ngw) {
        const f32x4* xr = (const f32x4*)(a.x + (size_t)m * DM) + lane; const f32x4* gr = (const f32x4*)a.g_mix + lane;
        f32x4 v[8]; float s = 0.f;
#pragma unroll
        for (int j = 0; j < 8; ++j) { v[j] = __builtin_nontemporal_load(xr + 64 * j); s += (v[j][0] * v[j][0] + v[j][1] * v[j][1]) + (v[j][2] * v[j][2] + v[j][3] * v[j][3]); }
        const float rs = 1.0f / sqrtf(wave_sum(s) * (1.0f / DM) + EPS);
        u32x2* o8 = (u32x2*)(hb + (size_t)m * DM) + lane;
#pragma unroll
        for (int j = 0; j < 8; ++j) { const f32x4 g = gr[64 * j]; u32x2 w; w.x = pk2(v[j][0] * rs * g[0], v[j][1] * rs * g[1]); w.y = pk2(v[j][2] * rs * g[2], v[j][3] * rs * g[3]); o8[64 * j] = w; }
    }
}

__device__ __forceinline__ void conv_phase(const Args& a, int gtid, int ngt) {
    const bf16_t* xr = (const bf16_t*)(a.ws + WS_XR); bf16_t* xc = (bf16_t*)(a.ws + WS_XC);
    constexpr int NCG = DR / 8;
    for (int it = gtid; it < (M / 8) * NCG; it += ngt) {
        const int cg = it % NCG, rg = it / NCG, c0 = cg * 8, m0 = rg * 8;
        f32x4 w[4][2]; f32x4 bb[2];
#pragma unroll
        for (int j = 0; j < 4; ++j) { w[j][0] = *(const f32x4*)(a.conv_w + (size_t)j * DR + c0); w[j][1] = *(const f32x4*)(a.conv_w + (size_t)j * DR + c0 + 4); }
        bb[0] = *(const f32x4*)(a.conv_b + c0); bb[1] = *(const f32x4*)(a.conv_b + c0 + 4);
        f32x4 win[3][2];
        const bool first = (m0 & (SEQ - 1)) == 0;
#pragma unroll
        for (int j = 0; j < 3; ++j) {
            if (first) { win[j][0] = (f32x4){0.f, 0.f, 0.f, 0.f}; win[j][1] = win[j][0]; }
            else { const u32x4 t = *(const u32x4*)(xr + (size_t)(m0 - 3 + j) * DR + c0); win[j][0] = (f32x4){pg8::bflo(t.x), pg8::bfhi(t.x), pg8::bflo(t.y), pg8::bfhi(t.y)}; win[j][1] = (f32x4){pg8::bflo(t.z), pg8::bfhi(t.z), pg8::bflo(t.w), pg8::bfhi(t.w)}; } }
#pragma unroll
        for (int i = 0; i < 8; ++i) {
            const u32x4 t = *(const u32x4*)(xr + (size_t)(m0 + i) * DR + c0);
            const f32x4 c0v = (f32x4){pg8::bflo(t.x), pg8::bfhi(t.x), pg8::bflo(t.y), pg8::bfhi(t.y)}, c1v = (f32x4){pg8::bflo(t.z), pg8::bfhi(t.z), pg8::bflo(t.w), pg8::bfhi(t.w)};
            const f32x4 y0 = bb[0] + w[0][0] * win[0][0] + w[1][0] * win[1][0] + w[2][0] * win[2][0] + w[3][0] * c0v;
            const f32x4 y1 = bb[1] + w[0][1] * win[0][1] + w[1][1] * win[1][1] + w[2][1] * win[2][1] + w[3][1] * c1v;
            *(u32x4*)(xc + (size_t)(m0 + i) * DR + c0) = pg8::pack8(y0, y1);
            win[0][0] = win[1][0]; win[0][1] = win[1][1]; win[1][0] = win[2][0]; win[1][1] = win[2][1]; win[2][0] = c0v; win[2][1] = c1v;
        }
    }
}

typedef short v4i16_t __attribute__((ext_vector_type(4)));
__device__ __forceinline__ s16x4 vtr(const LAS unsigned char* p) { return __builtin_bit_cast(s16x4, __builtin_amdgcn_ds_read_tr16_b64_v4i16((LAS v4i16_t*)p)); }
__device__ __forceinline__ void attn_unit(int b, int hh, int qb, const bf16_t* __restrict__ qn, const bf16_t* __restrict__ kn, const bf16_t* __restrict__ vv, bf16_t* __restrict__ ob, LAS unsigned char* wl, int lane) {
    LAS unsigned char* wk_ = wl; LAS unsigned char* wv_ = wl + 8192;
    const int r = lane & 31, h = lane >> 5;
    const size_t rowb = (size_t)b * SEQ;
    const int q0 = qb * 32;
#define AT_GLDS(src, dst) __builtin_amdgcn_global_load_lds((const unsigned*)(src), (LAS unsigned*)(dst), 16, 0, 0)
#define AT_ISSUE_K(kb_) do { int ln_ = lane; asm volatile("" : "+v"(ln_)); const bf16_t* kp_ = kn + (rowb + (size_t)(kb_) * 32) * DM + hh * HD; \
        _Pragma("unroll") for (int j = 0; j < 8; ++j) { const int row = (ln_ >> 4) + 4 * j; AT_GLDS(kp_ + (size_t)row * DM + (((ln_ & 15) ^ (row & 15)) * 8), wk_ + j * 1024); } } while (0)
#define AT_ISSUE_V(kb_) do { int ln_ = lane; asm volatile("" : "+v"(ln_)); const bf16_t* vp_ = vv + (rowb + (size_t)(kb_) * 32) * DM + hh * HD + (((ln_ & 15) ^ (4 * ((ln_ >> 4) & 3))) * 8); \
        _Pragma("unroll") for (int j = 0; j < 8; ++j) AT_GLDS(vp_ + (size_t)((ln_ >> 4) + 4 * j) * DM, wv_ + j * 1024); } while (0)
    bf16x8 qf[8];
    { const bf16_t* qp = qn + (rowb + q0 + r) * DM + hh * HD + 8 * h;
#pragma unroll
      for (int ks = 0; ks < 8; ++ks) qf[ks] = *(const bf16x8*)(qp + 16 * ks); }
    AT_ISSUE_K(qb); AT_ISSUE_V(qb);
    f32x16 o[4];
#pragma unroll
    for (int d = 0; d < 4; ++d)
#pragma unroll
        for (int i = 0; i < 16; ++i) o[d][i] = 0.f;
    float Rp = 1.0f;
    const int i16 = lane & 15, tq = i16 >> 2, tp = i16 & 3, blk = (lane >> 4) & 1;
    const LAS unsigned char* trb = wv_ + (4 * h + tq) * 256 + 32 * blk + 8 * tp;
    const LAS unsigned char* krb = wk_ + r * 256;
    for (int kb = qb; kb >= 0; --kb) {
        if (kb > 0) asm volatile("s_waitcnt vmcnt(8)" ::: "memory"); else asm volatile("s_waitcnt vmcnt(0)" ::: "memory");
        bf16x8 kf[8];
#pragma unroll
        for (int ks = 0; ks < 8; ++ks) kf[ks] = *(const LAS bf16x8*)(krb + (((2 * ks + h) ^ (r & 15)) * 16));
        asm volatile("s_waitcnt lgkmcnt(0)" ::: "memory");
        __builtin_amdgcn_sched_barrier(0);
        if (kb > 0) AT_ISSUE_K(kb - 1);
        __builtin_amdgcn_sched_barrier(0);
        f32x16 x;
#pragma unroll
        for (int i = 0; i < 16; ++i) x[i] = 0.f;
#pragma unroll
        for (int ks = 0; ks < 8; ++ks) x = MFMA32(kf[ks], qf[ks], x);
        const bool diag = (kb == qb);
        float kp[16], bt[16];
#pragma unroll
        for (int i = 0; i < 16; ++i) { const bool valid = !diag || crow(i, h) < r; const float e = __builtin_amdgcn_exp2f(fminf(x[i] * LOG2E, 100.0f)); const float k_ = __builtin_amdgcn_rcpf(1.0f + e);
            kp[i] = valid ? k_ : 1.0f; bt[i] = valid ? e * k_ : 0.0f; }
        float E[16], T[4], To[4];
#pragma unroll
        for (int g = 0; g < 4; ++g) { E[4 * g + 3] = 1.0f; E[4 * g + 2] = kp[4 * g + 3]; E[4 * g + 1] = E[4 * g + 2] * kp[4 * g + 2]; E[4 * g] = E[4 * g + 1] * kp[4 * g + 1]; T[g] = E[4 * g] * kp[4 * g]; }
#pragma unroll
        for (int g = 0; g < 4; ++g) To[g] = __shfl_xor(T[g], 32);
        const float U0 = T[0] * To[0], U1 = T[1] * To[1], U2 = T[2] * To[2], U3 = T[3] * To[3];
        float C[4]; C[3] = 1.0f; C[2] = U3; C[1] = U3 * U2; C[0] = C[1] * U1;
        const float tot = C[0] * U0;
        float w[16];
#pragma unroll
        for (int g = 0; g < 4; ++g) { const float off = C[g] * (h == 0 ? To[g] : 1.0f) * Rp;
#pragma unroll
            for (int j = 0; j < 4; ++j) w[4 * g + j] = bt[4 * g + j] * E[4 * g + j] * off; }
        Rp *= tot;
        bf16x8 xs[2];
#pragma unroll
        for (int s = 0; s < 2; ++s) { u32x4 pw; pw.x = pk2(w[8 * s], w[8 * s + 1]); pw.y = pk2(w[8 * s + 2], w[8 * s + 3]); pw.z = pk2(w[8 * s + 4], w[8 * s + 5]); pw.w = pk2(w[8 * s + 6], w[8 * s + 7]); xs[s] = __builtin_bit_cast(bf16x8, pw); }
        if (kb > 0) asm volatile("s_waitcnt vmcnt(8)" ::: "memory"); else asm volatile("s_waitcnt vmcnt(0)" ::: "memory");
#pragma unroll
        for (int db = 0; db < 4; ++db)
#pragma unroll
            for (int s = 0; s < 2; ++s) {
                const s16x4 lo = vtr(trb + (16 * s) * 256 + ((db ^ tq) * 64)), hi = vtr(trb + (16 * s + 8) * 256 + ((db ^ tq) * 64));
                const bf16x8 vf = __builtin_shufflevector(lo, hi, 0, 1, 2, 3, 4, 5, 6, 7);
                o[db] = MFMA32(vf, xs[s], o[db]);
            }
        const bool done = __all(Rp < 1.17549435e-38f);
        asm volatile("s_waitcnt lgkmcnt(0)" ::: "memory");
        __builtin_amdgcn_sched_barrier(0);
        if (kb > 0) AT_ISSUE_V(kb - 1);
        __builtin_amdgcn_sched_barrier(0);
        if (done) break;
    }
    asm volatile("s_waitcnt vmcnt(0)" ::: "memory");
    bf16_t* op = ob + (rowb + q0 + r) * DM + hh * HD + 4 * h;
#pragma unroll
    for (int db = 0; db < 4; ++db)
#pragma unroll
        for (int g = 0; g < 4; ++g) { u32x2 wv; wv.x = pk2(o[db][4 * g], o[db][4 * g + 1]); wv.y = pk2(o[db][4 * g + 2], o[db][4 * g + 3]); *(u32x2*)(op + 32 * db + 8 * g) = wv; }
#undef AT_GLDS
#undef AT_ISSUE_K
#undef AT_ISSUE_V
}

template <bool PASSB>
__device__ __forceinline__ void rnn_wave(const Args& a, int lane, LAS unsigned char* wl, int gw, int ngw) {
    const bf16_t* xc = (const bf16_t*)(a.ws + WS_XC); const bf16_t* gg = (const bf16_t*)(a.ws + WS_GG); bf16_t* ar = (bf16_t*)(a.ws + WS_AR);
    const bf16_t* wra = (const bf16_t*)(a.ws + WS_WRA); const bf16_t* wrx = (const bf16_t*)(a.ws + WS_WRX); float* summ = (float*)(a.ws + WS_SMALL + SM_SUMM);
    const int r = lane & 31, h = lane >> 5;
    constexpr int XP = 352, NUNITS = NBATCH * NRB * 6 * NCHUNK;
    LAS unsigned char* wt_ = wl; LAS unsigned char* wg_ = wl + 12288; LAS unsigned char* wo_ = wl + 14336;
#define RNN_GLDS(src, dst) __builtin_amdgcn_global_load_lds((const unsigned*)(src), (LAS unsigned*)(dst), 16, 0, 0)
#define RNN_VMWAIT() asm volatile("s_waitcnt vmcnt(0)" ::: "memory")
#define RNN_LGWAIT() asm volatile("s_waitcnt lgkmcnt(0)" ::: "memory")
    const int per = (NUNITS + ngw - 1) / ngw, u0 = gw * per, u1 = (u0 + per < NUNITS) ? u0 + per : NUNITS;
    bf16x8 wa[11], wx[11];
    int cur_nct = -1, prev_bc = -2; float bav = 0.f, bxv = 0.f, cl = 0.f; float hc = 0.f;
    for (int u = u0; u < u1; ++u) {
        const int nct = u >> 6, bc = u & 63, b = bc >> 5, c = bc & 31, n = nct / 6, ct = nct - 6 * n;
        const int chl = ct * 32 + r; const bool chv = chl < RB; const int chc = chv ? chl : RB - 1; const int ch = n * RB + chc;
        if (nct != cur_nct) {
            cur_nct = nct;
#pragma unroll
            for (int gsel = 0; gsel < 2; ++gsel) {
                const bf16_t* wsrc = gsel == 0 ? wra : wrx; int ln_ = lane; asm volatile("" : "+v"(ln_));
#pragma unroll
                for (int j = 0; j < 12; ++j) { const int p = ln_ + 64 * j, rr = (p * 2731) >> 16, q = p - rr * 24; const int cr = ct * 32 + rr;
                    RNN_GLDS(wsrc + (size_t)(n * RB + (cr < RB ? cr : RB - 1)) * RBP + q * 8, wt_ + j * 1024); }
                RNN_VMWAIT();
#pragma unroll
                for (int ks = 0; ks < 11; ++ks) { const bf16x8 v = *(const LAS bf16x8*)(wt_ + r * 384 + (16 * ks + 8 * h) * 2); if (gsel == 0) wa[ks] = v; else wx[ks] = v; }
                RNN_LGWAIT();
            }
            bav = a.b_rg_a[ch]; bxv = a.b_rg_x[ch]; const float l = a.lam[ch];
            cl = 8.0f * (fmaxf(-l, 0.f) + log1pf(expf(-fabsf(l))));
            prev_bc = -2;
        }
        const size_t mc0 = (size_t)b * SEQ + c * CHUNK;
        const bf16_t* xrow = xc + mc0 * DR + n * RB;
#define RNN_ISSUE_X(tt_) do { const bf16_t* xn_ = xrow + (size_t)(tt_) * 32 * DR; int ln_ = lane; asm volatile("" : "+v"(ln_));     \
        _Pragma("unroll") for (int j = 0; j < 11; ++j) { const int p = ln_ + 64 * j, rr = (p * 2979) >> 16, q = p - rr * 22; RNN_GLDS(xn_ + rr * DR + q * 8, wt_ + j * 1024); } } while (0)
#define RNN_ISSUE_G(tt_) do { if (PASSB) { int ln_ = lane; asm volatile("" : "+v"(ln_)); _Pragma("unroll") for (int j = 0; j < 2; ++j) { const int p = ln_ + 64 * j; RNN_GLDS(gg + (mc0 + (tt_) * 32 + (p >> 2)) * DR + n * RB + ct * 32 + (p & 3) * 8, wg_ + j * 1024); } } } while (0)
        RNN_ISSUE_X(0); RNN_ISSUE_G(0);
        float Pc = 1.f;
        if (!PASSB) hc = 0.f;
        else if (c == 0) hc = 0.f;
        else if (bc != prev_bc + 1) {
            typedef float f32x2_ __attribute__((ext_vector_type(2)));
            f32x2_ sv[NCHUNK - 1];
#pragma unroll
            for (int cp = 0; cp < NCHUNK - 1; ++cp) sv[cp] = *(const f32x2_*)(summ + ((size_t)(b * NCHUNK + cp) * DR + ch) * 2);
            hc = 0.f;
#pragma unroll
            for (int cp = 0; cp < NCHUNK - 1; ++cp) hc = cp < c ? sv[cp][0] * hc + sv[cp][1] : hc;
        }
        prev_bc = bc;
        const int tokp = lane >> 2, qp = lane & 3;
        const bool stv = ct * 32 + qp * 8 < RB;
        const size_t pbase = (mc0 + tokp) * DR + n * RB + ct * 32 + qp * 8;
        for (int tt = 0; tt < 4; ++tt) {
            if (PASSB && tt > 0) asm volatile("s_waitcnt vmcnt(2)" ::: "memory"); else RNN_VMWAIT();
            f32x16 aa, ax;
#pragma unroll
            for (int i = 0; i < 16; ++i) { aa[i] = 0.f; ax[i] = 0.f; }
#pragma unroll
            for (int ks = 0; ks < 11; ++ks) { const bf16x8 af = *(const LAS bf16x8*)(wt_ + r * XP + (16 * ks + 8 * h) * 2); aa = MFMA32(af, wa[ks], aa); ax = MFMA32(af, wx[ks], ax); }
            unsigned short xvr[16], ggr[16];
#pragma unroll
            for (int i = 0; i < 16; ++i) { xvr[i] = *(const LAS unsigned short*)(wt_ + crow(i, h) * XP + chl * 2); if (PASSB) ggr[i] = *(const LAS unsigned short*)(wg_ + crow(i, h) * 64 + r * 2); }
            RNN_LGWAIT();
            __builtin_amdgcn_sched_barrier(0);
            if (tt < 3) { RNN_ISSUE_X(tt + 1); RNN_ISSUE_G(tt + 1); }
            __builtin_amdgcn_sched_barrier(0);
            float av[16], uv[16];
#pragma unroll
            for (int i = 0; i < 16; ++i) { const float xv = bf2f(xvr[i]);
                const float rg = sigmoidf_(aa[i] + bav), ig = sigmoidf_(ax[i] + bxv); const float la = -cl * rg; const float av_ = __builtin_amdgcn_exp2f(la * LOG2E); av[i] = av_;
                uv[i] = __builtin_amdgcn_sqrtf((1.0f - av_) * (1.0f + av_)) * (ig * xv); }
            float pc[16], hl[16], Pg[4], Hg[4], Pgo[4], Hgo[4];
#pragma unroll
            for (int g = 0; g < 4; ++g) { float P = 1.f, H = 0.f;
#pragma unroll
                for (int j = 0; j < 4; ++j) { H = av[4 * g + j] * H + uv[4 * g + j]; P = P * av[4 * g + j]; pc[4 * g + j] = P; hl[4 * g + j] = H; }
                Pg[g] = P; Hg[g] = H; }
#pragma unroll
            for (int g = 0; g < 4; ++g) { Pgo[g] = __shfl_xor(Pg[g], 32); Hgo[g] = __shfl_xor(Hg[g], 32); }
            float cur = hc, cin[4];
#pragma unroll
            for (int g = 0; g < 4; ++g) { const float P0 = h == 0 ? Pg[g] : Pgo[g], H0 = h == 0 ? Hg[g] : Hgo[g], P1 = h == 0 ? Pgo[g] : Pg[g], H1 = h == 0 ? Hgo[g] : Hg[g];
                const float c0 = cur; cur = P0 * cur + H0; const float c1 = cur; cur = P1 * cur + H1; cin[g] = h == 0 ? c0 : c1; Pc *= P0 * P1; }
            hc = cur;
            if (PASSB) {
#pragma unroll
                for (int i = 0; i < 16; ++i) { const float hv = hl[i] + pc[i] * cin[i >> 2]; const float y = bf2f(ggr[i]) * hv; *(LAS unsigned short*)(wo_ + crow(i, h) * 64 + r * 2) = f2bf_hw(y); }
                const u32x4 o0 = *(const LAS u32x4*)(wo_ + tokp * 64 + qp * 16), o1 = *(const LAS u32x4*)(wo_ + (tokp + 16) * 64 + qp * 16);
                if (stv) { const size_t po = pbase + (size_t)tt * 32 * DR; *(u32x4*)(ar + po) = o0; *(u32x4*)(ar + po + (size_t)16 * DR) = o1; } }
            __builtin_amdgcn_sched_barrier(0);
        }
        if (!PASSB && chv && h == 0) { float* sp = summ + ((size_t)(b * NCHUNK + c) * DR + ch) * 2; sp[0] = Pc; sp[1] = hc; }
#undef RNN_ISSUE_X
#undef RNN_ISSUE_G
    }
#undef RNN_GLDS
#undef RNN_VMWAIT
#undef RNN_LGWAIT
}

namespace cg = cooperative_groups;
__global__ void __launch_bounds__(NTHREADS, 2) fwd(Args a) {
    extern __shared__ __attribute__((aligned(16))) unsigned char lds_raw[];
    LAS unsigned char* lds = (LAS unsigned char*)lds_raw;
    const int tid = threadIdx.x, lane = tid & 63, wave = __builtin_amdgcn_readfirstlane(tid >> 6);
    const int G = gridDim.x, bx = blockIdx.x;
    const int gw = bx * NWAVES + wave, ngw = G * NWAVES, gtid = bx * NTHREADS + tid, ngt = G * NTHREADS;
    unsigned char* ws = a.ws;
    const int lo = a.ph_lo, hi = a.ph_hi, mask = a.mask;
#define IN(k) (lo <= (k) && (k) < hi)
    { volatile LAS unsigned* misc = (volatile LAS unsigned*)(lds + MISC_OFF); if (tid < 16) misc[tid] = 0u; }
    __syncthreads();
#ifndef STAMPK
#define STAMPK -1
#endif
    unsigned long long t_start = 0, t_stamp = 0;
    if (STAMPK >= 0) t_start = __builtin_amdgcn_s_memrealtime();
    XcdBarrier bar = xcd_barrier_post((unsigned*)(ws + WS_SMALL + SM_CTL), (volatile LAS unsigned*)(lds + MISC_OFF));
#if USE_CG_SYNC
#define SEAM(k) do { if (IN(k) && IN((k) + 1)) cg::this_grid().sync(); } while (0)
#else
    bool lmode = false; int xslot = 0, lrank = 0;
    unsigned* bar2 = (unsigned*)(ws + WS_SMALL + SM_CTL) + 8192;
#ifndef LOCAL_SEAMS
#define LOCAL_SEAMS 1
#endif
#define SEAM(k) do { if (IN(k) && IN((k) + 1)) { if (lmode && (k) >= 5 && (k) <= 8) xcd_local_barrier(bar2, bar.x, 32u); else xcd_barrier(bar); } if (STAMPK == (k)) t_stamp = __builtin_amdgcn_s_memrealtime(); } while (0)
#endif
    bf16_t* hb = (bf16_t*)(ws + WS_HB); bf16_t* qn = (bf16_t*)(ws + WS_QN); bf16_t* kn = (bf16_t*)(ws + WS_KN); bf16_t* vv = (bf16_t*)(ws + WS_VV); bf16_t* xr = (bf16_t*)(ws + WS_XR);
    bf16_t* gg = (bf16_t*)(ws + WS_GG); bf16_t* sgr = (bf16_t*)(ws + WS_SGR); bf16_t* sga = (bf16_t*)(ws + WS_SGA); bf16_t* pb = (bf16_t*)(ws + WS_PB);
    bf16_t* ob = (bf16_t*)(ws + WS_OB); bf16_t* mixa = (bf16_t*)(ws + WS_MIXA); bf16_t* Pp = (bf16_t*)(ws + WS_PP); bf16_t* ar = (bf16_t*)(ws + WS_AR); bf16_t* mixb = (bf16_t*)(ws + WS_MIXB);
    bf16_t* x1b = (bf16_t*)(ws + WS_X1B); bf16_t* x2b = (bf16_t*)(ws + WS_X2B); bf16_t* act = (bf16_t*)(ws + WS_ACT);
    float* ssq1 = (float*)(ws + WS_SMALL + SM_SSQ1); float* ssq2 = (float*)(ws + WS_SMALL + SM_SSQ2);

#ifndef NO_P0
    if (IN(0)) { for (int rep = 0; rep < NREP(0); ++rep) if (mask & F_P0) p0_prologue(a, lds, gw, ngw, lane, gtid, ngt); }
#endif
    SEAM(0);
    if (LOCAL_SEAMS && G == 256 && IN(0) && IN(1)) {
        volatile LAS unsigned* misc = (volatile LAS unsigned*)(lds + MISC_OFF);
        if (tid == 0) { unsigned* b0 = (unsigned*)(ws + WS_SMALL + SM_CTL); unsigned npop = 0, ok = 1, slot = 0;
            for (unsigned j = 0; j < 16; ++j) { const unsigned c = xb_ld(&b0[XB_XCNT(j)]); if (c) { ++npop; if (c != 32u) ok = 0; if (j < bar.x) ++slot; } }
            misc[3] = slot; misc[4] = (ok && npop == 8u && misc[2] < 32u) ? 1u : 0u; }
        __syncthreads();
        lrank = __builtin_amdgcn_readfirstlane((int)misc[2]); xslot = __builtin_amdgcn_readfirstlane((int)misc[3]); lmode = __builtin_amdgcn_readfirstlane((int)misc[4]) != 0;
    }
    if (PHON(1) && IN(1) && (mask & F_G1)) for (int rep = 0; rep < NREP(1); ++rep) {
        pg8::Gemm g{hb, (const bf16_t*)(ws + WS_W1), M, DIN, DM}; pg8::StaticOrder S; S.init(M, DIN, G, bx);
        pg8::Epi1 E{xr, gg, qn, kn, vv, sgr, sga, a.q_gain, a.k_gain, (LAS float*)(lds + XCH_OFF), 1.0f / P1_KREP};
        pg8::gemm_phase<pg8::Epi1, pg8::StaticOrder, true, true, P1_KREP, P1_EREP>(lds, g, S, E);
        if (LATE_CONV && LC_WAO_TAIL && G == 256 && bx >= 192) convert_range(a, lds + wave * 16384, lane, CI_W1, CI_P2, (bx - 192) * NWAVES + wave, 64 * NWAVES);
        if (LATE_CONV && LC_P1TAIL && G == 256 && bx >= 192) convert_range(a, lds + wave * 16384, lane, CI_P2, CI_P3 + TAIL_EXTRA, (bx - 192) * NWAVES + wave, 64 * NWAVES);
    }
    SEAM(1);
    if (IN(2)) for (int rep = 0; rep < NREP(2); ++rep) {
        LAS unsigned char* wl = lds + wave * 16384;
#define P2_STREAM() do { if (mask & F_CONV) conv_phase(a, gtid, ngt); if (LATE_CONV && LC_P2) convert_range(a, wl, lane, CI_P2, CI_P3, gw, ngw); } while (0)
#define P2_ATTN() do { if (mask & F_ATTN) { for (int u = gw; u < NBATCH * NH * (SEQ / 32); u += ngw) attn_unit(u >> 11, (u >> 7) & 15, u & 127, qn, kn, vv, ob, wl, lane); } } while (0)
        if (P2_SWAP && wave < 4) { P2_ATTN(); P2_STREAM(); } else { P2_STREAM(); P2_ATTN(); }
#undef P2_STREAM
#undef P2_ATTN
    }
    SEAM(2);
    if (IN(3)) for (int rep = 0; rep < NREP(3); ++rep) {
        if (mask & F_RNN) {
            LAS unsigned char* wl = lds + wave * 16384;
            if (wave >= 4 && LATE_CONV) convert_range(a, wl, lane, (LC_P2 || (LC_P1TAIL && G == 256)) ? CI_P3 + ((LC_P1TAIL && G == 256) ? TAIL_EXTRA : 0) : CI_P2, CI_P4, gw, ngw);
            rnn_wave<false>(a, lane, wl, gw, ngw);
            if (wave < 4 && LATE_CONV) convert_range(a, wl, lane, (LC_P2 || (LC_P1TAIL && G == 256)) ? CI_P3 + ((LC_P1TAIL && G == 256) ? TAIL_EXTRA : 0) : CI_P2, CI_P4, gw, ngw);
        }
        if (PHON(3) && (mask & F_YA)) {
            __syncthreads();
            { pg8::Gemm g{ob, (const bf16_t*)(ws + WS_WAO), M, DM, DM}; pg8::StaticOrder S; S.init(M, DM, G, bx); pg8::EpiMixA E{mixa, sga, DM};
              pg8::gemm_phase<pg8::EpiMixA, pg8::StaticOrder, true, true>(lds, g, S, E); }
        }
    }
    SEAM(3);
    if (IN(4) && (mask & F_RNN)) {
        LAS unsigned char* wl = lds + wave * 16384;
        if (wave >= 4 && LATE_CONV && LC_P4) convert_range(a, wl, lane, CI_P4, CI_END, gw, ngw);
        rnn_wave<true>(a, lane, wl, gw, ngw);
        if (wave < 4 && LATE_CONV && LC_P4) convert_range(a, wl, lane, CI_P4, CI_END, gw, ngw);
    }
    SEAM(4);
    if (PHON(5) && IN(5) && (mask & F_YR)) for (int rep = 0; rep < NREP(5); ++rep) { pg8::Gemm g{ar, (const bf16_t*)(ws + WS_WRO), M, DM, DR}; pg8::Order<0> S; S.init(M, DM, G, bx, lmode, xslot, lrank); pg8::EpiMixB E{mixb, mixa, sgr, DM};
        pg8::gemm_phase<pg8::EpiMixB, pg8::Order<0>, true, true>(lds, g, S, E); }
    SEAM(5);
    if (PHON(6) && IN(6) && (mask & F_WO)) { pg8::Gemm g{mixb, (const bf16_t*)(ws + WS_WO), M, DM, DM}; pg8::Order<0> S; S.init(M, DM, G, bx, lmode, xslot, lrank); pg8::EpiRes<false> E{a.x, x1b, ssq1, DM};
        pg8::gemm_phase<pg8::EpiRes<false>, pg8::Order<0>, true, true>(lds, g, S, E); }
    SEAM(6);
    if (PHON(7) && IN(7) && (mask & F_FFU)) {
        pg8::Gemm g{x1b, (const bf16_t*)(ws + WS_WGU), M, 2 * DFF, DM}; pg8::Order<1> S; S.init(M, 2 * DFF, G, bx, lmode, xslot, lrank); pg8::EpiFfn E{act, ssq1, DFF, 1.0f / P7_KREP};
        pg8::gemm_phase<pg8::EpiFfn, pg8::Order<1>, P7_ALIGN, P7_SP2, P7_KREP, P7_EREP>(lds, g, S, E);
        if (lmode || G != 256 || bx >= 128) { pg8::Gemm g2{pb, (const bf16_t*)(ws + WS_WPP), M, DM, PLE}; pg8::Order<2> S2; if (G == 256) S2.init(M, DM, 128, bx - 128, lmode, xslot, lrank); else S2.init(M, DM, G, bx, false, 0, 0);
            pg8::EpiMixA E2{Pp, nullptr, DM};
            pg8::gemm_phase<pg8::EpiMixA, pg8::Order<2>, true, false>(lds, g2, S2, E2); }
        if (LATE_CONV && !LC_P4 && LC_P7TAIL && G == 256) { const int sidx = lmode ? (lrank >= 16 ? xslot * 16 + (lrank - 16) : -1) : (bx >= 128 ? bx - 128 : -1);
            if (sidx >= 0) convert_range(a, lds + wave * 16384, lane, CI_P4, CI_P4 + CI_WDN + CI_WPG, sidx * NWAVES + wave, 128 * NWAVES); } }
    SEAM(7);
    if (PHON(8) && IN(8) && (mask & F_FFD)) { pg8::Gemm g{act, (const bf16_t*)(ws + WS_WDN), M, DM, DFF}; pg8::Order<0> S; S.init(M, DM, G, bx, lmode, xslot, lrank); pg8::EpiRes<true> E{x1b, x2b, ssq2, DM};
        pg8::gemm_phase<pg8::EpiRes<true>, pg8::Order<0>, true, true>(lds, g, S, E); }
    SEAM(8);
    if (PHON(9) && IN(9) && (mask & F_PLE)) { pg8::Gemm g{x2b, (const bf16_t*)(ws + WS_WPG), M, DM, DM}; pg8::Order<0> S; S.init(M, DM, G, bx, lmode, xslot, lrank); pg8::EpiPle E{x2b, Pp, a.out, ssq2, DM};
        pg8::gemm_phase<pg8::EpiPle, pg8::Order<0>, true, true>(lds, g, S, E); }
    if (STAMPK >= 0 && bx == 0) { const unsigned long long t_end = __builtin_amdgcn_s_memrealtime(), wait = 2ull * (t_stamp - t_start); while (__builtin_amdgcn_s_memrealtime() - t_end < wait) __builtin_amdgcn_s_sleep(16); }
#undef IN
#undef SEAM
}

#ifndef FASTMASK
#define FASTMASK F_ALL
#endif
#ifndef ONE_LAUNCH
#define ONE_LAUNCH 1
#endif
extern "C" void kernel_launch(void* const* d_in, const int* in_sizes, int n_in, void* d_out, int out_size, void* d_ws, size_t ws_size, hipStream_t stream) {
    if (n_in != 22 || out_size != M * DM || ws_size < WS_END) { fprintf(stderr, "kernel_launch: unexpected sizes n_in %d out %d ws %zu\n", n_in, out_size, ws_size); return; }
    const float* x = (const float*)d_in[0]; const float* p = (const float*)d_in[1]; const float* g_mix = (const float*)d_in[2]; const float* w_in = (const float*)d_in[3];
    const float* conv_w = (const float*)d_in[4]; const float* conv_b = (const float*)d_in[5]; const float* w_rg_a = (const float*)d_in[6]; const float* b_rg_a = (const float*)d_in[7];
    const float* w_rg_x = (const float*)d_in[8]; const float* b_rg_x = (const float*)d_in[9]; const float* lam = (const float*)d_in[10]; const float* q_gain = (const float*)d_in[11];
    const float* k_gain = (const float*)d_in[12]; const float* w_rnn_out = (const float*)d_in[13]; const float* w_attn_out = (const float*)d_in[14]; const float* w_o = (const float*)d_in[15];
    const float* g_ffn = (const float*)d_in[16]; const float* w_gu = (const float*)d_in[17]; const float* w_dn = (const float*)d_in[18]; const float* g_ple = (const float*)d_in[19];
    const float* w_pg = (const float*)d_in[20]; const float* w_pp = (const float*)d_in[21];
    float* out = (float*)d_out; unsigned char* ws = (unsigned char*)d_ws;
    static int grid = 0;
    if (grid == 0) {
        int dev = 0, cus = 0, per_cu = 0;
        if (hipGetDevice(&dev) != hipSuccess || hipDeviceGetAttribute(&cus, hipDeviceAttributeMultiprocessorCount, dev) != hipSuccess) { fprintf(stderr, "kernel_launch: device query failed\n"); grid = -1; return; }
        if (hipFuncSetAttribute((const void*)fwd, hipFuncAttributeMaxDynamicSharedMemorySize, LDS_BYTES) != hipSuccess) { fprintf(stderr, "kernel_launch: hipFuncSetAttribute failed\n"); grid = -1; return; }
        if (hipOccupancyMaxActiveBlocksPerMultiprocessor(&per_cu, (const void*)fwd, NTHREADS, LDS_BYTES) != hipSuccess || per_cu < 1) { fprintf(stderr, "kernel_launch: occupancy query says %d blocks per CU\n", per_cu); (void)hipGetLastError(); grid = -1; return; }
        grid = cus;
    }
    if (grid < 0) return;
    Args a{};
    a.x = x; a.p = p; a.g_mix = g_mix; a.w_in = w_in; a.conv_w = conv_w; a.conv_b = conv_b; a.w_rg_a = w_rg_a; a.b_rg_a = b_rg_a; a.w_rg_x = w_rg_x; a.b_rg_x = b_rg_x; a.lam = lam;
    a.q_gain = q_gain; a.k_gain = k_gain; a.w_rnn_out = w_rnn_out; a.w_attn_out = w_attn_out; a.w_o = w_o; a.g_ffn = g_ffn; a.w_gu = w_gu; a.w_dn = w_dn; a.g_ple = g_ple; a.w_pg = w_pg; a.w_pp = w_pp;
    a.out = out; a.ws = ws;
    if (hipMemsetAsync(ws + WS_SMALL + SM_CTL, 0, CTL_BYTES, stream) != hipSuccess) { fprintf(stderr, "kernel_launch: memset failed\n"); return; }
    a.ph_lo = 0; a.ph_hi = 10; a.mask = F_ALL;
    void* kargs[] = {&a};
    hipError_t e = hipLaunchCooperativeKernel((const void*)fwd, dim3(grid), dim3(NTHREADS), kargs, LDS_BYTES, stream);
    if (e != hipSuccess) fprintf(stderr, "kernel_launch: launch failed: %s (grid %d)\n", hipGetErrorString(e), grid);
}
```

```cpp
#include <hip/hip_runtime.h>
#include <hip/hip_cooperative_groups.h>
#include <cstdio>
#include <cstdint>

typedef unsigned short bf16_t;
typedef float f32x4 __attribute__((ext_vector_type(4)));
typedef unsigned u32x4 __attribute__((ext_vector_type(4)));
typedef unsigned u32x2 __attribute__((ext_vector_type(2)));
typedef short bf16x8 __attribute__((ext_vector_type(8)));
typedef short s16x4 __attribute__((ext_vector_type(4)));
typedef float f32x16 __attribute__((ext_vector_type(16)));
#define LAS __attribute__((address_space(3)))

constexpr int SEQ = 4096, NBATCH = 2, M = NBATCH * SEQ, DM = 2048, DR = 2816, DIN = 15872, DFF = 5632, PLE = 256, NH = 16, HD = 128;
constexpr int NRB = 16, RB = 176, RBP = 192, NCHUNK = 32, CHUNK = 128;
constexpr float EPS = 1e-6f;
constexpr float LOG2E = 1.4426950408889634f, LN2 = 0.6931471805599453f;

constexpr size_t MiB = (size_t)1 << 20;
constexpr size_t WS_WRO = 0, WS_WAO = 11 * MiB, WS_WO = 19 * MiB, WS_WGU = 27 * MiB, WS_WDN = 71 * MiB, WS_WPG = 93 * MiB, WS_WPP = 101 * MiB, WS_WRA = 102 * MiB, WS_WRX = 102 * MiB + 1536 * 1024;
constexpr size_t WS_W1 = 106 * MiB, WS_HB = 168 * MiB, WS_QN = 200 * MiB, WS_KN = 232 * MiB, WS_VV = 264 * MiB, WS_XR = 296 * MiB, WS_GG = 340 * MiB, WS_SGR = 384 * MiB, WS_SGA = 416 * MiB, WS_SMALL = 460 * MiB, WS_PB = 464 * MiB, WS_END = 468 * MiB;
constexpr size_t WS_XC = WS_W1, WS_OB = WS_HB, WS_MIXA = WS_QN, WS_PP = WS_VV, WS_AR = WS_SGA, WS_MIXB = WS_W1, WS_X1B = WS_GG, WS_X2B = WS_GG, WS_ACT = WS_W1;
constexpr size_t SM_SSQ1 = 0, SM_SSQ2 = 32768, SM_SUMM = 65536;

__device__ __forceinline__ float bf2f(bf16_t b) { return __uint_as_float((unsigned)b << 16); }
__device__ __forceinline__ bf16_t f2bf(float f) { unsigned u = __float_as_uint(f); return (bf16_t)((u + 0x7fffu + ((u >> 16) & 1u)) >> 16); }
__device__ __forceinline__ float rbf(float f) { return bf2f(f2bf(f)); }
__device__ __forceinline__ float sigmoidf_(float x) { return __builtin_amdgcn_rcpf(1.0f + __builtin_amdgcn_exp2f(-x * LOG2E)); }
__device__ __forceinline__ float gelu_tanh(float x) { const float y = 0.7978845608028654f * (x + 0.044715f * x * x * x); return x * __builtin_amdgcn_rcpf(1.0f + __builtin_amdgcn_exp2f(-2.0f * LOG2E * y)); }
__device__ __forceinline__ float softplusf_(float z) { return fmaxf(z, 0.f) + LN2 * __builtin_amdgcn_logf(1.0f + __builtin_amdgcn_exp2f(-fabsf(z) * LOG2E)); }
__device__ __forceinline__ float wave_sum(float v) {
#pragma unroll
    for (int o = 1; o < 64; o <<= 1) v += __shfl_xor(v, o);
    return v;
}

#define ONE_LAUNCH 1
#define FASTMASK 2047
namespace pg8 {
#define PG8_LAS __attribute__((address_space(3)))
typedef unsigned short bf16_t;
typedef short bf16x8 __attribute__((ext_vector_type(8)));
typedef float f32x4 __attribute__((ext_vector_type(4)));
typedef unsigned u32x4 __attribute__((ext_vector_type(4)));
constexpr int BM = 256, BK = 64, HALF = 128, HTB = HALF * BK * 2  , STAGE_BYTES = 8 * HTB, NXCD = 8, WGM = 8;

__host__ __device__ __forceinline__ int lds_byte(int r, int c) { const int st = (r >> 4) * 2 + (c >> 5), rr = r & 15, cc = c & 31, ob = rr * 64 + cc * 2; return st * 1024 + (ob ^ (((ob >> 9) & 1) << 5)); }
__host__ __device__ __forceinline__ void stage_rc(int b, int& R, int& C) { const int st = b / 1024, sb = b % 1024, swz = sb ^ (((sb >> 9) & 1) << 5); R = (st >> 1) * 16 + swz / 64; C = (st & 1) * 32 + (swz % 64) / 2; }
__host__ __device__ __forceinline__ int perm32(int rho) { const int n = rho >> 4, i = rho & 15; return 8 * (i >> 2) + 4 * n + (i & 3); }

struct Unit { int pm, pn; };
struct Gemm { const bf16_t* A; const bf16_t* Bt; int M, N, K; };

struct StaticOrder {
    int nM, nN, nwg, G, c;
    __host__ __device__ void init(int M, int N, int G_, int c_) { nM = M / BM; nN = N / BM; nwg = nM * nN; G = G_; c = c_; }
    __host__ __device__ bool next(int i, Unit& u) const {
        const long L = (long)i * G + c; if (L >= nwg) return false;
        int wgid = (int)L; { const int q = nwg / NXCD, r = nwg % NXCD, xcd = wgid % NXCD, off = wgid / NXCD; wgid = (xcd < r ? xcd * (q + 1) : r * (q + 1) + (xcd - r) * q) + off; }
        const int nig = WGM * nN, gid = wgid / nig, fm = gid * WGM, gsz = (nM - fm) < WGM ? (nM - fm) : WGM;
        u.pm = fm + ((wgid % nig) % gsz); u.pn = (wgid % nig) / gsz; return true;
    }
    __device__ __forceinline__ void a_ready(const Unit&) const {}
    __device__ __forceinline__ void done(const Unit&) const {}
};
template <int kind> struct Order {
    StaticOrder so;
    __device__ __forceinline__ void init(int M, int N, int G, int c, bool local, int xs, int rk) { so.init(M, N, G, c); if (local) { so.nwg = -1; so.G = xs; so.c = rk; } }
    __device__ __forceinline__ bool next(int i, Unit& u) const {
        if (so.nwg >= 0) return so.next(i, u);
        const int xs = so.G, rk = so.c;
        if (kind == 0) { if (i > 0) return false; u.pm = 4 * xs + (rk >> 3); u.pn = rk & 7; return true; }
        if (kind == 1) { const int j = i * 32 + rk; if (j >= 176) return false; u.pm = 4 * xs + (j & 3); u.pn = j >> 2; return true; }
        if (kind == 3) { const int j = i * 32 + rk; if (j >= 248) return false; u.pm = 4 * xs + (j & 3); u.pn = j >> 2; return true; }
        if (i >= 2 || rk < 16) return false;
        const int j = (rk - 16) * 2 + i; u.pm = 4 * xs + (j >> 3); u.pn = j & 7; return true;
    }
    __device__ __forceinline__ void a_ready(const Unit&) const {}
    __device__ __forceinline__ void done(const Unit&) const {}
};

__device__ __forceinline__ unsigned cvt_pk_bf16(float lo, float hi) { unsigned r; asm volatile("v_cvt_pk_bf16_f32 %0, %1, %2" : "=v"(r) : "v"(lo), "v"(hi)); return r; }
__device__ __forceinline__ float bflo(unsigned w) { return __uint_as_float(w << 16); }
__device__ __forceinline__ float bfhi(unsigned w) { return __uint_as_float(w & 0xffff0000u); }
__device__ __forceinline__ float sig_(float x) { return __builtin_amdgcn_rcpf(1.0f + __builtin_amdgcn_exp2f(-x * 1.4426950408889634f)); }
__device__ __forceinline__ float gelu_t(float x) { const float y = 0.7978845608028654f * (x + 0.044715f * x * x * x); return x * __builtin_amdgcn_rcpf(1.0f + __builtin_amdgcn_exp2f(-2.0f * 1.4426950408889634f * y)); }
__device__ __forceinline__ u32x4 pack8(const f32x4& v0, const f32x4& v1) { u32x4 w; w.x = cvt_pk_bf16(v0[0], v0[1]); w.y = cvt_pk_bf16(v0[2], v0[3]); w.z = cvt_pk_bf16(v1[0], v1[1]); w.w = cvt_pk_bf16(v1[2], v1[3]); return w; }

#ifndef EPI_NT
#define EPI_NT 0
#endif
#if EPI_NT
#define EPI_ST16(p, v) st_nt16((p), (v))
#else
#define EPI_ST16(p, v) (*(u32x4*)(p) = (v))
#endif
__device__ __forceinline__ void st_nt16(void* p, const u32x4& v) { __builtin_nontemporal_store(v, (u32x4*)p); }
struct Epi1 {
    static constexpr bool PERM = true, AFTER_DRAIN = false;
    bf16_t *xr, *gg, *qn, *kn, *vv, *sgr, *sga; const float *qgain, *kgain; PG8_LAS float* xch; float kscale;
    __device__ __forceinline__ void operator()(const f32x4 (&acc)[2][2][4][2], const Unit& u, int wr, int wc, int fr, int fq) const {
        const int pn = u.pn;
        int kind, ld, colt; bf16_t* base;
        if (pn < 11) { kind = 0; base = xr; ld = 2816; colt = pn * 256; }
        else if (pn < 22) { kind = 1; base = gg; ld = 2816; colt = (pn - 11) * 256; }
        else if (pn < 30) { kind = 2; base = qn; ld = 2048; colt = (pn - 22) * 256; }
        else if (pn < 38) { kind = 3; base = kn; ld = 2048; colt = (pn - 30) * 256; }
        else if (pn < 46) { kind = 0; base = vv; ld = 2048; colt = (pn - 38) * 256; }
        else if (pn < 54) { kind = 4; base = sgr; ld = 2048; colt = (pn - 46) * 256; }
        else { kind = 4; base = sga; ld = 2048; colt = (pn - 54) * 256; }
        float rst[2][4][2]; f32x4 gv[2];
#pragma unroll
        for (int ai = 0; ai < 2; ++ai)
#pragma unroll
            for (int m = 0; m < 4; ++m) { rst[ai][m][0] = 1.f; rst[ai][m][1] = 1.f; }
        gv[0] = (f32x4){1.f, 1.f, 1.f, 1.f}; gv[1] = gv[0];
        if (kind == 2 || kind == 3) {
#pragma unroll
            for (int ai = 0; ai < 2; ++ai)
#pragma unroll
                for (int m = 0; m < 4; ++m)
#pragma unroll
                    for (int bj = 0; bj < 2; ++bj) { const f32x4 a = acc[ai][bj][m][0] * kscale, b = acc[ai][bj][m][1] * kscale;
                        float s = (a[0] * a[0] + a[1] * a[1]) + (a[2] * a[2] + a[3] * a[3]) + (b[0] * b[0] + b[1] * b[1]) + (b[2] * b[2] + b[3] * b[3]);
                        s += __shfl_xor(s, 16); s += __shfl_xor(s, 32);
                        if (fq == 0) xch[((ai * HALF + wr * 64 + m * 16 + fr) * 2 + bj) * 4 + wc] = s; }
            asm volatile("s_waitcnt lgkmcnt(0)" ::: "memory"); __builtin_amdgcn_s_barrier(); asm volatile("" ::: "memory");
            const float extra = kind == 2 ? 0.08838834764831845f : 1.0f;
#pragma unroll
            for (int ai = 0; ai < 2; ++ai)
#pragma unroll
                for (int m = 0; m < 4; ++m)
#pragma unroll
                    for (int bj = 0; bj < 2; ++bj) { const f32x4 t = *(const PG8_LAS f32x4*)&xch[((ai * HALF + wr * 64 + m * 16 + fr) * 2 + bj) * 4];
                        rst[ai][m][bj] = extra * __builtin_amdgcn_rsqf(((t[0] + t[1]) + (t[2] + t[3])) * (1.0f / 128.0f) + 1e-6f); }
            const float* gp = (kind == 2 ? qgain : kgain) + wc * 32 + 8 * fq; gv[0] = *(const f32x4*)gp; gv[1] = *(const f32x4*)(gp + 4);
        }
        bf16_t* rowp = base + (size_t)(u.pm * BM + wr * 64 + fr) * ld + colt + wc * 32 + 8 * fq;
        const size_t step16 = (size_t)16 * ld;
#define EPI1_LOOP(BODY) _Pragma("unroll") for (int ai = 0; ai < 2; ++ai) { _Pragma("unroll") for (int m = 0; m < 4; ++m) { _Pragma("unroll") for (int bj = 0; bj < 2; ++bj) { \
            f32x4 v0 = acc[ai][bj][m][0] * kscale, v1 = acc[ai][bj][m][1] * kscale; BODY; EPI_ST16(rowp + bj * HALF, pack8(v0, v1)); } \
            rowp += step16; __builtin_amdgcn_sched_barrier(0); } rowp += step16 * 4; }
        if (kind == 0) { EPI1_LOOP((void)0) }
        else if (kind == 1) { EPI1_LOOP(_Pragma("unroll") for (int j = 0; j < 4; ++j) { v0[j] = gelu_t(v0[j]); v1[j] = gelu_t(v1[j]); }) }
        else if (kind == 4) { EPI1_LOOP(_Pragma("unroll") for (int j = 0; j < 4; ++j) { v0[j] = sig_(v0[j]); v1[j] = sig_(v1[j]); }) }
        else { EPI1_LOOP(v0 = v0 * rst[ai][m][bj] * gv[0]; v1 = v1 * rst[ai][m][bj] * gv[1]) }
#undef EPI1_LOOP
    }
};
__device__ __forceinline__ void unpack8(const u32x4& g, f32x4& a, f32x4& b) { a = (f32x4){bflo(g.x), bfhi(g.x), bflo(g.y), bfhi(g.y)}; b = (f32x4){bflo(g.z), bfhi(g.z), bflo(g.w), bfhi(g.w)}; }
struct EpiMixA {
    static constexpr bool PERM = true, AFTER_DRAIN = false;
    bf16_t* O; const bf16_t* G; int ld;
    __device__ __forceinline__ void operator()(const f32x4 (&acc)[2][2][4][2], const Unit& u, int wr, int wc, int fr, int fq) const {
        const int row0 = u.pm * BM + wr * 64 + fr, col0 = u.pn * BM + wc * 32 + 8 * fq;
        u32x4 g[2][4][2];
        if (G) {
#pragma unroll
            for (int ai = 0; ai < 2; ++ai)
#pragma unroll
                for (int m = 0; m < 4; ++m)
#pragma unroll
                    for (int bj = 0; bj < 2; ++bj) g[ai][m][bj] = *(const u32x4*)(G + (size_t)(row0 + ai * HALF + m * 16) * ld + col0 + bj * HALF);
            asm volatile("" ::: "memory");
        }
#pragma unroll
        for (int ai = 0; ai < 2; ++ai)
#pragma unroll
            for (int m = 0; m < 4; ++m)
#pragma unroll
                for (int bj = 0; bj < 2; ++bj) { f32x4 v0 = acc[ai][bj][m][0], v1 = acc[ai][bj][m][1];
                    if (G) { f32x4 g0, g1; unpack8(g[ai][m][bj], g0, g1); v0 = v0 * g0; v1 = v1 * g1; }
                    *(u32x4*)(O + (size_t)(row0 + ai * HALF + m * 16) * ld + col0 + bj * HALF) = pack8(v0, v1); }
    }
};
struct EpiMixB {
    static constexpr bool PERM = true, AFTER_DRAIN = false;
    bf16_t* O; const bf16_t* F; const bf16_t* G; int ld;
    __device__ __forceinline__ void operator()(const f32x4 (&acc)[2][2][4][2], const Unit& u, int wr, int wc, int fr, int fq) const {
        const int row0 = u.pm * BM + wr * 64 + fr, col0 = u.pn * BM + wc * 32 + 8 * fq;
#pragma unroll
        for (int ai = 0; ai < 2; ++ai) {
            u32x4 f[4][2], g[4][2];
#pragma unroll
            for (int m = 0; m < 4; ++m)
#pragma unroll
                for (int bj = 0; bj < 2; ++bj) { const size_t o = (size_t)(row0 + ai * HALF + m * 16) * ld + col0 + bj * HALF; f[m][bj] = *(const u32x4*)(F + o); g[m][bj] = *(const u32x4*)(G + o); }
            asm volatile("" ::: "memory");
#pragma unroll
            for (int m = 0; m < 4; ++m)
#pragma unroll
                for (int bj = 0; bj < 2; ++bj) { const size_t o = (size_t)(row0 + ai * HALF + m * 16) * ld + col0 + bj * HALF; f32x4 f0, f1, g0, g1; unpack8(f[m][bj], f0, f1); unpack8(g[m][bj], g0, g1);
                    *(u32x4*)(O + o) = pack8(f0 + acc[ai][bj][m][0] * g0, f1 + acc[ai][bj][m][1] * g1); }
            asm volatile("" ::: "memory"); }
    }
};
template <bool XBF> struct EpiRes {
    static constexpr bool PERM = true, AFTER_DRAIN = false;
    const void* X; bf16_t* O; float* ssq; int ld;
    __device__ __forceinline__ void operator()(const f32x4 (&acc)[2][2][4][2], const Unit& u, int wr, int wc, int fr, int fq) const {
        const int row0 = u.pm * BM + wr * 64 + fr, col0 = u.pn * BM + wc * 32 + 8 * fq;
#pragma unroll
        for (int ai = 0; ai < 2; ++ai) {
            f32x4 xv[4][2][2];
#pragma unroll
            for (int m = 0; m < 4; ++m)
#pragma unroll
                for (int bj = 0; bj < 2; ++bj) { const size_t o = (size_t)(row0 + ai * HALF + m * 16) * ld + col0 + bj * HALF;
                    if (XBF) { const u32x4 t = *(const u32x4*)((const bf16_t*)X + o); unpack8(t, xv[m][bj][0], xv[m][bj][1]); }
                    else { xv[m][bj][0] = *(const f32x4*)((const float*)X + o); xv[m][bj][1] = *(const f32x4*)((const float*)X + o + 4); } }
            asm volatile("" ::: "memory");
#pragma unroll
            for (int m = 0; m < 4; ++m) { const int row = row0 + ai * HALF + m * 16; float s = 0.f;
#pragma unroll
                for (int bj = 0; bj < 2; ++bj) { const f32x4 v0 = xv[m][bj][0] + acc[ai][bj][m][0], v1 = xv[m][bj][1] + acc[ai][bj][m][1];
                    *(u32x4*)(O + (size_t)row * ld + col0 + bj * HALF) = pack8(v0, v1);
                    s += (v0[0] * v0[0] + v0[1] * v0[1]) + (v0[2] * v0[2] + v0[3] * v0[3]) + (v1[0] * v1[0] + v1[1] * v1[1]) + (v1[2] * v1[2] + v1[3] * v1[3]); }
                s += __shfl_xor(s, 16); s += __shfl_xor(s, 32);
                if (fq == 0) unsafeAtomicAdd(ssq + row, s); }
            asm volatile("" ::: "memory"); }
    }
};
struct EpiFfn {
    static constexpr bool PERM = true, AFTER_DRAIN = false;
    bf16_t* O; const float* ssq; int ldo; float kscale;
    __device__ __forceinline__ void operator()(const f32x4 (&acc)[2][2][4][2], const Unit& u, int wr, int wc, int fr, int fq) const {
        const int row0 = u.pm * BM + wr * 64 + fr, col0 = u.pn * HALF + wc * 32 + 8 * fq;
        float sq[2][4];
#pragma unroll
        for (int ai = 0; ai < 2; ++ai)
#pragma unroll
            for (int m = 0; m < 4; ++m) sq[ai][m] = ssq[row0 + ai * HALF + m * 16];
        asm volatile("" ::: "memory");
#pragma unroll
        for (int ai = 0; ai < 2; ++ai)
#pragma unroll
            for (int m = 0; m < 4; ++m) { const int row = row0 + ai * HALF + m * 16; const float rs = kscale * __builtin_amdgcn_rsqf(sq[ai][m] * (1.0f / 2048.0f) + 1e-6f);
                f32x4 v[2];
#pragma unroll
                for (int n = 0; n < 2; ++n)
#pragma unroll
                    for (int j = 0; j < 4; ++j) { const float g = rs * acc[ai][0][m][n][j], uu = rs * acc[ai][1][m][n][j]; v[n][j] = g * sig_(g) * uu; }
                EPI_ST16(O + (size_t)row * ldo + col0, pack8(v[0], v[1])); }
    }
};
struct EpiPle {
    static constexpr bool PERM = true, AFTER_DRAIN = false;
    const bf16_t* X; const bf16_t* P; float* out; const float* ssq; int ld;
    __device__ __forceinline__ void operator()(const f32x4 (&acc)[2][2][4][2], const Unit& u, int wr, int wc, int fr, int fq) const {
        const int row0 = u.pm * BM + wr * 64 + fr, col0 = u.pn * BM + wc * 32 + 8 * fq;
        float sq[2][4];
#pragma unroll
        for (int ai = 0; ai < 2; ++ai)
#pragma unroll
            for (int m = 0; m < 4; ++m) sq[ai][m] = ssq[row0 + ai * HALF + m * 16];
#pragma unroll
        for (int ai = 0; ai < 2; ++ai) {
            u32x4 xv[4][2], pv[4][2];
#pragma unroll
            for (int m = 0; m < 4; ++m)
#pragma unroll
                for (int bj = 0; bj < 2; ++bj) { const size_t o = (size_t)(row0 + ai * HALF + m * 16) * ld + col0 + bj * HALF; xv[m][bj] = *(const u32x4*)(X + o); pv[m][bj] = *(const u32x4*)(P + o); }
            asm volatile("" ::: "memory");
#pragma unroll
            for (int m = 0; m < 4; ++m) { const float rs = __builtin_amdgcn_rsqf(sq[ai][m] * (1.0f / 2048.0f) + 1e-6f);
#pragma unroll
                for (int bj = 0; bj < 2; ++bj) { const size_t o = (size_t)(row0 + ai * HALF + m * 16) * ld + col0 + bj * HALF; f32x4 x0, x1, p0, p1, r0, r1; unpack8(xv[m][bj], x0, x1); unpack8(pv[m][bj], p0, p1);
#pragma unroll
                    for (int j = 0; j < 4; ++j) { r0[j] = x0[j] + sig_(rs * acc[ai][bj][m][0][j]) * p0[j]; r1[j] = x1[j] + sig_(rs * acc[ai][bj][m][1][j]) * p1[j]; }
                    *(f32x4*)(out + o) = r0; *(f32x4*)(out + o + 4) = r1; } }
            asm volatile("" ::: "memory"); }
    }
};
template <class Epi, class Sched, bool ALIGN_EPI = false, bool SP2 = false, int KREP = 1, int EREP = 1>
__device__ __forceinline__ void gemm_phase(PG8_LAS unsigned char* lds, const Gemm g, const Sched& S, const Epi& E) {
    const int tid = threadIdx.x, wid = __builtin_amdgcn_readfirstlane(tid >> 6), lane = tid & 63, wr = wid >> 2, wc = wid & 3, fr = lane & 15, fq = lane >> 4;
    const int K = g.K, nt = K / BK;
    unsigned voffA[2], voffB[2];
#pragma unroll
    for (int i = 0; i < 2; ++i) { int R, C; stage_rc(tid * 16 + i * 8192, R, C); const int Rb = Epi::PERM ? ((R & ~31) + perm32(R & 31)) : R;
        voffA[i] = (unsigned)(R * K + C) * 2u; voffB[i] = (unsigned)(Rb * K + C) * 2u; }
    const size_t kstep = (size_t)(BK * 2);
    const size_t hstep = (size_t)HALF * K * 2;
    const size_t tstep = 2 * hstep;
    const unsigned ldsw = (unsigned)wid * 1024u;
    const int aoff = lds_byte(wr * 64 + fr, fq * 8), boff = lds_byte(wc * 32 + fr, fq * 8);
#define PG8_SA(b, h) (((b) * 2 + (h)) * HTB)
#define PG8_SB(b, h) ((4 + (b) * 2 + (h)) * HTB)
#define PG8_STAGE(bufoff, gbase, voff) do { _Pragma("unroll") for (int _i = 0; _i < 2; ++_i) \
        __builtin_amdgcn_global_load_lds((const unsigned*)((const char*)(gbase) + (voff)[_i]), (PG8_LAS unsigned*)(lds + (bufoff) + ldsw + _i * 8192), 16, 0, 0); } while (0)
#define PG8_LDA(dst, b, h) do { _Pragma("unroll") for (int m = 0; m < 4; ++m) _Pragma("unroll") for (int k = 0; k < 2; ++k) dst[m][k] = *(const PG8_LAS bf16x8*)(lds + PG8_SA(b, h) + aoff + m * 2048 + k * 1024); } while (0)
#define PG8_LDB(dst, b, h) do { _Pragma("unroll") for (int n = 0; n < 2; ++n) _Pragma("unroll") for (int k = 0; k < 2; ++k) dst[n][k] = *(const PG8_LAS bf16x8*)(lds + PG8_SB(b, h) + boff + n * 2048 + k * 1024); } while (0)
#define PG8_MMA(ai, bj, At, Bt) do { __builtin_amdgcn_s_setprio(1); _Pragma("unroll") for (int m = 0; m < 4; ++m) _Pragma("unroll") for (int n = 0; n < 2; ++n) _Pragma("unroll") for (int k = 0; k < 2; ++k) \
        acc[ai][bj][m][n] = __builtin_amdgcn_mfma_f32_16x16x32_bf16(Bt[n][k], At[m][k], acc[ai][bj][m][n], 0, 0, 0); __builtin_amdgcn_s_setprio(0); } while (0)
#define PG8_WAIT_V(n) asm volatile("s_waitcnt vmcnt(" #n ")" ::: "memory")
#define PG8_WAIT_L(n) asm volatile("s_waitcnt lgkmcnt(" #n ")" ::: "memory")
#define PG8_BAR __builtin_amdgcn_s_barrier()
#define PG8_SCHED __builtin_amdgcn_sched_barrier(0)
    Unit cur, nxt; int ui = 0;
    if (!S.next(0, cur)) return;
    f32x4 acc[2][2][4][2];
#pragma unroll
    for (int a = 0; a < 2; ++a)
#pragma unroll
        for (int b = 0; b < 2; ++b)
#pragma unroll
            for (int m = 0; m < 4; ++m)
#pragma unroll
                for (int n = 0; n < 2; ++n) acc[a][b][m][n] = (f32x4){0.f, 0.f, 0.f, 0.f};
    bf16x8 At[4][2], B0[2][2], B1[2][2];
    const char* cA = (const char*)g.A + (size_t)cur.pm * tstep; const char* cB = (const char*)g.Bt + (size_t)cur.pn * tstep;
    S.a_ready(cur);
    if constexpr (SP2) {
        PG8_STAGE(PG8_SB(0, 0), cB, voffB); PG8_STAGE(PG8_SB(0, 1), cB + hstep, voffB); PG8_STAGE(PG8_SA(0, 0), cA, voffA); PG8_STAGE(PG8_SA(0, 1), cA + hstep, voffA);
        if (wr == 1) PG8_BAR;
        PG8_WAIT_V(2); PG8_BAR;
        PG8_STAGE(PG8_SB(1, 0), cB + kstep, voffB); PG8_STAGE(PG8_SA(1, 0), cA + kstep, voffA); PG8_STAGE(PG8_SB(1, 1), cB + hstep + kstep, voffB);
        PG8_WAIT_V(6); PG8_BAR;
    } else {
        PG8_STAGE(PG8_SB(0, 0), cB, voffB); PG8_STAGE(PG8_SA(0, 0), cA, voffA); PG8_STAGE(PG8_SB(0, 1), cB + hstep, voffB); PG8_STAGE(PG8_SA(0, 1), cA + hstep, voffA);
        if (wr == 1) PG8_BAR;
        PG8_WAIT_V(4); PG8_BAR;
        PG8_STAGE(PG8_SB(1, 0), cB + kstep, voffB); PG8_STAGE(PG8_SA(1, 0), cA + kstep, voffA); PG8_STAGE(PG8_SB(1, 1), cB + hstep + kstep, voffB);
        PG8_WAIT_V(6); PG8_BAR;
    }
    for (;;) {
        const bool has_next = S.next(ui + 1, nxt);
        const char* nA = has_next ? (const char*)g.A + (size_t)nxt.pm * tstep : cA; const char* nB = has_next ? (const char*)g.Bt + (size_t)nxt.pn * tstep : cB;
        for (int pass = 0; pass < KREP; ++pass)
        for (int t = 0; t < nt; t += 2) {
            const bool lastpass = (pass == KREP - 1);
            const bool last = (t == nt - 2);
            const char* a1 = cA + (size_t)(t + 1) * kstep;
            const char* a2 = last ? (lastpass ? nA : cA) : cA + (size_t)(t + 2) * kstep; const char* b2 = last ? (lastpass ? nB : cB) : cB + (size_t)(t + 2) * kstep;
            const char* a3 = a2 + kstep; const char* b3 = b2 + kstep;
            if (last && has_next && lastpass) S.a_ready(nxt);
            if constexpr (SP2) {
            PG8_LDB(B0, 0, 0); PG8_LDB(B1, 0, 1); PG8_SCHED; PG8_LDA(At, 0, 0); PG8_STAGE(PG8_SA(1, 1), a1 + hstep, voffA);
            PG8_WAIT_V(8); PG8_WAIT_L(0); PG8_BAR; PG8_MMA(0, 0, At, B0); PG8_MMA(0, 1, At, B1); PG8_BAR; PG8_SCHED;
            PG8_LDA(At, 0, 1); PG8_STAGE(PG8_SB(0, 0), b2, voffB); PG8_STAGE(PG8_SB(0, 1), b2 + hstep, voffB); PG8_STAGE(PG8_SA(0, 0), a2, voffA);
            PG8_WAIT_V(8); PG8_WAIT_L(0); PG8_BAR; PG8_MMA(1, 0, At, B0); PG8_MMA(1, 1, At, B1); PG8_BAR; PG8_SCHED;
            PG8_LDB(B0, 1, 0); PG8_LDB(B1, 1, 1); PG8_SCHED; PG8_LDA(At, 1, 0); PG8_STAGE(PG8_SA(0, 1), a2 + hstep, voffA);
            PG8_WAIT_V(8); PG8_WAIT_L(0); PG8_BAR; PG8_MMA(0, 0, At, B0); PG8_MMA(0, 1, At, B1); PG8_BAR; PG8_SCHED;
            PG8_LDA(At, 1, 1); PG8_STAGE(PG8_SB(1, 0), b3, voffB); PG8_STAGE(PG8_SB(1, 1), b3 + hstep, voffB); PG8_STAGE(PG8_SA(1, 0), a3, voffA);
            PG8_WAIT_V(8); PG8_WAIT_L(0); PG8_BAR; PG8_MMA(1, 0, At, B0); PG8_MMA(1, 1, At, B1); PG8_BAR; PG8_SCHED;
            } else {
            PG8_LDB(B0, 0, 0); PG8_SCHED; PG8_LDA(At, 0, 0); PG8_STAGE(PG8_SA(1, 1), a1 + hstep, voffA);
            PG8_WAIT_L(8); PG8_BAR; PG8_WAIT_L(0); PG8_MMA(0, 0, At, B0); PG8_BAR; PG8_SCHED;
            PG8_LDB(B1, 0, 1); PG8_STAGE(PG8_SB(0, 0), b2, voffB);
            PG8_BAR; PG8_WAIT_L(0); PG8_MMA(0, 1, At, B1); PG8_BAR;
            PG8_LDA(At, 0, 1); PG8_STAGE(PG8_SA(0, 0), a2, voffA);
            PG8_BAR; PG8_WAIT_L(0); PG8_MMA(1, 0, At, B0); PG8_BAR; PG8_SCHED;
            PG8_STAGE(PG8_SB(0, 1), b2 + hstep, voffB);
            PG8_WAIT_V(6); PG8_BAR; PG8_MMA(1, 1, At, B1); PG8_BAR;
            PG8_LDB(B0, 1, 0); PG8_SCHED; PG8_LDA(At, 1, 0); PG8_STAGE(PG8_SA(0, 1), a2 + hstep, voffA);
            PG8_WAIT_L(8); PG8_BAR; PG8_WAIT_L(0); PG8_MMA(0, 0, At, B0); PG8_BAR; PG8_SCHED;
            PG8_LDB(B1, 1, 1); PG8_STAGE(PG8_SB(1, 0), b3, voffB);
            PG8_BAR; PG8_WAIT_L(0); PG8_MMA(0, 1, At, B1); PG8_BAR;
            PG8_LDA(At, 1, 1); PG8_STAGE(PG8_SA(1, 0), a3, voffA);
            PG8_BAR; PG8_WAIT_L(0); PG8_MMA(1, 0, At, B0); PG8_BAR; PG8_SCHED;
            PG8_STAGE(PG8_SB(1, 1), b3 + hstep, voffB);
            PG8_WAIT_V(6); PG8_BAR; PG8_MMA(1, 1, At, B1); PG8_BAR;
            }
        }
        if constexpr (ALIGN_EPI) { if (wr == 0) PG8_BAR; }
        if constexpr (!Epi::AFTER_DRAIN) { for (int er = 0; er < EREP; ++er) E(acc, cur, wr, wc, fr, fq); S.done(cur); }
        if (!has_next) break;
#pragma unroll
        for (int a = 0; a < 2; ++a)
#pragma unroll
            for (int b = 0; b < 2; ++b)
#pragma unroll
                for (int m = 0; m < 4; ++m)
#pragma unroll
                    for (int n = 0; n < 2; ++n) acc[a][b][m][n] = (f32x4){0.f, 0.f, 0.f, 0.f};
        cur = nxt; cA = nA; cB = nB; ++ui;
        if constexpr (ALIGN_EPI) { if (wr == 1) PG8_BAR; }
    }
    PG8_WAIT_V(0);
    if constexpr (!ALIGN_EPI) { if (wr == 0) PG8_BAR; }
    PG8_BAR;
    if constexpr (Epi::AFTER_DRAIN) { E.fused(acc, cur, wr, wc, fr, fq, lds, wid, lane); S.done(cur); }
#undef PG8_SA
#undef PG8_SB
#undef PG8_STAGE
#undef PG8_LDA
#undef PG8_LDB
#undef PG8_MMA
#undef PG8_WAIT_V
#undef PG8_WAIT_L
#undef PG8_BAR
#undef PG8_SCHED
}
}

#define GAS __attribute__((address_space(1)))
#define RLX_AGENT __ATOMIC_RELAXED, __HIP_MEMORY_SCOPE_AGENT
#define XB_TMO      128
#define XB_XCNT(j)  (256  + 64 * (j))
#define XB_XSUB(j)  (1280 + 64 * (j))
#define XB_XGEN(j)  (2304 + 64 * (j))
#define XB_TOP      3328
#define XB_TOPGEN   3392
#define XCD_BAR_WORDS 3456
#define XB_SPIN_CAP (1u << 18)

__device__ __forceinline__ unsigned xb_ld(unsigned* p)              { return __hip_atomic_load(p, __ATOMIC_RELAXED, __HIP_MEMORY_SCOPE_AGENT); }
__device__ __forceinline__ unsigned xb_add(unsigned* p, unsigned v) { return __hip_atomic_fetch_add(p, v, __ATOMIC_RELAXED, __HIP_MEMORY_SCOPE_AGENT); }
__device__ __forceinline__ unsigned xb_xcc_id() { return (unsigned)__builtin_amdgcn_s_getreg((3 << 11) | 20) & 0xFu; }
#define XB_SPIN(cond, bar) do { unsigned _sp = 0; while (cond) { __builtin_amdgcn_s_sleep(1); \
    if ((++_sp & 255u) == 0u) { if (xb_ld(&(bar)[XB_TMO])) break; if (_sp > XB_SPIN_CAP) { atomicAdd(&(bar)[XB_TMO], 1u); break; } } } } while (0)

struct XcdBarrier {
    unsigned* bar; unsigned x;
    volatile LAS unsigned* st;
};

__device__ __forceinline__ XcdBarrier xcd_barrier_post(unsigned* bar, volatile LAS unsigned* st) {
    XcdBarrier b; b.bar = bar; b.x = xb_xcc_id(); b.st = st;
    if (threadIdx.x == 0) st[2] = xb_add(&bar[XB_XCNT(b.x)], 1u);
    return b;
}
__device__ __forceinline__ void xcd_barrier_complete(unsigned* bar, unsigned x, unsigned& nloc, unsigned& nx) {
    const unsigned G = gridDim.x * gridDim.y * gridDim.z;
    unsigned sum, cnt, mine, sp = 0u;
    for (;;) {
        sum = 0u; cnt = 0u; mine = 0u;
#pragma unroll
        for (unsigned j = 0; j < 16; ++j) { const unsigned c = xb_ld(&bar[XB_XCNT(j)]); sum += c; cnt += (c > 0u) ? 1u : 0u; mine = (j == x) ? c : mine; }
        if (sum == G) break;
        __builtin_amdgcn_s_sleep(1);
        if ((++sp & 255u) == 0u) { if (xb_ld(&bar[XB_TMO])) break; if (sp > XB_SPIN_CAP) { atomicAdd(&bar[XB_TMO], 1u); break; } }
    }
    nloc = mine > 0u ? mine : 1u; nx = cnt > 0u ? cnt : 1u;
}

__device__ __forceinline__ void xcd_barrier(const XcdBarrier& b) {
    asm volatile("s_waitcnt vmcnt(0)" ::: "memory");
    __syncthreads();
    if (threadIdx.x == 0) {
        unsigned* bar = b.bar;
        __builtin_amdgcn_s_waitcnt(0);
        unsigned nloc = b.st[0], nx = b.st[1];
        if (nloc == 0u) { xcd_barrier_complete(bar, b.x, nloc, nx); b.st[0] = nloc; b.st[1] = nx; }
        const unsigned old = xb_add(&bar[XB_XSUB(b.x)], 1u);
        const unsigned gen = old / nloc;
        if (old + 1u == (gen + 1u) * nloc) {
            __builtin_amdgcn_fence(__ATOMIC_RELEASE, "agent");
            asm volatile("s_waitcnt vmcnt(0)" ::: "memory");
            const unsigned og = xb_add(&bar[XB_TOP], 1u);
            const unsigned tg = og / nx;
            if (og + 1u == (tg + 1u) * nx) xb_add(&bar[XB_TOPGEN], 1u);
            else XB_SPIN(xb_ld(&bar[XB_TOPGEN]) == tg, bar);
            __builtin_amdgcn_fence(__ATOMIC_ACQUIRE, "agent");
            xb_add(&bar[XB_XGEN(b.x)], 1u);
            asm volatile("s_waitcnt vmcnt(0)" ::: "memory");
        } else {
            XB_SPIN(xb_ld(&bar[XB_XGEN(b.x)]) == gen, bar);
            __builtin_amdgcn_fence(__ATOMIC_ACQUIRE, "agent");
            asm volatile("s_waitcnt vmcnt(0)" ::: "memory");
        }
    }
    __syncthreads();
}


__device__ __forceinline__ void xcd_local_barrier(unsigned* bar2, unsigned x, unsigned nloc) {
    asm volatile("s_waitcnt vmcnt(0)" ::: "memory");
    __syncthreads();
    if (threadIdx.x == 0) {
        __builtin_amdgcn_s_waitcnt(0);
        const unsigned old = xb_add(&bar2[XB_XSUB(x)], 1u);
        const unsigned gen = old / nloc;
        if (old + 1u == (gen + 1u) * nloc) xb_add(&bar2[XB_XGEN(x)], 1u);
        else XB_SPIN(xb_ld(&bar2[XB_XGEN(x)]) == gen, bar2);
        __builtin_amdgcn_fence(__ATOMIC_ACQUIRE, "agent");
        asm volatile("s_waitcnt vmcnt(0)" ::: "memory");
    }
    __syncthreads();
}

#ifndef ONLYP
#define ONLYP -1
#endif
constexpr int ONLY = ONLYP;
#define PHON(k) (ONLY < 0 || ONLY == (k))
#ifndef P7_ALIGN
#define P7_ALIGN true
#endif
#ifndef P7_SP2
#define P7_SP2 true
#endif
#ifndef P7_KREP
#define P7_KREP 1
#endif
#ifndef P7_EREP
#define P7_EREP 1
#endif
#ifndef P1_LOCAL
#define P1_LOCAL 1
#endif
#ifndef P1_KREP
#define P1_KREP 1
#endif
#ifndef P1_EREP
#define P1_EREP 1
#endif
#ifndef USE_CG_SYNC
#define USE_CG_SYNC 0
#endif
#ifndef LATE_CONV
#define LATE_CONV 1
#endif
#ifndef LC_P2
#define LC_P2 0
#endif
#ifndef LC_P4
#define LC_P4 0
#endif
#ifndef LC_WAO_TAIL
#define LC_WAO_TAIL 1
#endif
#ifndef LC_P7TAIL
#define LC_P7TAIL 1
#endif
#ifndef LC_P1TAIL
#define LC_P1TAIL 1
#endif
#ifndef TAIL_EXTRA
#define TAIL_EXTRA 0
#endif
#ifndef P2_SWAP
#define P2_SWAP 1
#endif
#ifndef DUPMASK
#define DUPMASK 0
#endif
#define NREP(k) (((DUPMASK >> (k)) & 1) + 1)
constexpr size_t SM_DUMMY = 2 * MiB;
constexpr int NWAVES = 8, NTHREADS = NWAVES * 64;
constexpr int RING_BYTES = 131072, XCH_OFF = RING_BYTES, XCH_BYTES = 8192, MISC_OFF = XCH_OFF + XCH_BYTES, LDS_BYTES = 147456;
static_assert(MISC_OFF + 64 <= LDS_BYTES, "LDS map");
constexpr size_t SM_CTL = 3 * MiB, CTL_BYTES = 65536;
constexpr int VST_PITCH = 320, VST_BYTES = 32 * VST_PITCH;
static_assert(NWAVES * VST_BYTES <= RING_BYTES, "attention scratch");

enum { F_P0 = 1, F_G1 = 2, F_CONV = 4, F_ATTN = 8, F_RNN = 16, F_YA = 32, F_YR = 64, F_WO = 128, F_FFU = 256, F_FFD = 512, F_PLE = 1024, F_ALL = 2047 };

struct Args {
    const float *x, *p, *g_mix, *w_in, *conv_w, *conv_b, *w_rg_a, *b_rg_a, *w_rg_x, *b_rg_x, *lam, *q_gain, *k_gain, *w_rnn_out, *w_attn_out, *w_o, *g_ffn, *w_gu, *w_dn, *g_ple, *w_pg, *w_pp;
    float* out; unsigned char* ws; int ph_lo, ph_hi, mask, pad;
};

__device__ __forceinline__ int crow(int reg, int h) { return (reg & 3) + 8 * (reg >> 2) + 4 * h; }
#define MFMA32(a, b, c) __builtin_amdgcn_mfma_f32_32x32x16_bf16((a), (b), (c), 0, 0, 0)
__device__ __forceinline__ unsigned pk2(float lo, float hi) { unsigned r; asm("v_cvt_pk_bf16_f32 %0, %1, %2" : "=v"(r) : "v"(lo), "v"(hi)); return r; }
__device__ __forceinline__ unsigned short f2bf_hw(float f) { return (unsigned short)pk2(f, f); }

constexpr int CI_W1 = (DM / 64) * (DIN / 64), CI_WAO = (DM / 64) * (DM / 64), CI_WRO = (DR / 64) * (DM / 64), CI_WO = CI_WAO, CI_WGU = (DM / 64) * (2 * DFF / 64), CI_WDN = (DFF / 64) * (DM / 64), CI_WPG = CI_WAO, CI_WPP = (PLE / 64) * (DM / 64);
constexpr int CI_P0 = 0, CI_P2 = CI_P0 + CI_W1 + CI_WAO, CI_P3 = CI_P2 + CI_WRO + CI_WO, CI_P4 = CI_P3 + CI_WGU, CI_END = CI_P4 + CI_WDN + CI_WPG + CI_WPP;
struct CvtItem { const float* wp; const float* ks; bf16_t* out; int ldw, Kdim; };
__device__ __forceinline__ CvtItem cvt_decode(const Args& a, int it, int lane) {
    unsigned char* ws = a.ws; int r = it; const float* W; const float* ks = nullptr; bf16_t* WT; int ldw, Kdim, nb; bool gu = false;
    if (r < CI_W1) { W = a.w_in; ldw = DIN; Kdim = DM; WT = (bf16_t*)(ws + WS_W1); nb = DIN / 64; }
    else if ((r -= CI_W1) < CI_WAO) { W = a.w_attn_out; ldw = DM; Kdim = DM; WT = (bf16_t*)(ws + WS_WAO); nb = DM / 64; }
    else if ((r -= CI_WAO) < CI_WRO) { W = a.w_rnn_out; ldw = DM; Kdim = DR; WT = (bf16_t*)(ws + WS_WRO); nb = DM / 64; }
    else if ((r -= CI_WRO) < CI_WO) { W = a.w_o; ldw = DM; Kdim = DM; WT = (bf16_t*)(ws + WS_WO); nb = DM / 64; }
    else if ((r -= CI_WO) < CI_WGU) { W = a.w_gu; ldw = 2 * DFF; Kdim = DM; WT = (bf16_t*)(ws + WS_WGU); nb = 2 * DFF / 64; ks = a.g_ffn; gu = true; }
    else if ((r -= CI_WGU) < CI_WDN) { W = a.w_dn; ldw = DM; Kdim = DFF; WT = (bf16_t*)(ws + WS_WDN); nb = DM / 64; }
    else if ((r -= CI_WDN) < CI_WPG) { W = a.w_pg; ldw = DM; Kdim = DM; WT = (bf16_t*)(ws + WS_WPG); nb = DM / 64; ks = a.g_ple; }
    else { r -= CI_WPG; W = a.w_pp; ldw = DM; Kdim = PLE; WT = (bf16_t*)(ws + WS_WPP); nb = DM / 64; }
    const int k0 = 64 * (r / nb), n0 = 64 * (r % nb);
    int orow = n0;
    if (gu) { const int isu = n0 >= DFF ? 1 : 0; const int j0 = n0 - isu * DFF; orow = (j0 >> 7) * 256 + isu * 128 + (j0 & 127); }
    CvtItem d; d.wp = W + (size_t)k0 * ldw + n0 + lane; d.ks = ks ? ks + k0 : nullptr; d.out = WT + (size_t)orow * Kdim + k0; d.ldw = ldw; d.Kdim = Kdim; return d;
}
__device__ __forceinline__ void cvt_load(const CvtItem& d, float (&v)[64]) {
#pragma unroll
    for (int i = 0; i < 64; ++i) v[i] = __builtin_nontemporal_load(d.wp + (size_t)i * d.ldw);
}
__device__ __forceinline__ void cvt_finish(const CvtItem& d, float (&v)[64], LAS unsigned* scr, int lane) {
    if (d.ks) {
#pragma unroll
        for (int i = 0; i < 64; ++i) v[i] *= d.ks[i]; }
#pragma unroll
    for (int i = 0; i < 32; ++i) scr[i * 65 + lane] = pk2(v[2 * i], v[2 * i + 1]);
    asm volatile("s_waitcnt lgkmcnt(0)" ::: "memory");
    const int c = lane & 7;
#pragma unroll
    for (int j = 0; j < 8; ++j) { const int nn = (lane >> 3) + 8 * j; const LAS unsigned* s = scr + (4 * c) * 65 + nn;
        u32x4 o; o.x = s[0]; o.y = s[65]; o.z = s[130]; o.w = s[195];
        *(u32x4*)(d.out + (size_t)nn * d.Kdim + 8 * c) = o; }
    asm volatile("s_waitcnt lgkmcnt(0)" ::: "memory");
}
__device__ __forceinline__ void convert_range(const Args& a, LAS unsigned char* wl, int lane, int lo, int hi, int gw, int ngw) {
    LAS unsigned* scr = (LAS unsigned*)wl;
    int it = lo + gw; if (it >= hi) return;
    float va[64], vb[64];
    CvtItem da = cvt_decode(a, it, lane), db = da; cvt_load(da, va);
    for (;;) {
        it += ngw; const bool hb_ = it < hi; if (hb_) { db = cvt_decode(a, it, lane); cvt_load(db, vb); }
        cvt_finish(da, va, scr, lane); if (!hb_) break;
        it += ngw; const bool ha_ = it < hi; if (ha_) { da = cvt_decode(a, it, lane); cvt_load(da, va); }
        cvt_finish(db, vb, scr, lane); if (!ha_) break;
    }
}
__device__ __forceinline__ void p0_prologue(const Args& a, LAS unsigned char* lds, int gw, int ngw, int lane, int gtid, int ngt) {
    unsigned char* ws = a.ws;
    { const f32x4* pp = (const f32x4*)a.p; u32x2* po = (u32x2*)(ws + WS_PB);
      for (int i = gtid; i < M * PLE / 4; i += ngt) { const f32x4 v = __builtin_nontemporal_load(pp + i); u32x2 w; w.x = pk2(v[0], v[1]); w.y = pk2(v[2], v[3]); po[i] = w; } }
    { bf16_t* wra = (bf16_t*)(ws + WS_WRA); bf16_t* wrx = (bf16_t*)(ws + WS_WRX);
      for (int i = gtid; i < NRB * RB * RBP; i += ngt) { const int c = i % RBP, d = (i / RBP) % RB, n = i / (RBP * RB);
          const size_t src = ((size_t)n * RB + (c < RB ? c : 0)) * RB + d;
          wra[i] = c < RB ? f2bf_hw(a.w_rg_a[src]) : (bf16_t)0; wrx[i] = c < RB ? f2bf_hw(a.w_rg_x[src]) : (bf16_t)0; } }
    { float* z = (float*)(ws + WS_SMALL); for (int i = gtid; i < 2 * M; i += ngt) z[i] = 0.f; }
    if (LATE_CONV && !LC_P4) convert_range(a, lds + (threadIdx.x >> 6) * 16384, lane, (LC_P7TAIL && gridDim.x == 256) ? CI_P4 + CI_WDN + CI_WPG : CI_P4, CI_END, gw, ngw);
    convert_range(a, lds + (threadIdx.x >> 6) * 16384, lane, CI_P0, LATE_CONV ? ((LC_WAO_TAIL && gridDim.x == 256) ? CI_W1 : CI_P2) : CI_END, gw, ngw);
    bf16_t* hb = (bf16_t*)(ws + WS_HB);
    for (int m = gw; m < M; m += ngw) {
        const f32x4* xr = (const f32x4*)(a.x + (size_t)m * DM) + lane; const f32x4* gr = (const f32x4*)a.g_mix + lane;
        f32x4 v[8]; float s = 0.f;
#pragma unroll
        for (int j = 0; j < 8; ++j) { v[j] = __builtin_nontemporal_load(xr + 64 * j); s += (v[j][0] * v[j][0] + v[j][1] * v[j][1]) + (v[j][2] * v[j][2] + v[j][3] * v[j][3]); }
        const float rs = 1.0f / sqrtf(wave_sum(s) * (1.0f / DM) + EPS);
        u32x2* o8 = (u32x2*)(hb + (size_t)m * DM) + lane;
#pragma unroll
        for (int j = 0; j < 8; ++j) { const f32x4 g = gr[64 * j]; u32x2 w; w.x = pk2(v[j][0] * rs * g[0], v[j][1] * rs * g[1]); w.y = pk2(v[j][2] * rs * g[2], v[j][3] * rs * g[3]); o8[64 * j] = w; }
    }
}

__device__ __forceinline__ void conv_phase(const Args& a, int gtid, int ngt) {
    const bf16_t* xr = (const bf16_t*)(a.ws + WS_XR); bf16_t* xc = (bf16_t*)(a.ws + WS_XC);
    constexpr int NCG = DR / 8;
    for (int it = gtid; it < (M / 8) * NCG; it += ngt) {
        const int cg = it % NCG, rg = it / NCG, c0 = cg * 8, m0 = rg * 8;
        f32x4 w[4][2]; f32x4 bb[2];
#pragma unroll
        for (int j = 0; j < 4; ++j) { w[j][0] = *(const f32x4*)(a.conv_w + (size_t)j * DR + c0); w[j][1] = *(const f32x4*)(a.conv_w + (size_t)j * DR + c0 + 4); }
        bb[0] = *(const f32x4*)(a.conv_b + c0); bb[1] = *(const f32x4*)(a.conv_b + c0 + 4);
        f32x4 win[3][2];
        const bool first = (m0 & (SEQ - 1)) == 0;
#pragma unroll
        for (int j = 0; j < 3; ++j) {
            if (first) { win[j][0] = (f32x4){0.f, 0.f, 0.f, 0.f}; win[j][1] = win[j][0]; }
            else { const u32x4 t = *(const u32x4*)(xr + (size_t)(m0 - 3 + j) * DR + c0); win[j][0] = (f32x4){pg8::bflo(t.x), pg8::bfhi(t.x), pg8::bflo(t.y), pg8::bfhi(t.y)}; win[j][1] = (f32x4){pg8::bflo(t.z), pg8::bfhi(t.z), pg8::bflo(t.w), pg8::bfhi(t.w)}; } }
#pragma unroll
        for (int i = 0; i < 8; ++i) {
            const u32x4 t = *(const u32x4*)(xr + (size_t)(m0 + i) * DR + c0);
            const f32x4 c0v = (f32x4){pg8::bflo(t.x), pg8::bfhi(t.x), pg8::bflo(t.y), pg8::bfhi(t.y)}, c1v = (f32x4){pg8::bflo(t.z), pg8::bfhi(t.z), pg8::bflo(t.w), pg8::bfhi(t.w)};
            const f32x4 y0 = bb[0] + w[0][0] * win[0][0] + w[1][0] * win[1][0] + w[2][0] * win[2][0] + w[3][0] * c0v;
            const f32x4 y1 = bb[1] + w[0][1] * win[0][1] + w[1][1] * win[1][1] + w[2][1] * win[2][1] + w[3][1] * c1v;
            *(u32x4*)(xc + (size_t)(m0 + i) * DR + c0) = pg8::pack8(y0, y1);
            win[0][0] = win[1][0]; win[0][1] = win[1][1]; win[1][0] = win[2][0]; win[1][1] = win[2][1]; win[2][0] = c0v; win[2][1] = c1v;
        }
    }
}

typedef short v4i16_t __attribute__((ext_vector_type(4)));
__device__ __forceinline__ s16x4 vtr(const LAS unsigned char* p) { return __builtin_bit_cast(s16x4, __builtin_amdgcn_ds_read_tr16_b64_v4i16((LAS v4i16_t*)p)); }
__device__ __forceinline__ void attn_unit(int b, int hh, int qb, const bf16_t* __restrict__ qn, const bf16_t* __restrict__ kn, const bf16_t* __restrict__ vv, bf16_t* __restrict__ ob, LAS unsigned char* wl, int lane) {
    LAS unsigned char* wk_ = wl; LAS unsigned char* wv_ = wl + 8192;
    const int r = lane & 31, h = lane >> 5;
    const size_t rowb = (size_t)b * SEQ;
    const int q0 = qb * 32;
#define AT_GLDS(src, dst) __builtin_amdgcn_global_load_lds((const unsigned*)(src), (LAS unsigned*)(dst), 16, 0, 0)
#define AT_ISSUE_K(kb_) do { int ln_ = lane; asm volatile("" : "+v"(ln_)); const bf16_t* kp_ = kn + (rowb + (size_t)(kb_) * 32) * DM + hh * HD; \
        _Pragma("unroll") for (int j = 0; j < 8; ++j) { const int row = (ln_ >> 4) + 4 * j; AT_GLDS(kp_ + (size_t)row * DM + (((ln_ & 15) ^ (row & 15)) * 8), wk_ + j * 1024); } } while (0)
#define AT_ISSUE_V(kb_) do { int ln_ = lane; asm volatile("" : "+v"(ln_)); const bf16_t* vp_ = vv + (rowb + (size_t)(kb_) * 32) * DM + hh * HD + (((ln_ & 15) ^ (4 * ((ln_ >> 4) & 3))) * 8); \
        _Pragma("unroll") for (int j = 0; j < 8; ++j) AT_GLDS(vp_ + (size_t)((ln_ >> 4) + 4 * j) * DM, wv_ + j * 1024); } while (0)
    bf16x8 qf[8];
    { const bf16_t* qp = qn + (rowb + q0 + r) * DM + hh * HD + 8 * h;
#pragma unroll
      for (int ks = 0; ks < 8; ++ks) qf[ks] = *(const bf16x8*)(qp + 16 * ks); }
    AT_ISSUE_K(qb); AT_ISSUE_V(qb);
    f32x16 o[4];
#pragma unroll
    for (int d = 0; d < 4; ++d)
#pragma unroll
        for (int i = 0; i < 16; ++i) o[d][i] = 0.f;
    float Rp = 1.0f;
    const int i16 = lane & 15, tq = i16 >> 2, tp = i16 & 3, blk = (lane >> 4) & 1;
    const LAS unsigned char* trb = wv_ + (4 * h + tq) * 256 + 32 * blk + 8 * tp;
    const LAS unsigned char* krb = wk_ + r * 256;
    for (int kb = qb; kb >= 0; --kb) {
        if (kb > 0) asm volatile("s_waitcnt vmcnt(8)" ::: "memory"); else asm volatile("s_waitcnt vmcnt(0)" ::: "memory");
        bf16x8 kf[8];
#pragma unroll
        for (int ks = 0; ks < 8; ++ks) kf[ks] = *(const LAS bf16x8*)(krb + (((2 * ks + h) ^ (r & 15)) * 16));
        asm volatile("s_waitcnt lgkmcnt(0)" ::: "memory");
        __builtin_amdgcn_sched_barrier(0);
        if (kb > 0) AT_ISSUE_K(kb - 1);
        __builtin_amdgcn_sched_barrier(0);
        f32x16 x;
#pragma unroll
        for (int i = 0; i < 16; ++i) x[i] = 0.f;
#pragma unroll
        for (int ks = 0; ks < 8; ++ks) x = MFMA32(kf[ks], qf[ks], x);
        const bool diag = (kb == qb);
        float kp[16], bt[16];
#pragma unroll
        for (int i = 0; i < 16; ++i) { const bool valid = !diag || crow(i, h) < r; const float e = __builtin_amdgcn_exp2f(fminf(x[i] * LOG2E, 100.0f)); const float k_ = __builtin_amdgcn_rcpf(1.0f + e);
            kp[i] = valid ? k_ : 1.0f; bt[i] = valid ? e * k_ : 0.0f; }
        float E[16], T[4], To[4];
#pragma unroll
        for (int g = 0; g < 4; ++g) { E[4 * g + 3] = 1.0f; E[4 * g + 2] = kp[4 * g + 3]; E[4 * g + 1] = E[4 * g + 2] * kp[4 * g + 2]; E[4 * g] = E[4 * g + 1] * kp[4 * g + 1]; T[g] = E[4 * g] * kp[4 * g]; }
#pragma unroll
        for (int g = 0; g < 4; ++g) To[g] = __shfl_xor(T[g], 32);
        const float U0 = T[0] * To[0], U1 = T[1] * To[1], U2 = T[2] * To[2], U3 = T[3] * To[3];
        float C[4]; C[3] = 1.0f; C[2] = U3; C[1] = U3 * U2; C[0] = C[1] * U1;
        const float tot = C[0] * U0;
        float w[16];
#pragma unroll
        for (int g = 0; g < 4; ++g) { const float off = C[g] * (h == 0 ? To[g] : 1.0f) * Rp;
#pragma unroll
            for (int j = 0; j < 4; ++j) w[4 * g + j] = bt[4 * g + j] * E[4 * g + j] * off; }
        Rp *= tot;
        bf16x8 xs[2];
#pragma unroll
        for (int s = 0; s < 2; ++s) { u32x4 pw; pw.x = pk2(w[8 * s], w[8 * s + 1]); pw.y = pk2(w[8 * s + 2], w[8 * s + 3]); pw.z = pk2(w[8 * s + 4], w[8 * s + 5]); pw.w = pk2(w[8 * s + 6], w[8 * s + 7]); xs[s] = __builtin_bit_cast(bf16x8, pw); }
        if (kb > 0) asm volatile("s_waitcnt vmcnt(8)" ::: "memory"); else asm volatile("s_waitcnt vmcnt(0)" ::: "memory");
#pragma unroll
        for (int db = 0; db < 4; ++db)
#pragma unroll
            for (int s = 0; s < 2; ++s) {
                const s16x4 lo = vtr(trb + (16 * s) * 256 + ((db ^ tq) * 64)), hi = vtr(trb + (16 * s + 8) * 256 + ((db ^ tq) * 64));
                const bf16x8 vf = __builtin_shufflevector(lo, hi, 0, 1, 2, 3, 4, 5, 6, 7);
                o[db] = MFMA32(vf, xs[s], o[db]);
            }
        const bool done = __all(Rp < 1.17549435e-38f);
        asm volatile("s_waitcnt lgkmcnt(0)" ::: "memory");
        __builtin_amdgcn_sched_barrier(0);
        if (kb > 0) AT_ISSUE_V(kb - 1);
        __builtin_amdgcn_sched_barrier(0);
        if (done) break;
    }
    asm volatile("s_waitcnt vmcnt(0)" ::: "memory");
    bf16_t* op = ob + (rowb + q0 + r) * DM + hh * HD + 4 * h;
#pragma unroll
    for (int db = 0; db < 4; ++db)
#pragma unroll
        for (int g = 0; g < 4; ++g) { u32x2 wv; wv.x = pk2(o[db][4 * g], o[db][4 * g + 1]); wv.y = pk2(o[db][4 * g + 2], o[db][4 * g + 3]); *(u32x2*)(op + 32 * db + 8 * g) = wv; }
#undef AT_GLDS
#undef AT_ISSUE_K
#undef AT_ISSUE_V
}

template <bool PASSB>
__device__ __forceinline__ void rnn_wave(const Args& a, int lane, LAS unsigned char* wl, int gw, int ngw) {
    const bf16_t* xc = (const bf16_t*)(a.ws + WS_XC); const bf16_t* gg = (const bf16_t*)(a.ws + WS_GG); bf16_t* ar = (bf16_t*)(a.ws + WS_AR);
    const bf16_t* wra = (const bf16_t*)(a.ws + WS_WRA); const bf16_t* wrx = (const bf16_t*)(a.ws + WS_WRX); float* summ = (float*)(a.ws + WS_SMALL + SM_SUMM);
    const int r = lane & 31, h = lane >> 5;
    constexpr int XP = 352, NUNITS = NBATCH * NRB * 6 * NCHUNK;
    LAS unsigned char* wt_ = wl; LAS unsigned char* wg_ = wl + 12288; LAS unsigned char* wo_ = wl + 14336;
#define RNN_GLDS(src, dst) __builtin_amdgcn_global_load_lds((const unsigned*)(src), (LAS unsigned*)(dst), 16, 0, 0)
#define RNN_VMWAIT() asm volatile("s_waitcnt vmcnt(0)" ::: "memory")
#define RNN_LGWAIT() asm volatile("s_waitcnt lgkmcnt(0)" ::: "memory")
    const int per = (NUNITS + ngw - 1) / ngw, u0 = gw * per, u1 = (u0 + per < NUNITS) ? u0 + per : NUNITS;
    bf16x8 wa[11], wx[11];
    int cur_nct = -1, prev_bc = -2; float bav = 0.f, bxv = 0.f, cl = 0.f; float hc = 0.f;
    for (int u = u0; u < u1; ++u) {
        const int nct = u >> 6, bc = u & 63, b = bc >> 5, c = bc & 31, n = nct / 6, ct = nct - 6 * n;
        const int chl = ct * 32 + r; const bool chv = chl < RB; const int chc = chv ? chl : RB - 1; const int ch = n * RB + chc;
        if (nct != cur_nct) {
            cur_nct = nct;
#pragma unroll
            for (int gsel = 0; gsel < 2; ++gsel) {
                const bf16_t* wsrc = gsel == 0 ? wra : wrx; int ln_ = lane; asm volatile("" : "+v"(ln_));
#pragma unroll
                for (int j = 0; j < 12; ++j) { const int p = ln_ + 64 * j, rr = (p * 2731) >> 16, q = p - rr * 24; const int cr = ct * 32 + rr;
                    RNN_GLDS(wsrc + (size_t)(n * RB + (cr < RB ? cr : RB - 1)) * RBP + q * 8, wt_ + j * 1024); }
                RNN_VMWAIT();
#pragma unroll
                for (int ks = 0; ks < 11; ++ks) { const bf16x8 v = *(const LAS bf16x8*)(wt_ + r * 384 + (16 * ks + 8 * h) * 2); if (gsel == 0) wa[ks] = v; else wx[ks] = v; }
                RNN_LGWAIT();
            }
            bav = a.b_rg_a[ch]; bxv = a.b_rg_x[ch]; const float l = a.lam[ch];
            cl = 8.0f * (fmaxf(-l, 0.f) + log1pf(expf(-fabsf(l))));
            prev_bc = -2;
        }
        const size_t mc0 = (size_t)b * SEQ + c * CHUNK;
        const bf16_t* xrow = xc + mc0 * DR + n * RB;
#define RNN_ISSUE_X(tt_) do { const bf16_t* xn_ = xrow + (size_t)(tt_) * 32 * DR; int ln_ = lane; asm volatile("" : "+v"(ln_));     \
        _Pragma("unroll") for (int j = 0; j < 11; ++j) { const int p = ln_ + 64 * j, rr = (p * 2979) >> 16, q = p - rr * 22; RNN_GLDS(xn_ + rr * DR + q * 8, wt_ + j * 1024); } } while (0)
#define RNN_ISSUE_G(tt_) do { if (PASSB) { int ln_ = lane; asm volatile("" : "+v"(ln_)); _Pragma("unroll") for (int j = 0; j < 2; ++j) { const int p = ln_ + 64 * j; RNN_GLDS(gg + (mc0 + (tt_) * 32 + (p >> 2)) * DR + n * RB + ct * 32 + (p & 3) * 8, wg_ + j * 1024); } } } while (0)
        RNN_ISSUE_X(0); RNN_ISSUE_G(0);
        float Pc = 1.f;
        if (!PASSB) hc = 0.f;
        else if (c == 0) hc = 0.f;
        else if (bc != prev_bc + 1) {
            typedef float f32x2_ __attribute__((ext_vector_type(2)));
            f32x2_ sv[NCHUNK - 1];
#pragma unroll
            for (int cp = 0; cp < NCHUNK - 1; ++cp) sv[cp] = *(const f32x2_*)(summ + ((size_t)(b * NCHUNK + cp) * DR + ch) * 2);
            hc = 0.f;
#pragma unroll
            for (int cp = 0; cp < NCHUNK - 1; ++cp) hc = cp < c ? sv[cp][0] * hc + sv[cp][1] : hc;
        }
        prev_bc = bc;
        const int tokp = lane >> 2, qp = lane & 3;
        const bool stv = ct * 32 + qp * 8 < RB;
        const size_t pbase = (mc0 + tokp) * DR + n * RB + ct * 32 + qp * 8;
        for (int tt = 0; tt < 4; ++tt) {
            if (PASSB && tt > 0) asm volatile("s_waitcnt vmcnt(2)" ::: "memory"); else RNN_VMWAIT();
            f32x16 aa, ax;
#pragma unroll
            for (int i = 0; i < 16; ++i) { aa[i] = 0.f; ax[i] = 0.f; }
#pragma unroll
            for (int ks = 0; ks < 11; ++ks) { const bf16x8 af = *(const LAS bf16x8*)(wt_ + r * XP + (16 * ks + 8 * h) * 2); aa = MFMA32(af, wa[ks], aa); ax = MFMA32(af, wx[ks], ax); }
            unsigned short xvr[16], ggr[16];
#pragma unroll
            for (int i = 0; i < 16; ++i) { xvr[i] = *(const LAS unsigned short*)(wt_ + crow(i, h) * XP + chl * 2); if (PASSB) ggr[i] = *(const LAS unsigned short*)(wg_ + crow(i, h) * 64 + r * 2); }
            RNN_LGWAIT();
            __builtin_amdgcn_sched_barrier(0);
            if (tt < 3) { RNN_ISSUE_X(tt + 1); RNN_ISSUE_G(tt + 1); }
            __builtin_amdgcn_sched_barrier(0);
            float av[16], uv[16];
#pragma unroll
            for (int i = 0; i < 16; ++i) { const float xv = bf2f(xvr[i]);
                const float rg = sigmoidf_(aa[i] + bav), ig = sigmoidf_(ax[i] + bxv); const float la = -cl * rg; const float av_ = __builtin_amdgcn_exp2f(la * LOG2E); av[i] = av_;
                uv[i] = __builtin_amdgcn_sqrtf((1.0f - av_) * (1.0f + av_)) * (ig * xv); }
            float pc[16], hl[16], Pg[4], Hg[4], Pgo[4], Hgo[4];
#pragma unroll
            for (int g = 0; g < 4; ++g) { float P = 1.f, H = 0.f;
#pragma unroll
                for (int j = 0; j < 4; ++j) { H = av[4 * g + j] * H + uv[4 * g + j]; P = P * av[4 * g + j]; pc[4 * g + j] = P; hl[4 * g + j] = H; }
                Pg[g] = P; Hg[g] = H; }
#pragma unroll
            for (int g = 0; g < 4; ++g) { Pgo[g] = __shfl_xor(Pg[g], 32); Hgo[g] = __shfl_xor(Hg[g], 32); }
            float cur = hc, cin[4];
#pragma unroll
            for (int g = 0; g < 4; ++g) { const float P0 = h == 0 ? Pg[g] : Pgo[g], H0 = h == 0 ? Hg[g] : Hgo[g], P1 = h == 0 ? Pgo[g] : Pg[g], H1 = h == 0 ? Hgo[g] : Hg[g];
                const float c0 = cur; cur = P0 * cur + H0; const float c1 = cur; cur = P1 * cur + H1; cin[g] = h == 0 ? c0 : c1; Pc *= P0 * P1; }
            hc = cur;
            if (PASSB) {
#pragma unroll
                for (int i = 0; i < 16; ++i) { const float hv = hl[i] + pc[i] * cin[i >> 2]; const float y = bf2f(ggr[i]) * hv; *(LAS unsigned short*)(wo_ + crow(i, h) * 64 + r * 2) = f2bf_hw(y); }
                const u32x4 o0 = *(const LAS u32x4*)(wo_ + tokp * 64 + qp * 16), o1 = *(const LAS u32x4*)(wo_ + (tokp + 16) * 64 + qp * 16);
                if (stv) { const size_t po = pbase + (size_t)tt * 32 * DR; *(u32x4*)(ar + po) = o0; *(u32x4*)(ar + po + (size_t)16 * DR) = o1; } }
            __builtin_amdgcn_sched_barrier(0);
        }
        if (!PASSB && chv && h == 0) { float* sp = summ + ((size_t)(b * NCHUNK + c) * DR + ch) * 2; sp[0] = Pc; sp[1] = hc; }
#undef RNN_ISSUE_X
#undef RNN_ISSUE_G
    }
#undef RNN_GLDS
#undef RNN_VMWAIT
#undef RNN_LGWAIT
}

namespace cg = cooperative_groups;
__global__ void __launch_bounds__(NTHREADS, 2) fwd(Args a) {
    extern __shared__ __attribute__((aligned(16))) unsigned char lds_raw[];
    LAS unsigned char* lds = (LAS unsigned char*)lds_raw;
    const int tid = threadIdx.x, lane = tid & 63, wave = __builtin_amdgcn_readfirstlane(tid >> 6);
    const int G = gridDim.x, bx = blockIdx.x;
    const int gw = bx * NWAVES + wave, ngw = G * NWAVES, gtid = bx * NTHREADS + tid, ngt = G * NTHREADS;
    unsigned char* ws = a.ws;
    const int lo = a.ph_lo, hi = a.ph_hi, mask = a.mask;
#define IN(k) (lo <= (k) && (k) < hi)
    { volatile LAS unsigned* misc = (volatile LAS unsigned*)(lds + MISC_OFF); if (tid < 16) misc[tid] = 0u; }
    __syncthreads();
#ifndef STAMPK
#define STAMPK -1
#endif
    unsigned long long t_start = 0, t_stamp = 0;
    if (STAMPK >= 0) t_start = __builtin_amdgcn_s_memrealtime();
    XcdBarrier bar = xcd_barrier_post((unsigned*)(ws + WS_SMALL + SM_CTL), (volatile LAS unsigned*)(lds + MISC_OFF));
#if USE_CG_SYNC
#define SEAM(k) do { if (IN(k) && IN((k) + 1)) cg::this_grid().sync(); } while (0)
#else
    bool lmode = false; int xslot = 0, lrank = 0;
    unsigned* bar2 = (unsigned*)(ws + WS_SMALL + SM_CTL) + 8192;
#ifndef LOCAL_SEAMS
#define LOCAL_SEAMS 1
#endif
#define SEAM(k) do { if (IN(k) && IN((k) + 1)) { if (lmode && (k) >= 5 && (k) <= 8) xcd_local_barrier(bar2, bar.x, 32u); else xcd_barrier(bar); } if (STAMPK == (k)) t_stamp = __builtin_amdgcn_s_memrealtime(); } while (0)
#endif
    bf16_t* hb = (bf16_t*)(ws + WS_HB); bf16_t* qn = (bf16_t*)(ws + WS_QN); bf16_t* kn = (bf16_t*)(ws + WS_KN); bf16_t* vv = (bf16_t*)(ws + WS_VV); bf16_t* xr = (bf16_t*)(ws + WS_XR);
    bf16_t* gg = (bf16_t*)(ws + WS_GG); bf16_t* sgr = (bf16_t*)(ws + WS_SGR); bf16_t* sga = (bf16_t*)(ws + WS_SGA); bf16_t* pb = (bf16_t*)(ws + WS_PB);
    bf16_t* ob = (bf16_t*)(ws + WS_OB); bf16_t* mixa = (bf16_t*)(ws + WS_MIXA); bf16_t* Pp = (bf16_t*)(ws + WS_PP); bf16_t* ar = (bf16_t*)(ws + WS_AR); bf16_t* mixb = (bf16_t*)(ws + WS_MIXB);
    bf16_t* x1b = (bf16_t*)(ws + WS_X1B); bf16_t* x2b = (bf16_t*)(ws + WS_X2B); bf16_t* act = (bf16_t*)(ws + WS_ACT);
    float* ssq1 = (float*)(ws + WS_SMALL + SM_SSQ1); float* ssq2 = (float*)(ws + WS_SMALL + SM_SSQ2);

#ifndef NO_P0
    if (IN(0)) { for (int rep = 0; rep < NREP(0); ++rep) if (mask & F_P0) p0_prologue(a, lds, gw, ngw, lane, gtid, ngt); }
#endif
    SEAM(0);
    if (LOCAL_SEAMS && G == 256 && IN(0) && IN(1)) {
        volatile LAS unsigned* misc = (volatile LAS unsigned*)(lds + MISC_OFF);
        if (tid == 0) { unsigned* b0 = (unsigned*)(ws + WS_SMALL + SM_CTL); unsigned npop = 0, ok = 1, slot = 0;
            for (unsigned j = 0; j < 16; ++j) { const unsigned c = xb_ld(&b0[XB_XCNT(j)]); if (c) { ++npop; if (c != 32u) ok = 0; if (j < bar.x) ++slot; } }
            misc[3] = slot; misc[4] = (ok && npop == 8u && misc[2] < 32u) ? 1u : 0u; }
        __syncthreads();
        lrank = __builtin_amdgcn_readfirstlane((int)misc[2]); xslot = __builtin_amdgcn_readfirstlane((int)misc[3]); lmode = __builtin_amdgcn_readfirstlane((int)misc[4]) != 0;
    }
    if (PHON(1) && IN(1) && (mask & F_G1)) for (int rep = 0; rep < NREP(1); ++rep) {
        pg8::Gemm g{hb, (const bf16_t*)(ws + WS_W1), M, DIN, DM}; pg8::Order<3> S; S.init(M, DIN, G, bx, lmode && P1_LOCAL, xslot, lrank);
        pg8::Epi1 E{xr, gg, qn, kn, vv, sgr, sga, a.q_gain, a.k_gain, (LAS float*)(lds + XCH_OFF), 1.0f / P1_KREP};
        pg8::gemm_phase<pg8::Epi1, pg8::Order<3>, true, true, P1_KREP, P1_EREP>(lds, g, S, E);
        const int tidx = (lmode && P1_LOCAL) ? (lrank >= 24 ? xslot * 8 + (lrank - 24) : -1) : (bx >= 192 ? bx - 192 : -1);
        if (LATE_CONV && LC_WAO_TAIL && G == 256 && tidx >= 0) convert_range(a, lds + wave * 16384, lane, CI_W1, CI_P2, tidx * NWAVES + wave, 64 * NWAVES);
        if (LATE_CONV && LC_P1TAIL && G == 256 && tidx >= 0) convert_range(a, lds + wave * 16384, lane, CI_P2, CI_P3 + TAIL_EXTRA, tidx * NWAVES + wave, 64 * NWAVES);
    }
    SEAM(1);
    if (IN(2)) for (int rep = 0; rep < NREP(2); ++rep) {
        LAS unsigned char* wl = lds + wave * 16384;
#define P2_STREAM() do { if (mask & F_CONV) conv_phase(a, gtid, ngt); if (LATE_CONV && LC_P2) convert_range(a, wl, lane, CI_P2, CI_P3, gw, ngw); } while (0)
#define P2_ATTN() do { if (mask & F_ATTN) { for (int u = gw; u < NBATCH * NH * (SEQ / 32); u += ngw) attn_unit(u >> 11, (u >> 7) & 15, u & 127, qn, kn, vv, ob, wl, lane); } } while (0)
        if (P2_SWAP && wave < 4) { P2_ATTN(); P2_STREAM(); } else { P2_STREAM(); P2_ATTN(); }
#undef P2_STREAM
#undef P2_ATTN
    }
    SEAM(2);
    if (IN(3)) for (int rep = 0; rep < NREP(3); ++rep) {
        if (mask & F_RNN) {
            LAS unsigned char* wl = lds + wave * 16384;
            if (wave >= 4 && LATE_CONV) convert_range(a, wl, lane, (LC_P2 || (LC_P1TAIL && G == 256)) ? CI_P3 + ((LC_P1TAIL && G == 256) ? TAIL_EXTRA : 0) : CI_P2, CI_P4, gw, ngw);
            rnn_wave<false>(a, lane, wl, gw, ngw);
            if (wave < 4 && LATE_CONV) convert_range(a, wl, lane, (LC_P2 || (LC_P1TAIL && G == 256)) ? CI_P3 + ((LC_P1TAIL && G == 256) ? TAIL_EXTRA : 0) : CI_P2, CI_P4, gw, ngw);
        }
        if (PHON(3) && (mask & F_YA)) {
            __syncthreads();
            { pg8::Gemm g{ob, (const bf16_t*)(ws + WS_WAO), M, DM, DM}; pg8::StaticOrder S; S.init(M, DM, G, bx); pg8::EpiMixA E{mixa, sga, DM};
              pg8::gemm_phase<pg8::EpiMixA, pg8::StaticOrder, true, true>(lds, g, S, E); }
        }
    }
    SEAM(3);
    if (IN(4) && (mask & F_RNN)) {
        LAS unsigned char* wl = lds + wave * 16384;
        if (wave >= 4 && LATE_CONV && LC_P4) convert_range(a, wl, lane, CI_P4, CI_END, gw, ngw);
        rnn_wave<true>(a, lane, wl, gw, ngw);
        if (wave < 4 && LATE_CONV && LC_P4) convert_range(a, wl, lane, CI_P4, CI_END, gw, ngw);
    }
    SEAM(4);
    if (PHON(5) && IN(5) && (mask & F_YR)) for (int rep = 0; rep < NREP(5); ++rep) { pg8::Gemm g{ar, (const bf16_t*)(ws + WS_WRO), M, DM, DR}; pg8::Order<0> S; S.init(M, DM, G, bx, lmode, xslot, lrank); pg8::EpiMixB E{mixb, mixa, sgr, DM};
        pg8::gemm_phase<pg8::EpiMixB, pg8::Order<0>, true, true>(lds, g, S, E); }
    SEAM(5);
    if (PHON(6) && IN(6) && (mask & F_WO)) { pg8::Gemm g{mixb, (const bf16_t*)(ws + WS_WO), M, DM, DM}; pg8::Order<0> S; S.init(M, DM, G, bx, lmode, xslot, lrank); pg8::EpiRes<false> E{a.x, x1b, ssq1, DM};
        pg8::gemm_phase<pg8::EpiRes<false>, pg8::Order<0>, true, true>(lds, g, S, E); }
    SEAM(6);
    if (PHON(7) && IN(7) && (mask & F_FFU)) {
        pg8::Gemm g{x1b, (const bf16_t*)(ws + WS_WGU), M, 2 * DFF, DM}; pg8::Order<1> S; S.init(M, 2 * DFF, G, bx, lmode, xslot, lrank); pg8::EpiFfn E{act, ssq1, DFF, 1.0f / P7_KREP};
        pg8::gemm_phase<pg8::EpiFfn, pg8::Order<1>, P7_ALIGN, P7_SP2, P7_KREP, P7_EREP>(lds, g, S, E);
        if (lmode || G != 256 || bx >= 128) { pg8::Gemm g2{pb, (const bf16_t*)(ws + WS_WPP), M, DM, PLE}; pg8::Order<2> S2; if (G == 256) S2.init(M, DM, 128, bx - 128, lmode, xslot, lrank); else S2.init(M, DM, G, bx, false, 0, 0);
            pg8::EpiMixA E2{Pp, nullptr, DM};
            pg8::gemm_phase<pg8::EpiMixA, pg8::Order<2>, true, false>(lds, g2, S2, E2); }
        if (LATE_CONV && !LC_P4 && LC_P7TAIL && G == 256) { const int sidx = lmode ? (lrank >= 16 ? xslot * 16 + (lrank - 16) : -1) : (bx >= 128 ? bx - 128 : -1);
            if (sidx >= 0) convert_range(a, lds + wave * 16384, lane, CI_P4, CI_P4 + CI_WDN + CI_WPG, sidx * NWAVES + wave, 128 * NWAVES); } }
    SEAM(7);
    if (PHON(8) && IN(8) && (mask & F_FFD)) { pg8::Gemm g{act, (const bf16_t*)(ws + WS_WDN), M, DM, DFF}; pg8::Order<0> S; S.init(M, DM, G, bx, lmode, xslot, lrank); pg8::EpiRes<true> E{x1b, x2b, ssq2, DM};
        pg8::gemm_phase<pg8::EpiRes<true>, pg8::Order<0>, true, true>(lds, g, S, E); }
    SEAM(8);
    if (PHON(9) && IN(9) && (mask & F_PLE)) { pg8::Gemm g{x2b, (const bf16_t*)(ws + WS_WPG), M, DM, DM}; pg8::Order<0> S; S.init(M, DM, G, bx, lmode, xslot, lrank); pg8::EpiPle E{x2b, Pp, a.out, ssq2, DM};
        pg8::gemm_phase<pg8::EpiPle, pg8::Order<0>, true, true>(lds, g, S, E); }
    if (STAMPK >= 0 && bx == 0) { const unsigned long long t_end = __builtin_amdgcn_s_memrealtime(), wait = 2ull * (t_stamp - t_start); while (__builtin_amdgcn_s_memrealtime() - t_end < wait) __builtin_amdgcn_s_sleep(16); }
#undef IN
#undef SEAM
}

#ifndef FASTMASK
#define FASTMASK F_ALL
#endif
#ifndef ONE_LAUNCH
#define ONE_LAUNCH 1
#endif
extern "C" void kernel_launch(void* const* d_in, const int* in_sizes, int n_in, void* d_out, int out_size, void* d_ws, size_t ws_size, hipStream_t stream) {
    if (n_in != 22 || out_size != M * DM || ws_size < WS_END) { fprintf(stderr, "kernel_launch: unexpected sizes n_in %d out %d ws %zu\n", n_in, out_size, ws_size); return; }
    const float* x = (const float*)d_in[0]; const float* p = (const float*)d_in[1]; const float* g_mix = (const float*)d_in[2]; const float* w_in = (const float*)d_in[3];
    const float* conv_w = (const float*)d_in[4]; const float* conv_b = (const float*)d_in[5]; const float* w_rg_a = (const float*)d_in[6]; const float* b_rg_a = (const float*)d_in[7];
    const float* w_rg_x = (const float*)d_in[8]; const float* b_rg_x = (const float*)d_in[9]; const float* lam = (const float*)d_in[10]; const float* q_gain = (const float*)d_in[11];
    const float* k_gain = (const float*)d_in[12]; const float* w_rnn_out = (const float*)d_in[13]; const float* w_attn_out = (const float*)d_in[14]; const float* w_o = (const float*)d_in[15];
    const float* g_ffn = (const float*)d_in[16]; const float* w_gu = (const float*)d_in[17]; const float* w_dn = (const float*)d_in[18]; const float* g_ple = (const float*)d_in[19];
    const float* w_pg = (const float*)d_in[20]; const float* w_pp = (const float*)d_in[21];
    float* out = (float*)d_out; unsigned char* ws = (unsigned char*)d_ws;
    static int grid = 0;
    if (grid == 0) {
        int dev = 0, cus = 0, per_cu = 0;
        if (hipGetDevice(&dev) != hipSuccess || hipDeviceGetAttribute(&cus, hipDeviceAttributeMultiprocessorCount, dev) != hipSuccess) { fprintf(stderr, "kernel_launch: device query failed\n"); grid = -1; return; }
        if (hipFuncSetAttribute((const void*)fwd, hipFuncAttributeMaxDynamicSharedMemorySize, LDS_BYTES) != hipSuccess) { fprintf(stderr, "kernel_launch: hipFuncSetAttribute failed\n"); grid = -1; return; }
        if (hipOccupancyMaxActiveBlocksPerMultiprocessor(&per_cu, (const void*)fwd, NTHREADS, LDS_BYTES) != hipSuccess || per_cu < 1) { fprintf(stderr, "kernel_launch: occupancy query says %d blocks per CU\n", per_cu); (void)hipGetLastError(); grid = -1; return; }
        grid = cus;
    }
    if (grid < 0) return;
    Args a{};
    a.x = x; a.p = p; a.g_mix = g_mix; a.w_in = w_in; a.conv_w = conv_w; a.conv_b = conv_b; a.w_rg_a = w_rg_a; a.b_rg_a = b_rg_a; a.w_rg_x = w_rg_x; a.b_rg_x = b_rg_x; a.lam = lam;
    a.q_gain = q_gain; a.k_gain = k_gain; a.w_rnn_out = w_rnn_out; a.w_attn_out = w_attn_out; a.w_o = w_o; a.g_ffn = g_ffn; a.w_gu = w_gu; a.w_dn = w_dn; a.g_ple = g_ple; a.w_pg = w_pg; a.w_pp = w_pp;
    a.out = out; a.ws = ws;
    if (hipMemsetAsync(ws + WS_SMALL + SM_CTL, 0, CTL_BYTES, stream) != hipSuccess) { fprintf(stderr, "kernel_launch: memset failed\n"); return; }
    a.ph_lo = 0; a.ph_hi = 10; a.mask = F_ALL;
    void* kargs[] = {&a};
    hipError_t e = hipLaunchCooperativeKernel((const void*)fwd, dim3(grid), dim3(NTHREADS), kargs, LDS_BYTES, stream);
    if (e != hipSuccess) fprintf(stderr, "kernel_launch: launch failed: %s (grid %d)\n", hipGetErrorString(e), grid);
}
```

```cpp
#include <hip/hip_runtime.h>
#include <hip/hip_cooperative_groups.h>
#include <cstdio>
#include <cstdint>

typedef unsigned short bf16_t;
typedef float f32x4 __attribute__((ext_vector_type(4)));
typedef unsigned u32x4 __attribute__((ext_vector_type(4)));
typedef unsigned u32x2 __attribute__((ext_vector_type(2)));
typedef short bf16x8 __attribute__((ext_vector_type(8)));
typedef short s16x4 __attribute__((ext_vector_type(4)));
typedef float f32x16 __attribute__((ext_vector_type(16)));
#define LAS __attribute__((address_space(3)))

constexpr int SEQ = 4096, NBATCH = 2, M = NBATCH * SEQ, DM = 2048, DR = 2816, DIN = 15872, DFF = 5632, PLE = 256, NH = 16, HD = 128;
constexpr int NRB = 16, RB = 176, RBP = 192, NCHUNK = 32, CHUNK = 128;
constexpr float EPS = 1e-6f;
constexpr float LOG2E = 1.4426950408889634f, LN2 = 0.6931471805599453f;

constexpr size_t MiB = (size_t)1 << 20;
constexpr size_t WS_WRO = 0, WS_WAO = 11 * MiB, WS_WO = 19 * MiB, WS_WGU = 27 * MiB, WS_WDN = 71 * MiB, WS_WPG = 93 * MiB, WS_WPP = 101 * MiB, WS_WRA = 102 * MiB, WS_WRX = 102 * MiB + 1536 * 1024;
constexpr size_t WS_W1 = 106 * MiB, WS_HB = 168 * MiB, WS_QN = 200 * MiB, WS_KN = 232 * MiB, WS_VV = 264 * MiB, WS_XR = 296 * MiB, WS_GG = 340 * MiB, WS_SGR = 388 * MiB, WS_SGA = 420 * MiB, WS_SMALL = 460 * MiB, WS_PB = 464 * MiB, WS_END = 468 * MiB;
constexpr size_t WS_XC = WS_W1, WS_OB = WS_HB, WS_MIXA = WS_QN, WS_PP = WS_VV, WS_AR = WS_XR, WS_MIXB = WS_KN  , WS_X1B = WS_GG, WS_X2B = WS_GG, WS_ACT = WS_W1;
constexpr size_t SM_SSQ1 = 0, SM_SSQ2 = 32768, SM_SUMM = 65536;

__device__ __forceinline__ float bf2f(bf16_t b) { return __uint_as_float((unsigned)b << 16); }
__device__ __forceinline__ bf16_t f2bf(float f) { unsigned u = __float_as_uint(f); return (bf16_t)((u + 0x7fffu + ((u >> 16) & 1u)) >> 16); }
__device__ __forceinline__ float rbf(float f) { return bf2f(f2bf(f)); }
__device__ __forceinline__ float sigmoidf_(float x) { return __builtin_amdgcn_rcpf(1.0f + __builtin_amdgcn_exp2f(-x * LOG2E)); }
__device__ __forceinline__ float gelu_tanh(float x) { const float y = 0.7978845608028654f * (x + 0.044715f * x * x * x); return x * __builtin_amdgcn_rcpf(1.0f + __builtin_amdgcn_exp2f(-2.0f * LOG2E * y)); }
__device__ __forceinline__ float softplusf_(float z) { return fmaxf(z, 0.f) + LN2 * __builtin_amdgcn_logf(1.0f + __builtin_amdgcn_exp2f(-fabsf(z) * LOG2E)); }
__device__ __forceinline__ float wave_sum(float v) {
#pragma unroll
    for (int o = 1; o < 64; o <<= 1) v += __shfl_xor(v, o);
    return v;
}
#ifndef WT_STORES
#define WT_STORES 0
#endif
__device__ __forceinline__ void st16_wt(void* p, const __attribute__((ext_vector_type(4))) unsigned& v) {
#if WT_STORES
    asm volatile("s_nop 1\n\tglobal_store_dwordx4 %0, %1, off sc1\n\ts_nop 1" :: "v"(p), "v"(v) : "memory");
#else
    *(__attribute__((ext_vector_type(4))) unsigned*)p = v;
#endif
}

#define ONE_LAUNCH 1
#define FASTMASK 2047
namespace pg8 {
#define PG8_LAS __attribute__((address_space(3)))
typedef unsigned short bf16_t;
typedef short bf16x8 __attribute__((ext_vector_type(8)));
typedef float f32x4 __attribute__((ext_vector_type(4)));
typedef unsigned u32x4 __attribute__((ext_vector_type(4)));
constexpr int BM = 256, BK = 64, HALF = 128, HTB = HALF * BK * 2  , STAGE_BYTES = 8 * HTB, NXCD = 8, WGM = 8;

__host__ __device__ __forceinline__ int lds_byte(int r, int c) { const int st = (r >> 4) * 2 + (c >> 5), rr = r & 15, cc = c & 31, ob = rr * 64 + cc * 2; return st * 1024 + (ob ^ (((ob >> 9) & 1) << 5)); }
__host__ __device__ __forceinline__ void stage_rc(int b, int& R, int& C) { const int st = b / 1024, sb = b % 1024, swz = sb ^ (((sb >> 9) & 1) << 5); R = (st >> 1) * 16 + swz / 64; C = (st & 1) * 32 + (swz % 64) / 2; }
__host__ __device__ __forceinline__ int perm32(int rho) { const int n = rho >> 4, i = rho & 15; return 8 * (i >> 2) + 4 * n + (i & 3); }

struct Unit { int pm, pn; };
struct Gemm { const bf16_t* A; const bf16_t* Bt; int M, N, K; };

struct StaticOrder {
    int nM, nN, nwg, G, c;
    __host__ __device__ void init(int M, int N, int G_, int c_) { nM = M / BM; nN = N / BM; nwg = nM * nN; G = G_; c = c_; }
    __host__ __device__ bool next(int i, Unit& u) const {
        const long L = (long)i * G + c; if (L >= nwg) return false;
        int wgid = (int)L; { const int q = nwg / NXCD, r = nwg % NXCD, xcd = wgid % NXCD, off = wgid / NXCD; wgid = (xcd < r ? xcd * (q + 1) : r * (q + 1) + (xcd - r) * q) + off; }
        const int nig = WGM * nN, gid = wgid / nig, fm = gid * WGM, gsz = (nM - fm) < WGM ? (nM - fm) : WGM;
        u.pm = fm + ((wgid % nig) % gsz); u.pn = (wgid % nig) / gsz; return true;
    }
    __device__ __forceinline__ void a_ready(const Unit&) const {}
    __device__ __forceinline__ void done(const Unit&) const {}
};
#ifndef P1_ORD
#define P1_ORD 1
#endif
#ifndef ROT_P1
#define ROT_P1 0
#endif
#ifndef ROT_XCD
#define ROT_XCD 1
#endif
template <int kind> struct Order {
    StaticOrder so;
    __device__ __forceinline__ void init(int M, int N, int G, int c, bool local, int xs, int rk) { so.init(M, N, G, c); if (local) { so.nwg = -1; so.G = xs; so.c = rk; } }
    __device__ __forceinline__ bool next(int i, Unit& u) const {
        if (so.nwg >= 0) return so.next(i, u);
        const int xs = so.G, rk = so.c;
        if (kind == 0) { if (i > 0) return false; u.pm = 4 * xs + (rk >> 3); u.pn = rk & 7; return true; }
        if (kind == 1) { const int j = i * 32 + rk; if (j >= 176) return false; u.pm = 4 * xs + (j & 3);
            int s = (j >> 2) + (ROT_XCD ? 8 * xs : 0); s = s >= 88 ? s - 88 : s; s = s >= 44 ? s - 44 : s; u.pn = s; return true; }
        if (kind == 3) { const int j = i * 32 + rk; if (j >= 248) return false; u.pm = 4 * xs + (j & 3); int s = j >> 2; if (ROT_P1 && s >= 27) { s += 4 * xs; s = s >= 62 ? s - 35 : s; }
            u.pn = P1_ORD ? (s < 16 ? 46 + s : s < 27 ? s - 5 : s < 51 ? s - 5 : s - 51) : s; return true; }
        if (i >= 2 || rk < 16) return false;
        const int j = (rk - 16) * 2 + i; u.pm = 4 * xs + (j >> 3); u.pn = j & 7; return true;
    }
    __device__ __forceinline__ void a_ready(const Unit&) const {}
    __device__ __forceinline__ void done(const Unit&) const {}
};

__device__ __forceinline__ unsigned cvt_pk_bf16(float lo, float hi) { unsigned r; asm volatile("v_cvt_pk_bf16_f32 %0, %1, %2" : "=v"(r) : "v"(lo), "v"(hi)); return r; }
__device__ __forceinline__ float bflo(unsigned w) { return __uint_as_float(w << 16); }
__device__ __forceinline__ float bfhi(unsigned w) { return __uint_as_float(w & 0xffff0000u); }
__device__ __forceinline__ float sig_(float x) { return __builtin_amdgcn_rcpf(1.0f + __builtin_amdgcn_exp2f(-x * 1.4426950408889634f)); }
__device__ __forceinline__ float gelu_t(float x) { const float y = 0.7978845608028654f * (x + 0.044715f * x * x * x); return x * __builtin_amdgcn_rcpf(1.0f + __builtin_amdgcn_exp2f(-2.0f * 1.4426950408889634f * y)); }
__device__ __forceinline__ u32x4 pack8(const f32x4& v0, const f32x4& v1) { u32x4 w; w.x = cvt_pk_bf16(v0[0], v0[1]); w.y = cvt_pk_bf16(v0[2], v0[3]); w.z = cvt_pk_bf16(v1[0], v1[1]); w.w = cvt_pk_bf16(v1[2], v1[3]); return w; }

#ifndef EPI_NT
#define EPI_NT 0
#endif
#if EPI_NT
#define EPI_ST16(p, v) st_nt16((p), (v))
#else
#define EPI_ST16(p, v) (*(u32x4*)(p) = (v))
#ifndef EPI_WT
#define EPI_WT 0
#endif
#if EPI_WT
#define EPI_ST16_WT(p, v) st16_wt((p), (v))
#else
#define EPI_ST16_WT(p, v) (*(u32x4*)(p) = (v))
#endif
#endif
__device__ __forceinline__ void st_nt16(void* p, const u32x4& v) { __builtin_nontemporal_store(v, (u32x4*)p); }
struct Epi1 {
    static constexpr bool PERM = true, AFTER_DRAIN = false, PREFETCH = false;
    bf16_t *xr, *gg, *qn, *kn, *vv, *sgr, *sga; const float *qgain, *kgain; PG8_LAS float* xch; float kscale;
    __device__ __forceinline__ void operator()(const f32x4 (&acc)[2][2][4][2], const Unit& u, int wr, int wc, int fr, int fq) const {
        const int pn = u.pn;
        int kind, ld, colt; bf16_t* base;
        if (pn < 11) { kind = 0; base = xr; ld = 2816; colt = pn * 256; }
        else if (pn < 22) { kind = 1; base = gg; ld = 2816; colt = (pn - 11) * 256; }
        else if (pn < 30) { kind = 2; base = qn; ld = 2048; colt = (pn - 22) * 256; }
        else if (pn < 38) { kind = 3; base = kn; ld = 2048; colt = (pn - 30) * 256; }
        else if (pn < 46) { kind = 0; base = vv; ld = 2048; colt = (pn - 38) * 256; }
        else if (pn < 54) { kind = 4; base = sgr; ld = 2048; colt = (pn - 46) * 256; }
        else { kind = 4; base = sga; ld = 2048; colt = (pn - 54) * 256; }
        float rst[2][4][2]; f32x4 gv[2];
#pragma unroll
        for (int ai = 0; ai < 2; ++ai)
#pragma unroll
            for (int m = 0; m < 4; ++m) { rst[ai][m][0] = 1.f; rst[ai][m][1] = 1.f; }
        gv[0] = (f32x4){1.f, 1.f, 1.f, 1.f}; gv[1] = gv[0];
        if (kind == 2 || kind == 3) {
#pragma unroll
            for (int ai = 0; ai < 2; ++ai)
#pragma unroll
                for (int m = 0; m < 4; ++m)
#pragma unroll
                    for (int bj = 0; bj < 2; ++bj) { const f32x4 a = acc[ai][bj][m][0] * kscale, b = acc[ai][bj][m][1] * kscale;
                        float s = (a[0] * a[0] + a[1] * a[1]) + (a[2] * a[2] + a[3] * a[3]) + (b[0] * b[0] + b[1] * b[1]) + (b[2] * b[2] + b[3] * b[3]);
                        s += __shfl_xor(s, 16); s += __shfl_xor(s, 32);
                        if (fq == 0) xch[((ai * HALF + wr * 64 + m * 16 + fr) * 2 + bj) * 4 + wc] = s; }
            asm volatile("s_waitcnt lgkmcnt(0)" ::: "memory"); __builtin_amdgcn_s_barrier(); asm volatile("" ::: "memory");
            const float extra = kind == 2 ? 0.08838834764831845f * 1.4426950408889634f : 1.0f;
#pragma unroll
            for (int ai = 0; ai < 2; ++ai)
#pragma unroll
                for (int m = 0; m < 4; ++m)
#pragma unroll
                    for (int bj = 0; bj < 2; ++bj) { const f32x4 t = *(const PG8_LAS f32x4*)&xch[((ai * HALF + wr * 64 + m * 16 + fr) * 2 + bj) * 4];
                        rst[ai][m][bj] = extra * __builtin_amdgcn_rsqf(((t[0] + t[1]) + (t[2] + t[3])) * (1.0f / 128.0f) + 1e-6f); }
            const float* gp = (kind == 2 ? qgain : kgain) + wc * 32 + 8 * fq; gv[0] = *(const f32x4*)gp; gv[1] = *(const f32x4*)(gp + 4);
        }
        bf16_t* rowp = base + (size_t)(u.pm * BM + wr * 64 + fr) * ld + colt + wc * 32 + 8 * fq;
        const size_t step16 = (size_t)16 * ld;
#define EPI1_LOOP(BODY) _Pragma("unroll") for (int ai = 0; ai < 2; ++ai) { _Pragma("unroll") for (int m = 0; m < 4; ++m) { _Pragma("unroll") for (int bj = 0; bj < 2; ++bj) { \
            f32x4 v0 = acc[ai][bj][m][0] * kscale, v1 = acc[ai][bj][m][1] * kscale; BODY; EPI_ST16_WT(rowp + bj * HALF, pack8(v0, v1)); } \
            rowp += step16; __builtin_amdgcn_sched_barrier(0); } rowp += step16 * 4; }
        if (kind == 0) { EPI1_LOOP((void)0) }
        else if (kind == 1) {
            size_t coff[2];
#pragma unroll
            for (int bj = 0; bj < 2; ++bj) { const int col = colt + bj * HALF + wc * 32 + 8 * fq; const int nb = col / 176, cl = col - nb * 176; coff[bj] = (size_t)(nb * 6 + (cl >> 5)) * 1024 + (cl & 31); }
            const int R0 = u.pm * BM + wr * 64 + fr;
#pragma unroll
            for (int ai = 0; ai < 2; ++ai) {
#pragma unroll
                for (int m = 0; m < 4; ++m) { const int row = R0 + ai * HALF + m * 16; const size_t roff = (size_t)(row >> 5) * (96 * 1024) + (row & 31) * 32;
#pragma unroll
                    for (int bj = 0; bj < 2; ++bj) { f32x4 v0 = acc[ai][bj][m][0] * kscale, v1 = acc[ai][bj][m][1] * kscale;
#pragma unroll
                        for (int j = 0; j < 4; ++j) { v0[j] = gelu_t(v0[j]); v1[j] = gelu_t(v1[j]); }
                        EPI_ST16_WT(gg + roff + coff[bj], pack8(v0, v1)); }
                    __builtin_amdgcn_sched_barrier(0); } }
        }
        else if (kind == 4) { EPI1_LOOP(_Pragma("unroll") for (int j = 0; j < 4; ++j) { v0[j] = sig_(v0[j]); v1[j] = sig_(v1[j]); }) }
        else { EPI1_LOOP(v0 = v0 * rst[ai][m][bj] * gv[0]; v1 = v1 * rst[ai][m][bj] * gv[1]) }
#undef EPI1_LOOP
    }
};
__device__ __forceinline__ void unpack8(const u32x4& g, f32x4& a, f32x4& b) { a = (f32x4){bflo(g.x), bfhi(g.x), bflo(g.y), bfhi(g.y)}; b = (f32x4){bflo(g.z), bfhi(g.z), bflo(g.w), bfhi(g.w)}; }
struct EpiMixA {
    static constexpr bool PERM = true, AFTER_DRAIN = false, PREFETCH = false;
    bf16_t* O; const bf16_t* G; int ld;
    __device__ __forceinline__ void operator()(const f32x4 (&acc)[2][2][4][2], const Unit& u, int wr, int wc, int fr, int fq) const {
        const int row0 = u.pm * BM + wr * 64 + fr, col0 = u.pn * BM + wc * 32 + 8 * fq;
        u32x4 g[2][4][2];
        if (G) {
#pragma unroll
            for (int ai = 0; ai < 2; ++ai)
#pragma unroll
                for (int m = 0; m < 4; ++m)
#pragma unroll
                    for (int bj = 0; bj < 2; ++bj) g[ai][m][bj] = *(const u32x4*)(G + (size_t)(row0 + ai * HALF + m * 16) * ld + col0 + bj * HALF);
            asm volatile("" ::: "memory");
        }
#pragma unroll
        for (int ai = 0; ai < 2; ++ai)
#pragma unroll
            for (int m = 0; m < 4; ++m)
#pragma unroll
                for (int bj = 0; bj < 2; ++bj) { f32x4 v0 = acc[ai][bj][m][0], v1 = acc[ai][bj][m][1];
                    if (G) { f32x4 g0, g1; unpack8(g[ai][m][bj], g0, g1); v0 = v0 * g0; v1 = v1 * g1; }
                    bf16_t* op_ = O + (size_t)(row0 + ai * HALF + m * 16) * ld + col0 + bj * HALF; if (G) EPI_ST16_WT(op_, pack8(v0, v1)); else *(u32x4*)op_ = pack8(v0, v1); }
    }
};
#ifndef EPI_NTL
#define EPI_NTL 0
#endif
#if EPI_NTL
#define EPI_LD16(p) __builtin_nontemporal_load((const u32x4*)(p))
#define EPI_LDF4(p) __builtin_nontemporal_load((const f32x4*)(p))
#else
#define EPI_LD16(p) (*(const u32x4*)(p))
#define EPI_LDF4(p) (*(const f32x4*)(p))
#endif
struct EpiMixB {
    static constexpr bool PERM = true, AFTER_DRAIN = false, PREFETCH = false;
    bf16_t* O; const bf16_t* F; const bf16_t* G; int ld;
    __device__ __forceinline__ void operator()(const f32x4 (&acc)[2][2][4][2], const Unit& u, int wr, int wc, int fr, int fq) const {
        const int row0 = u.pm * BM + wr * 64 + fr, col0 = u.pn * BM + wc * 32 + 8 * fq;
        u32x4 f[4][2], g[4][2];
#pragma unroll
        for (int m = 0; m < 4; ++m)
#pragma unroll
            for (int bj = 0; bj < 2; ++bj) { const size_t o = (size_t)(row0 + m * 16) * ld + col0 + bj * HALF; f[m][bj] = EPI_LD16(F + o); g[m][bj] = EPI_LD16(G + o); }
        asm volatile("" ::: "memory");
#pragma unroll
        for (int ai = 0; ai < 2; ++ai) {
            u32x4 r[4][2];
#pragma unroll
            for (int m = 0; m < 4; ++m)
#pragma unroll
                for (int bj = 0; bj < 2; ++bj) { f32x4 f0, f1, g0, g1; unpack8(f[m][bj], f0, f1); unpack8(g[m][bj], g0, g1); r[m][bj] = pack8(f0 + acc[ai][bj][m][0] * g0, f1 + acc[ai][bj][m][1] * g1); }
            if (ai == 0) {
                asm volatile("" ::: "memory");
#pragma unroll
                for (int m = 0; m < 4; ++m)
#pragma unroll
                    for (int bj = 0; bj < 2; ++bj) { const size_t o = (size_t)(row0 + HALF + m * 16) * ld + col0 + bj * HALF; f[m][bj] = EPI_LD16(F + o); g[m][bj] = EPI_LD16(G + o); }
            }
            asm volatile("" ::: "memory");
#pragma unroll
            for (int m = 0; m < 4; ++m)
#pragma unroll
                for (int bj = 0; bj < 2; ++bj) *(u32x4*)(O + (size_t)(row0 + ai * HALF + m * 16) * ld + col0 + bj * HALF) = r[m][bj];
            asm volatile("" ::: "memory"); }
    }
};
template <bool XBF> struct EpiRes {
    static constexpr bool PERM = true, AFTER_DRAIN = false, PREFETCH = false;
    const void* X; bf16_t* O; float* ssq; int ld;
    __device__ __forceinline__ void operator()(const f32x4 (&acc)[2][2][4][2], const Unit& u, int wr, int wc, int fr, int fq) const {
        const int row0 = u.pm * BM + wr * 64 + fr, col0 = u.pn * BM + wc * 32 + 8 * fq;
        f32x4 xv[4][2][2]; u32x4 xb[4][2];
#define EPIRES_LOAD(ai_) _Pragma("unroll") for (int m = 0; m < 4; ++m) { _Pragma("unroll") for (int bj = 0; bj < 2; ++bj) { const size_t o = (size_t)(row0 + (ai_) * HALF + m * 16) * ld + col0 + bj * HALF; \
            if (XBF) xb[m][bj] = EPI_LD16((const bf16_t*)X + o); else { xv[m][bj][0] = EPI_LDF4((const float*)X + o); xv[m][bj][1] = EPI_LDF4((const float*)X + o + 4); } } }
        EPIRES_LOAD(0)
        asm volatile("" ::: "memory");
#pragma unroll
        for (int ai = 0; ai < 2; ++ai) {
            u32x4 r[4][2]; float s[4];
#pragma unroll
            for (int m = 0; m < 4; ++m) { s[m] = 0.f;
#pragma unroll
                for (int bj = 0; bj < 2; ++bj) { f32x4 x0, x1; if (XBF) unpack8(xb[m][bj], x0, x1); else { x0 = xv[m][bj][0]; x1 = xv[m][bj][1]; }
                    const f32x4 v0 = x0 + acc[ai][bj][m][0], v1 = x1 + acc[ai][bj][m][1];
                    r[m][bj] = pack8(v0, v1);
                    s[m] += (v0[0] * v0[0] + v0[1] * v0[1]) + (v0[2] * v0[2] + v0[3] * v0[3]) + (v1[0] * v1[0] + v1[1] * v1[1]) + (v1[2] * v1[2] + v1[3] * v1[3]); }
                s[m] += __shfl_xor(s[m], 16); s[m] += __shfl_xor(s[m], 32); }
            if (ai == 0) { asm volatile("" ::: "memory"); EPIRES_LOAD(1) }
            asm volatile("" ::: "memory");
#pragma unroll
            for (int m = 0; m < 4; ++m) { const int row = row0 + ai * HALF + m * 16;
#pragma unroll
                for (int bj = 0; bj < 2; ++bj) *(u32x4*)(O + (size_t)row * ld + col0 + bj * HALF) = r[m][bj];
                if (fq == 0) unsafeAtomicAdd(ssq + row, s[m]); }
            asm volatile("" ::: "memory"); }
#undef EPIRES_LOAD
    }
};
typedef float f32x2 __attribute__((ext_vector_type(2)));
constexpr int SQ_LDS_OFF = 131072 + 8192 + 256;
struct EpiFfn {
    static constexpr bool PERM = true, AFTER_DRAIN = false, PREFETCH = true;
    bf16_t* O; const float* ssq; int ldo; float kscale;
    __device__ __forceinline__ void prefetch(PG8_LAS unsigned char* lds, const Unit& u, int par, int wid, int lane) const {
        if (wid < 4) __builtin_amdgcn_global_load_lds((const unsigned*)(ssq + u.pm * BM + wid * 64 + lane), (PG8_LAS unsigned*)(lds + SQ_LDS_OFF + par * 1024 + wid * 256), 4, 0, 0);
    }
    __device__ __forceinline__ void run(const f32x4 (&acc)[2][2][4][2], const Unit& u, int wr, int wc, int fr, int fq, PG8_LAS unsigned char* lds, int par) const {
        const int row0 = u.pm * BM + wr * 64 + fr, col0 = u.pn * HALF + wc * 32 + 8 * fq;
        const PG8_LAS float* sl = (const PG8_LAS float*)(lds + SQ_LDS_OFF + par * 1024) + wr * 64 + fr;
        float sq[2][4];
#pragma unroll
        for (int ai = 0; ai < 2; ++ai)
#pragma unroll
            for (int m = 0; m < 4; ++m) sq[ai][m] = sl[ai * HALF + m * 16];
#pragma unroll
        for (int ai = 0; ai < 2; ++ai)
#pragma unroll
            for (int m = 0; m < 4; ++m) { const int row = row0 + ai * HALF + m * 16; const float rs = kscale * __builtin_amdgcn_rsqf(sq[ai][m] * (1.0f / 2048.0f) + 1e-6f);
                const float c1 = -1.4426950408889634f * rs, r2 = rs * rs; const f32x2 cc = {c1, c1}, rr = {r2, r2}, one = {1.0f, 1.0f};
                u32x4 w;
#pragma unroll
                for (int n = 0; n < 2; ++n)
#pragma unroll
                    for (int jp = 0; jp < 2; ++jp) { const f32x2 g2 = {acc[ai][0][m][n][2 * jp], acc[ai][0][m][n][2 * jp + 1]}, u2 = {acc[ai][1][m][n][2 * jp], acc[ai][1][m][n][2 * jp + 1]};
                        const f32x2 t = g2 * cc; f32x2 e = {__builtin_amdgcn_exp2f(t[0]), __builtin_amdgcn_exp2f(t[1])}; e = e + one;
                        const f32x2 q = {__builtin_amdgcn_rcpf(e[0]), __builtin_amdgcn_rcpf(e[1])}; const f32x2 o = ((g2 * u2) * rr) * q;
                        w[n * 2 + jp] = cvt_pk_bf16(o[0], o[1]); }
                EPI_ST16(O + (size_t)row * ldo + col0, w); }
    }
};
#ifndef PLE_SWAP
#define PLE_SWAP 0
#endif
#ifndef PLE_NT
#define PLE_NT 1
#endif
#if PLE_NT
#define EPIPLE_ST(p, v) __builtin_nontemporal_store((v), (f32x4*)(p))
#else
#define EPIPLE_ST(p, v) (*(f32x4*)(p) = (v))
#endif
struct EpiPle {
    static constexpr bool PERM = true, AFTER_DRAIN = false, PREFETCH = false;
    const bf16_t* X; const bf16_t* P; float* out; const float* ssq; int ld;
    __device__ __forceinline__ void operator()(const f32x4 (&acc)[2][2][4][2], const Unit& u, int wr, int wc, int fr, int fq) const {
        const int row0 = u.pm * BM + wr * 64 + fr, col0 = u.pn * BM + wc * 32 + 8 * fq;
        float sq[2][4];
#pragma unroll
        for (int ai = 0; ai < 2; ++ai)
#pragma unroll
            for (int m = 0; m < 4; ++m) sq[ai][m] = ssq[row0 + ai * HALF + m * 16];
        u32x4 xv[4][2], pv[4][2];
#define EPIPLE_LOAD(ai_) _Pragma("unroll") for (int m = 0; m < 4; ++m) { _Pragma("unroll") for (int bj = 0; bj < 2; ++bj) { const size_t o = (size_t)(row0 + (ai_) * HALF + m * 16) * ld + col0 + bj * HALF; xv[m][bj] = EPI_LD16(X + o); pv[m][bj] = EPI_LD16(P + o); } }
        EPIPLE_LOAD(0)
        asm volatile("" ::: "memory");
#pragma unroll
        for (int ai = 0; ai < 2; ++ai) {
            f32x4 r[4][2][2];
#pragma unroll
            for (int m = 0; m < 4; ++m) { const float rs = __builtin_amdgcn_rsqf(sq[ai][m] * (1.0f / 2048.0f) + 1e-6f);
#pragma unroll
                for (int bj = 0; bj < 2; ++bj) { f32x4 x0, x1, p0, p1; unpack8(xv[m][bj], x0, x1); unpack8(pv[m][bj], p0, p1);
#pragma unroll
                    for (int j = 0; j < 4; ++j) { r[m][bj][0][j] = x0[j] + sig_(rs * acc[ai][bj][m][0][j]) * p0[j]; r[m][bj][1][j] = x1[j] + sig_(rs * acc[ai][bj][m][1][j]) * p1[j]; } } }
            if (ai == 0) { asm volatile("" ::: "memory"); EPIPLE_LOAD(1) }
            asm volatile("" ::: "memory");
#pragma unroll
            for (int m = 0; m < 4; ++m)
#pragma unroll
                for (int bj = 0; bj < 2; ++bj) {
#if PLE_SWAP
                    f32x4 qa, qb;
#pragma unroll
                    for (int j = 0; j < 4; ++j) { const auto sw = __builtin_amdgcn_permlane32_swap(__float_as_uint(r[m][bj][0][j]), __float_as_uint(r[m][bj][1][j]), false, false); qa[j] = __uint_as_float(sw[0]); qb[j] = __uint_as_float(sw[1]); }
                    const size_t ob = (size_t)(row0 + ai * HALF + m * 16) * ld + (col0 - 8 * fq) + bj * HALF + (fq & 1) * 8 + (fq >> 1) * 4;
                    EPIPLE_ST(out + ob, qa); EPIPLE_ST(out + ob + 16, qb);
#else
                    const size_t o = (size_t)(row0 + ai * HALF + m * 16) * ld + col0 + bj * HALF; EPIPLE_ST(out + o, r[m][bj][0]); EPIPLE_ST(out + o + 4, r[m][bj][1]);
#endif
                }
            asm volatile("" ::: "memory"); }
#undef EPIPLE_LOAD
    }
};
template <class Epi, class Sched, bool ALIGN_EPI = false, bool SP2 = false, int KREP = 1, int EREP = 1>
__device__ __forceinline__ void gemm_phase(PG8_LAS unsigned char* lds, const Gemm g, const Sched& S, const Epi& E) {
    const int tid = threadIdx.x, wid = __builtin_amdgcn_readfirstlane(tid >> 6), lane = tid & 63, wr = wid >> 2, wc = wid & 3, fr = lane & 15, fq = lane >> 4;
    const int K = g.K, nt = K / BK;
    unsigned voffA[2], voffB[2];
#pragma unroll
    for (int i = 0; i < 2; ++i) { int R, C; stage_rc(tid * 16 + i * 8192, R, C); const int Rb = Epi::PERM ? ((R & ~31) + perm32(R & 31)) : R;
        voffA[i] = (unsigned)(R * K + C) * 2u; voffB[i] = (unsigned)(Rb * K + C) * 2u; }
    const size_t kstep = (size_t)(BK * 2);
    const size_t hstep = (size_t)HALF * K * 2;
    const size_t tstep = 2 * hstep;
    const unsigned ldsw = (unsigned)wid * 1024u;
    const int aoff = lds_byte(wr * 64 + fr, fq * 8), boff = lds_byte(wc * 32 + fr, fq * 8);
#define PG8_SA(b, h) (((b) * 2 + (h)) * HTB)
#define PG8_SB(b, h) ((4 + (b) * 2 + (h)) * HTB)
#define PG8_STAGE(bufoff, gbase, voff) do { _Pragma("unroll") for (int _i = 0; _i < 2; ++_i) \
        __builtin_amdgcn_global_load_lds((const unsigned*)((const char*)(gbase) + (voff)[_i]), (PG8_LAS unsigned*)(lds + (bufoff) + ldsw + _i * 8192), 16, 0, 0); } while (0)
#define PG8_LDA(dst, b, h) do { _Pragma("unroll") for (int m = 0; m < 4; ++m) _Pragma("unroll") for (int k = 0; k < 2; ++k) dst[m][k] = *(const PG8_LAS bf16x8*)(lds + PG8_SA(b, h) + aoff + m * 2048 + k * 1024); } while (0)
#define PG8_LDB(dst, b, h) do { _Pragma("unroll") for (int n = 0; n < 2; ++n) _Pragma("unroll") for (int k = 0; k < 2; ++k) dst[n][k] = *(const PG8_LAS bf16x8*)(lds + PG8_SB(b, h) + boff + n * 2048 + k * 1024); } while (0)
#define PG8_MMA(ai, bj, At, Bt) do { __builtin_amdgcn_s_setprio(1); _Pragma("unroll") for (int m = 0; m < 4; ++m) _Pragma("unroll") for (int n = 0; n < 2; ++n) _Pragma("unroll") for (int k = 0; k < 2; ++k) \
        acc[ai][bj][m][n] = __builtin_amdgcn_mfma_f32_16x16x32_bf16(Bt[n][k], At[m][k], acc[ai][bj][m][n], 0, 0, 0); __builtin_amdgcn_s_setprio(0); } while (0)
#define PG8_WAIT_V(n) asm volatile("s_waitcnt vmcnt(" #n ")" ::: "memory")
#define PG8_WAIT_L(n) asm volatile("s_waitcnt lgkmcnt(" #n ")" ::: "memory")
#define PG8_BAR __builtin_amdgcn_s_barrier()
#define PG8_SCHED __builtin_amdgcn_sched_barrier(0)
    Unit cur, nxt; int ui = 0;
    if (!S.next(0, cur)) return;
    f32x4 acc[2][2][4][2];
#pragma unroll
    for (int a = 0; a < 2; ++a)
#pragma unroll
        for (int b = 0; b < 2; ++b)
#pragma unroll
            for (int m = 0; m < 4; ++m)
#pragma unroll
                for (int n = 0; n < 2; ++n) acc[a][b][m][n] = (f32x4){0.f, 0.f, 0.f, 0.f};
    bf16x8 At[4][2], B0[2][2], B1[2][2];
    const char* cA = (const char*)g.A + (size_t)cur.pm * tstep; const char* cB = (const char*)g.Bt + (size_t)cur.pn * tstep;
    S.a_ready(cur);
    if constexpr (Epi::PREFETCH) E.prefetch(lds, cur, 0, wid, lane);
    if constexpr (SP2) {
        PG8_STAGE(PG8_SB(0, 0), cB, voffB); PG8_STAGE(PG8_SB(0, 1), cB + hstep, voffB); PG8_STAGE(PG8_SA(0, 0), cA, voffA); PG8_STAGE(PG8_SA(0, 1), cA + hstep, voffA);
        if (wr == 1) PG8_BAR;
        PG8_WAIT_V(2); PG8_BAR;
        PG8_STAGE(PG8_SB(1, 0), cB + kstep, voffB); PG8_STAGE(PG8_SA(1, 0), cA + kstep, voffA); PG8_STAGE(PG8_SB(1, 1), cB + hstep + kstep, voffB);
        PG8_WAIT_V(6); PG8_BAR;
    } else {
        PG8_STAGE(PG8_SB(0, 0), cB, voffB); PG8_STAGE(PG8_SA(0, 0), cA, voffA); PG8_STAGE(PG8_SB(0, 1), cB + hstep, voffB); PG8_STAGE(PG8_SA(0, 1), cA + hstep, voffA);
        if (wr == 1) PG8_BAR;
        PG8_WAIT_V(4); PG8_BAR;
        PG8_STAGE(PG8_SB(1, 0), cB + kstep, voffB); PG8_STAGE(PG8_SA(1, 0), cA + kstep, voffA); PG8_STAGE(PG8_SB(1, 1), cB + hstep + kstep, voffB);
        PG8_WAIT_V(6); PG8_BAR;
    }
    for (;;) {
        const bool has_next = S.next(ui + 1, nxt);
        const char* nA = has_next ? (const char*)g.A + (size_t)nxt.pm * tstep : cA; const char* nB = has_next ? (const char*)g.Bt + (size_t)nxt.pn * tstep : cB;
#ifndef KLOOP_ALIGN
#define KLOOP_ALIGN 8
#endif
        if (KLOOP_ALIGN) asm volatile(".p2align %0" :: "n"(KLOOP_ALIGN));
        for (int pass = 0; pass < KREP; ++pass)
        for (int t = 0; t < nt; t += 2) {
            const bool lastpass = (pass == KREP - 1);
            const bool last = (t == nt - 2);
            const char* a1 = cA + (size_t)(t + 1) * kstep;
            const char* a2 = last ? (lastpass ? nA : cA) : cA + (size_t)(t + 2) * kstep; const char* b2 = last ? (lastpass ? nB : cB) : cB + (size_t)(t + 2) * kstep;
            const char* a3 = a2 + kstep; const char* b3 = b2 + kstep;
            if (last && has_next && lastpass) { S.a_ready(nxt); if constexpr (Epi::PREFETCH) E.prefetch(lds, nxt, (ui + 1) & 1, wid, lane); }
            if constexpr (SP2) {
            PG8_LDB(B0, 0, 0); PG8_LDB(B1, 0, 1); PG8_SCHED; PG8_LDA(At, 0, 0); PG8_STAGE(PG8_SA(1, 1), a1 + hstep, voffA);
            PG8_WAIT_V(8); PG8_WAIT_L(0); PG8_BAR; PG8_MMA(0, 0, At, B0); PG8_MMA(0, 1, At, B1); PG8_BAR; PG8_SCHED;
            PG8_LDA(At, 0, 1); PG8_STAGE(PG8_SB(0, 0), b2, voffB); PG8_STAGE(PG8_SB(0, 1), b2 + hstep, voffB); PG8_STAGE(PG8_SA(0, 0), a2, voffA);
            PG8_WAIT_V(8); PG8_WAIT_L(0); PG8_BAR; PG8_MMA(1, 0, At, B0); PG8_MMA(1, 1, At, B1); PG8_BAR; PG8_SCHED;
            PG8_LDB(B0, 1, 0); PG8_LDB(B1, 1, 1); PG8_SCHED; PG8_LDA(At, 1, 0); PG8_STAGE(PG8_SA(0, 1), a2 + hstep, voffA);
            PG8_WAIT_V(8); PG8_WAIT_L(0); PG8_BAR; PG8_MMA(0, 0, At, B0); PG8_MMA(0, 1, At, B1); PG8_BAR; PG8_SCHED;
            PG8_LDA(At, 1, 1); PG8_STAGE(PG8_SB(1, 0), b3, voffB); PG8_STAGE(PG8_SB(1, 1), b3 + hstep, voffB); PG8_STAGE(PG8_SA(1, 0), a3, voffA);
            PG8_WAIT_V(8); PG8_WAIT_L(0); PG8_BAR; PG8_MMA(1, 0, At, B0); PG8_MMA(1, 1, At, B1); PG8_BAR; PG8_SCHED;
            } else {
            PG8_LDB(B0, 0, 0); PG8_SCHED; PG8_LDA(At, 0, 0); PG8_STAGE(PG8_SA(1, 1), a1 + hstep, voffA);
            PG8_WAIT_L(8); PG8_BAR; PG8_WAIT_L(0); PG8_MMA(0, 0, At, B0); PG8_BAR; PG8_SCHED;
            PG8_LDB(B1, 0, 1); PG8_STAGE(PG8_SB(0, 0), b2, voffB);
            PG8_BAR; PG8_WAIT_L(0); PG8_MMA(0, 1, At, B1); PG8_BAR;
            PG8_LDA(At, 0, 1); PG8_STAGE(PG8_SA(0, 0), a2, voffA);
            PG8_BAR; PG8_WAIT_L(0); PG8_MMA(1, 0, At, B0); PG8_BAR; PG8_SCHED;
            PG8_STAGE(PG8_SB(0, 1), b2 + hstep, voffB);
            PG8_WAIT_V(6); PG8_BAR; PG8_MMA(1, 1, At, B1); PG8_BAR;
            PG8_LDB(B0, 1, 0); PG8_SCHED; PG8_LDA(At, 1, 0); PG8_STAGE(PG8_SA(0, 1), a2 + hstep, voffA);
            PG8_WAIT_L(8); PG8_BAR; PG8_WAIT_L(0); PG8_MMA(0, 0, At, B0); PG8_BAR; PG8_SCHED;
            PG8_LDB(B1, 1, 1); PG8_STAGE(PG8_SB(1, 0), b3, voffB);
            PG8_BAR; PG8_WAIT_L(0); PG8_MMA(0, 1, At, B1); PG8_BAR;
            PG8_LDA(At, 1, 1); PG8_STAGE(PG8_SA(1, 0), a3, voffA);
            PG8_BAR; PG8_WAIT_L(0); PG8_MMA(1, 0, At, B0); PG8_BAR; PG8_SCHED;
            PG8_STAGE(PG8_SB(1, 1), b3 + hstep, voffB);
            PG8_WAIT_V(6); PG8_BAR; PG8_MMA(1, 1, At, B1); PG8_BAR;
            }
        }
        if constexpr (ALIGN_EPI) { if (wr == 0) PG8_BAR; }
        if constexpr (!Epi::AFTER_DRAIN) { for (int er = 0; er < EREP; ++er) { if constexpr (Epi::PREFETCH) E.run(acc, cur, wr, wc, fr, fq, lds, ui & 1); else E(acc, cur, wr, wc, fr, fq); } S.done(cur); }
        if (!has_next) break;
#pragma unroll
        for (int a = 0; a < 2; ++a)
#pragma unroll
            for (int b = 0; b < 2; ++b)
#pragma unroll
                for (int m = 0; m < 4; ++m)
#pragma unroll
                    for (int n = 0; n < 2; ++n) acc[a][b][m][n] = (f32x4){0.f, 0.f, 0.f, 0.f};
        cur = nxt; cA = nA; cB = nB; ++ui;
        if constexpr (ALIGN_EPI) { if (wr == 1) PG8_BAR; }
    }
    PG8_WAIT_V(0);
    if constexpr (!ALIGN_EPI) { if (wr == 0) PG8_BAR; }
    PG8_BAR;
    if constexpr (Epi::AFTER_DRAIN) { E.fused(acc, cur, wr, wc, fr, fq, lds, wid, lane); S.done(cur); }
#undef PG8_SA
#undef PG8_SB
#undef PG8_STAGE
#undef PG8_LDA
#undef PG8_LDB
#undef PG8_MMA
#undef PG8_WAIT_V
#undef PG8_WAIT_L
#undef PG8_BAR
#undef PG8_SCHED
}
}

#define GAS __attribute__((address_space(1)))
#define RLX_AGENT __ATOMIC_RELAXED, __HIP_MEMORY_SCOPE_AGENT
#define XB_TMO      128
#define XB_XCNT(j)  (256  + 64 * (j))
#define XB_XSUB(j)  (1280 + 64 * (j))
#define XB_XGEN(j)  (2304 + 64 * (j))
#define XB_TOP      3328
#define XB_TOPGEN   3392
#define XCD_BAR_WORDS 3456
#define XB_SPIN_CAP (1u << 18)

__device__ __forceinline__ unsigned xb_ld(unsigned* p)              { return __hip_atomic_load(p, __ATOMIC_RELAXED, __HIP_MEMORY_SCOPE_AGENT); }
__device__ __forceinline__ unsigned xb_add(unsigned* p, unsigned v) { return __hip_atomic_fetch_add(p, v, __ATOMIC_RELAXED, __HIP_MEMORY_SCOPE_AGENT); }
__device__ __forceinline__ unsigned xb_xcc_id() { return (unsigned)__builtin_amdgcn_s_getreg((3 << 11) | 20) & 0xFu; }
#define XB_SPIN(cond, bar) do { unsigned _sp = 0; while (cond) { __builtin_amdgcn_s_sleep(1); \
    if ((++_sp & 255u) == 0u) { if (xb_ld(&(bar)[XB_TMO])) break; if (_sp > XB_SPIN_CAP) { atomicAdd(&(bar)[XB_TMO], 1u); break; } } } } while (0)

struct XcdBarrier {
    unsigned* bar; unsigned x;
    volatile LAS unsigned* st;
};

__device__ __forceinline__ XcdBarrier xcd_barrier_post(unsigned* bar, volatile LAS unsigned* st) {
    XcdBarrier b; b.bar = bar; b.x = xb_xcc_id(); b.st = st;
    if (threadIdx.x == 0) st[2] = xb_add(&bar[XB_XCNT(b.x)], 1u);
    return b;
}
__device__ __forceinline__ void xcd_barrier_complete(unsigned* bar, unsigned x, unsigned& nloc, unsigned& nx, unsigned& slot, unsigned& even) {
    const unsigned G = gridDim.x * gridDim.y * gridDim.z;
    unsigned sum, cnt, mine, sl, ev, sp = 0u;
    for (;;) {
        sum = 0u; cnt = 0u; mine = 0u; sl = 0u; ev = 1u;
#pragma unroll
        for (unsigned j = 0; j < 16; ++j) { const unsigned c = xb_ld(&bar[XB_XCNT(j)]); sum += c; cnt += (c > 0u) ? 1u : 0u; mine = (j == x) ? c : mine; sl += (c > 0u && j < x) ? 1u : 0u; ev = (c > 0u && c != 32u) ? 0u : ev; }
        if (sum == G) break;
        __builtin_amdgcn_s_sleep(1);
        if ((++sp & 255u) == 0u) { if (xb_ld(&bar[XB_TMO])) break; if (sp > XB_SPIN_CAP) { atomicAdd(&bar[XB_TMO], 1u); break; } }
    }
    nloc = mine > 0u ? mine : 1u; nx = cnt > 0u ? cnt : 1u; slot = sl; even = (sum == G) ? ev : 0u;
}

#ifndef XB_EARLY_ACQ
#define XB_EARLY_ACQ 1
#endif
#ifndef XB_ACQ_FIRST
#define XB_ACQ_FIRST 1
#endif
__device__ __forceinline__ void xcd_barrier(const XcdBarrier& b) {
    asm volatile("s_waitcnt vmcnt(0)" ::: "memory");
    __syncthreads();
    if (threadIdx.x == 0) {
        unsigned* bar = b.bar;
        __builtin_amdgcn_s_waitcnt(0);
        if (XB_EARLY_ACQ && XB_ACQ_FIRST) __builtin_amdgcn_fence(__ATOMIC_ACQUIRE, "agent");
        unsigned nloc = b.st[0], nx = b.st[1];
        const unsigned old = xb_add(&bar[XB_XSUB(b.x)], 1u);
        if (nloc == 0u) { unsigned slot_, even_; xcd_barrier_complete(bar, b.x, nloc, nx, slot_, even_); b.st[0] = nloc; b.st[1] = nx; b.st[3] = slot_; b.st[4] = (even_ && nx == 8u && b.st[2] < 32u) ? 1u : 0u; }
        const unsigned gen = old / nloc;
        if (old + 1u == (gen + 1u) * nloc) {
            __builtin_amdgcn_fence(__ATOMIC_RELEASE, "agent");
            asm volatile("s_waitcnt vmcnt(0)" ::: "memory");
#ifndef XB_EARLY_ACQ
#define XB_EARLY_ACQ 1
#endif
            if (XB_EARLY_ACQ && !XB_ACQ_FIRST) __builtin_amdgcn_fence(__ATOMIC_ACQUIRE, "agent");
            const unsigned og = xb_add(&bar[XB_TOP], 1u);
            const unsigned tg = og / nx;
            if (og + 1u == (tg + 1u) * nx) xb_add(&bar[XB_TOPGEN], 1u);
            else XB_SPIN(xb_ld(&bar[XB_TOPGEN]) == tg, bar);
            if (!XB_EARLY_ACQ) __builtin_amdgcn_fence(__ATOMIC_ACQUIRE, "agent");
            xb_add(&bar[XB_XGEN(b.x)], 1u);
            asm volatile("s_waitcnt vmcnt(0)" ::: "memory");
        } else {
#ifndef XB_POLL_TOP
#define XB_POLL_TOP 1
#endif
            if (XB_EARLY_ACQ && !XB_ACQ_FIRST) __builtin_amdgcn_fence(__ATOMIC_ACQUIRE, "agent");
            if (XB_POLL_TOP) XB_SPIN(xb_ld(&bar[XB_TOPGEN]) == gen, bar); else
            XB_SPIN(xb_ld(&bar[XB_XGEN(b.x)]) == gen, bar);
            if (!XB_EARLY_ACQ) __builtin_amdgcn_fence(__ATOMIC_ACQUIRE, "agent");
            asm volatile("s_waitcnt vmcnt(0)" ::: "memory");
        }
    }
    __syncthreads();
}


__device__ __forceinline__ void xcd_local_barrier(unsigned* bar2, unsigned x, unsigned nloc) {
    asm volatile("s_waitcnt vmcnt(0)" ::: "memory");
    __syncthreads();
    if (threadIdx.x == 0) {
        __builtin_amdgcn_s_waitcnt(0);
        if (XB_EARLY_ACQ && XB_ACQ_FIRST) __builtin_amdgcn_fence(__ATOMIC_ACQUIRE, "agent");
        const unsigned old = xb_add(&bar2[XB_XSUB(x)], 1u);
        const unsigned gen = old / nloc;
        if (XB_EARLY_ACQ && !XB_ACQ_FIRST) __builtin_amdgcn_fence(__ATOMIC_ACQUIRE, "agent");
        if (old + 1u == (gen + 1u) * nloc) xb_add(&bar2[XB_XGEN(x)], 1u);
        else XB_SPIN(xb_ld(&bar2[XB_XGEN(x)]) == gen, bar2);
        if (!XB_EARLY_ACQ) __builtin_amdgcn_fence(__ATOMIC_ACQUIRE, "agent");
        asm volatile("s_waitcnt vmcnt(0)" ::: "memory");
    }
    __syncthreads();
}

#ifndef ONLYP
#define ONLYP -1
#endif
constexpr int ONLY = ONLYP;
#define PHON(k) (ONLY < 0 || ONLY == (k))
#ifndef P7_ALIGN
#define P7_ALIGN true
#endif
#ifndef P7_SP2
#define P7_SP2 true
#endif
#ifndef P7_KREP
#define P7_KREP 1
#endif
#ifndef P7_EREP
#define P7_EREP 1
#endif
#ifndef P1_LOCAL
#define P1_LOCAL 1
#endif
#ifndef P1_KREP
#define P1_KREP 1
#endif
#ifndef P1_EREP
#define P1_EREP 1
#endif
#ifndef P9_EREP
#define P9_EREP 1
#endif
#ifndef P5_EREP
#define P5_EREP 1
#endif
#ifndef USE_CG_SYNC
#define USE_CG_SYNC 0
#endif
#ifndef LATE_CONV
#define LATE_CONV 1
#endif
#ifndef LC_P2
#define LC_P2 0
#endif
#ifndef LC_P4
#define LC_P4 0
#endif
#ifndef LC_WAO_TAIL
#define LC_WAO_TAIL 1
#endif
#ifndef LC_P7TAIL
#define LC_P7TAIL 1
#endif
#ifndef LC_P1TAIL
#define LC_P1TAIL 1
#endif
#ifndef TAIL_EXTRA
#define TAIL_EXTRA 0
#endif
#ifndef P2_SWAP
#define P2_SWAP 1
#endif
#ifndef DUPMASK
#define DUPMASK 0
#endif
#define NREP(k) (((DUPMASK >> (k)) & 1) + 1)
constexpr size_t SM_DUMMY = 2 * MiB;
constexpr int NWAVES = 8, NTHREADS = NWAVES * 64;
constexpr int RING_BYTES = 131072, XCH_OFF = RING_BYTES, XCH_BYTES = 8192, MISC_OFF = XCH_OFF + XCH_BYTES, LDS_BYTES = 147456;
static_assert(MISC_OFF + 64 <= LDS_BYTES, "LDS map");
constexpr size_t SM_CTL = 3 * MiB, CTL_BYTES = 65536;
constexpr int VST_PITCH = 320, VST_BYTES = 32 * VST_PITCH;
static_assert(NWAVES * VST_BYTES <= RING_BYTES, "attention scratch");

enum { F_P0 = 1, F_G1 = 2, F_CONV = 4, F_ATTN = 8, F_RNN = 16, F_YA = 32, F_YR = 64, F_WO = 128, F_FFU = 256, F_FFD = 512, F_PLE = 1024, F_ALL = 2047 };

struct Args {
    const float *x, *p, *g_mix, *w_in, *conv_w, *conv_b, *w_rg_a, *b_rg_a, *w_rg_x, *b_rg_x, *lam, *q_gain, *k_gain, *w_rnn_out, *w_attn_out, *w_o, *g_ffn, *w_gu, *w_dn, *g_ple, *w_pg, *w_pp;
    float* out; unsigned char* ws; int ph_lo, ph_hi, mask, pad;
};

__device__ __forceinline__ int crow(int reg, int h) { return (reg & 3) + 8 * (reg >> 2) + 4 * h; }
#define MFMA32(a, b, c) __builtin_amdgcn_mfma_f32_32x32x16_bf16((a), (b), (c), 0, 0, 0)
__device__ __forceinline__ unsigned pk2(float lo, float hi) { unsigned r; asm("v_cvt_pk_bf16_f32 %0, %1, %2" : "=v"(r) : "v"(lo), "v"(hi)); return r; }
__device__ __forceinline__ unsigned short f2bf_hw(float f) { return (unsigned short)pk2(f, f); }

constexpr int CI_W1 = (DM / 64) * (DIN / 64), CI_WAO = (DM / 64) * (DM / 64), CI_WRO = (DR / 64) * (DM / 64), CI_WO = CI_WAO, CI_WGU = (DM / 64) * (2 * DFF / 64), CI_WDN = (DFF / 64) * (DM / 64), CI_WPG = CI_WAO, CI_WPP = (PLE / 64) * (DM / 64);
constexpr int CI_P0 = 0, CI_P2 = CI_P0 + CI_W1 + CI_WAO, CI_P3 = CI_P2 + CI_WRO + CI_WO, CI_P4 = CI_P3 + CI_WGU, CI_END = CI_P4 + CI_WDN + CI_WPG + CI_WPP;
struct CvtItem { const float* wp; const float* ks; bf16_t* out; int ldw, Kdim; };
__device__ __forceinline__ CvtItem cvt_decode(const Args& a, int it, int lane) {
    unsigned char* ws = a.ws; int r = it; const float* W; const float* ks = nullptr; bf16_t* WT; int ldw, Kdim, nb; bool gu = false;
    if (r < CI_W1) { W = a.w_in; ldw = DIN; Kdim = DM; WT = (bf16_t*)(ws + WS_W1); nb = DIN / 64; }
    else if ((r -= CI_W1) < CI_WAO) { W = a.w_attn_out; ldw = DM; Kdim = DM; WT = (bf16_t*)(ws + WS_WAO); nb = DM / 64; }
    else if ((r -= CI_WAO) < CI_WRO) { W = a.w_rnn_out; ldw = DM; Kdim = DR; WT = (bf16_t*)(ws + WS_WRO); nb = DM / 64; }
    else if ((r -= CI_WRO) < CI_WO) { W = a.w_o; ldw = DM; Kdim = DM; WT = (bf16_t*)(ws + WS_WO); nb = DM / 64; }
    else if ((r -= CI_WO) < CI_WGU) { W = a.w_gu; ldw = 2 * DFF; Kdim = DM; WT = (bf16_t*)(ws + WS_WGU); nb = 2 * DFF / 64; ks = a.g_ffn; gu = true; }
    else if ((r -= CI_WGU) < CI_WDN) { W = a.w_dn; ldw = DM; Kdim = DFF; WT = (bf16_t*)(ws + WS_WDN); nb = DM / 64; }
    else if ((r -= CI_WDN) < CI_WPG) { W = a.w_pg; ldw = DM; Kdim = DM; WT = (bf16_t*)(ws + WS_WPG); nb = DM / 64; ks = a.g_ple; }
    else { r -= CI_WPG; W = a.w_pp; ldw = DM; Kdim = PLE; WT = (bf16_t*)(ws + WS_WPP); nb = DM / 64; }
#ifndef CVT_NMAJOR
#define CVT_NMAJOR 0
#endif
    const int kbn = Kdim / 64;
    const int k0 = CVT_NMAJOR ? 64 * (r % kbn) : 64 * (r / nb), n0 = CVT_NMAJOR ? 64 * (r / kbn) : 64 * (r % nb);
    int orow = n0;
    if (gu) { const int isu = n0 >= DFF ? 1 : 0; const int j0 = n0 - isu * DFF; orow = (j0 >> 7) * 256 + isu * 128 + (j0 & 127); }
    CvtItem d; d.wp = W + (size_t)k0 * ldw + n0 + lane; d.ks = ks ? ks + k0 : nullptr; d.out = WT + (size_t)orow * Kdim + k0; d.ldw = ldw; d.Kdim = Kdim; return d;
}
__device__ __forceinline__ void cvt_load(const CvtItem& d, float (&v)[64]) {
#pragma unroll
    for (int i = 0; i < 64; ++i) v[i] = __builtin_nontemporal_load(d.wp + (size_t)i * d.ldw);
}
__device__ __forceinline__ void cvt_finish(const CvtItem& d, float (&v)[64], LAS unsigned* scr, int lane) {
    if (d.ks) {
#pragma unroll
        for (int i = 0; i < 64; ++i) v[i] *= d.ks[i]; }
#pragma unroll
    for (int i = 0; i < 32; ++i) scr[i * 65 + lane] = pk2(v[2 * i], v[2 * i + 1]);
    asm volatile("s_waitcnt lgkmcnt(0)" ::: "memory");
    const int c = lane & 7;
#pragma unroll
    for (int j = 0; j < 8; ++j) { const int nn = (lane >> 3) + 8 * j; const LAS unsigned* s = scr + (4 * c) * 65 + nn;
        u32x4 o; o.x = s[0]; o.y = s[65]; o.z = s[130]; o.w = s[195];
        st16_wt(d.out + (size_t)nn * d.Kdim + 8 * c, o); }
    asm volatile("s_waitcnt lgkmcnt(0)" ::: "memory");
}
__device__ __forceinline__ void convert_range(const Args& a, LAS unsigned char* wl, int lane, int lo, int hi, int gw, int ngw) {
    LAS unsigned* scr = (LAS unsigned*)wl;
    int it = lo + gw; if (it >= hi) return;
    float va[64], vb[64];
    CvtItem da = cvt_decode(a, it, lane), db = da; cvt_load(da, va);
    for (;;) {
        it += ngw; const bool hb_ = it < hi; if (hb_) { db = cvt_decode(a, it, lane); cvt_load(db, vb); }
        cvt_finish(da, va, scr, lane); if (!hb_) break;
        it += ngw; const bool ha_ = it < hi; if (ha_) { da = cvt_decode(a, it, lane); cvt_load(da, va); }
        cvt_finish(db, vb, scr, lane); if (!ha_) break;
    }
}
#ifndef LC_SMALL_TAIL
#define LC_SMALL_TAIL 0
#endif
__device__ __forceinline__ void p0_small(const Args& a, int gtid, int ngt, bool do_pb, bool do_rg) {
    unsigned char* ws = a.ws;
    if (do_pb) { const f32x4* pp = (const f32x4*)a.p; u32x2* po = (u32x2*)(ws + WS_PB);
      for (int i = gtid; i < M * PLE / 4; i += ngt) { const f32x4 v = __builtin_nontemporal_load(pp + i); u32x2 w; w.x = pk2(v[0], v[1]); w.y = pk2(v[2], v[3]); po[i] = w; } }
    if (do_rg) { bf16_t* wra = (bf16_t*)(ws + WS_WRA); bf16_t* wrx = (bf16_t*)(ws + WS_WRX);
      for (int i = gtid; i < NRB * RB * RBP; i += ngt) { const int c = i % RBP, d = (i / RBP) % RB, n = i / (RBP * RB);
          const size_t src = ((size_t)n * RB + (c < RB ? c : 0)) * RB + d;
          wra[i] = c < RB ? f2bf_hw(a.w_rg_a[src] * -LOG2E) : (bf16_t)0; wrx[i] = c < RB ? f2bf_hw(a.w_rg_x[src] * -LOG2E) : (bf16_t)0; } }
}
__device__ __forceinline__ void p0_prologue(const Args& a, LAS unsigned char* lds, int gw, int ngw, int lane, int gtid, int ngt) {
    unsigned char* ws = a.ws;
    p0_small(a, gtid, ngt, !(LC_SMALL_TAIL && gridDim.x == 256), true);
    { float* z = (float*)(ws + WS_SMALL); for (int i = gtid; i < 2 * M; i += ngt) z[i] = 0.f; }
    if (LATE_CONV && !LC_P4 && !(LC_SMALL_TAIL && LC_P7TAIL && gridDim.x == 256)) {
        if (LC_P7TAIL && gridDim.x == 256) { if (gw >= ngw - CI_WPP) convert_range(a, lds + (threadIdx.x >> 6) * 16384, lane, CI_P4 + CI_WDN + CI_WPG, CI_END, gw - (ngw - CI_WPP), ngw); }
        else convert_range(a, lds + (threadIdx.x >> 6) * 16384, lane, CI_P4, CI_END, gw, ngw); }
    convert_range(a, lds + (threadIdx.x >> 6) * 16384, lane, CI_P0, LATE_CONV ? ((LC_WAO_TAIL && gridDim.x == 256) ? CI_W1 : CI_P2) : CI_END, gw, ngw);
    bf16_t* hb = (bf16_t*)(ws + WS_HB);
    for (int m = gw; m < M; m += ngw) {
        const f32x4* xr = (const f32x4*)(a.x + (size_t)m * DM) + lane; const f32x4* gr = (const f32x4*)a.g_mix + lane;
        f32x4 v[8]; float s = 0.f;
#pragma unroll
        for (int j = 0; j < 8; ++j) { v[j] = __builtin_nontemporal_load(xr + 64 * j); s += (v[j][0] * v[j][0] + v[j][1] * v[j][1]) + (v[j][2] * v[j][2] + v[j][3] * v[j][3]); }
        const float rs = 1.0f / sqrtf(wave_sum(s) * (1.0f / DM) + EPS);
        u32x2* o8 = (u32x2*)(hb + (size_t)m * DM) + lane;
#pragma unroll
        for (int j = 0; j < 8; ++j) { const f32x4 g = gr[64 * j]; u32x2 w; w.x = pk2(v[j][0] * rs * g[0], v[j][1] * rs * g[1]); w.y = pk2(v[j][2] * rs * g[2], v[j][3] * rs * g[3]); o8[64 * j] = w; }
    }
}

__device__ __forceinline__ void conv_item(const Args& a, int it);
__device__ __forceinline__ void conv_phase(const Args& a, int gtid, int ngt) {
    const bf16_t* xr = (const bf16_t*)(a.ws + WS_XR); bf16_t* xc = (bf16_t*)(a.ws + WS_XC);
    constexpr int NCG = DR / 8;
    for (int it = gtid; it < (M / 8) * NCG; it += ngt) conv_item(a, it);
}
__device__ __forceinline__ void conv_item(const Args& a, int it) {
    const bf16_t* xr = (const bf16_t*)(a.ws + WS_XR); bf16_t* xc = (bf16_t*)(a.ws + WS_XC);
    constexpr int NCG = DR / 8;
    {
        const int cg = it % NCG, rg = it / NCG, c0 = cg * 8, m0 = rg * 8;
        f32x4 w[4][2]; f32x4 bb[2];
#pragma unroll
        for (int j = 0; j < 4; ++j) { w[j][0] = *(const f32x4*)(a.conv_w + (size_t)j * DR + c0); w[j][1] = *(const f32x4*)(a.conv_w + (size_t)j * DR + c0 + 4); }
        bb[0] = *(const f32x4*)(a.conv_b + c0); bb[1] = *(const f32x4*)(a.conv_b + c0 + 4);
        f32x4 win[3][2];
        const bool first = (m0 & (SEQ - 1)) == 0;
#pragma unroll
        for (int j = 0; j < 3; ++j) {
            if (first) { win[j][0] = (f32x4){0.f, 0.f, 0.f, 0.f}; win[j][1] = win[j][0]; }
            else { const u32x4 t = *(const u32x4*)(xr + (size_t)(m0 - 3 + j) * DR + c0); win[j][0] = (f32x4){pg8::bflo(t.x), pg8::bfhi(t.x), pg8::bflo(t.y), pg8::bfhi(t.y)}; win[j][1] = (f32x4){pg8::bflo(t.z), pg8::bfhi(t.z), pg8::bflo(t.w), pg8::bfhi(t.w)}; } }
#pragma unroll
        for (int i = 0; i < 8; ++i) {
            const u32x4 t = *(const u32x4*)(xr + (size_t)(m0 + i) * DR + c0);
            const f32x4 c0v = (f32x4){pg8::bflo(t.x), pg8::bfhi(t.x), pg8::bflo(t.y), pg8::bfhi(t.y)}, c1v = (f32x4){pg8::bflo(t.z), pg8::bfhi(t.z), pg8::bflo(t.w), pg8::bfhi(t.w)};
            const f32x4 y0 = bb[0] + w[0][0] * win[0][0] + w[1][0] * win[1][0] + w[2][0] * win[2][0] + w[3][0] * c0v;
            const f32x4 y1 = bb[1] + w[0][1] * win[0][1] + w[1][1] * win[1][1] + w[2][1] * win[2][1] + w[3][1] * c1v;
            st16_wt(xc + (size_t)(m0 + i) * DR + c0, pg8::pack8(y0, y1));
            win[0][0] = win[1][0]; win[0][1] = win[1][1]; win[1][0] = win[2][0]; win[1][1] = win[2][1]; win[2][0] = c0v; win[2][1] = c1v;
        }
    }
}

typedef short v4i16_t __attribute__((ext_vector_type(4)));
__device__ __forceinline__ s16x4 vtr(const LAS unsigned char* p) { return __builtin_bit_cast(s16x4, __builtin_amdgcn_ds_read_tr16_b64_v4i16((LAS v4i16_t*)p)); }
__device__ __forceinline__ void attn_unit(int b, int hh, int qb, const bf16_t* __restrict__ qn, const bf16_t* __restrict__ kn, const bf16_t* __restrict__ vv, bf16_t* __restrict__ ob, LAS unsigned char* wl, int lane) {
    LAS unsigned char* wk_ = wl; LAS unsigned char* wv_ = wl + 8192;
    const int r = lane & 31, h = lane >> 5;
    const size_t rowb = (size_t)b * SEQ;
    const int q0 = qb * 32;
#define AT_GLDS(src, dst) __builtin_amdgcn_global_load_lds((const unsigned*)(src), (LAS unsigned*)(dst), 16, 0, 0)
    unsigned koff[8], voff[8];
#pragma unroll
    for (int j = 0; j < 8; ++j) { const int row = (lane >> 4) + 4 * j; koff[j] = (unsigned)(row * DM + (((lane & 15) ^ (row & 15)) * 8)) * 2u; voff[j] = (unsigned)(row * DM + (((lane & 15) ^ (4 * ((lane >> 4) & 3))) * 8)) * 2u; }
    const char* kbase0 = (const char*)(kn + rowb * DM + hh * HD); const char* vbase0 = (const char*)(vv + rowb * DM + hh * HD);
#define AT_ISSUE_K(kb_) do { const char* kp_ = kbase0 + (size_t)(kb_) * (32 * DM * 2); \
        _Pragma("unroll") for (int j = 0; j < 8; ++j) AT_GLDS(kp_ + koff[j], wk_ + j * 1024); } while (0)
#define AT_ISSUE_V(kb_) do { const char* vp_ = vbase0 + (size_t)(kb_) * (32 * DM * 2); \
        _Pragma("unroll") for (int j = 0; j < 8; ++j) AT_GLDS(vp_ + voff[j], wv_ + j * 1024); } while (0)
    bf16x8 qf[8];
    { const bf16_t* qp = qn + (rowb + q0 + r) * DM + hh * HD + 8 * h;
#pragma unroll
      for (int ks = 0; ks < 8; ++ks) qf[ks] = *(const bf16x8*)(qp + 16 * ks); }
    AT_ISSUE_K(qb); AT_ISSUE_V(qb);
    f32x16 o[4];
#pragma unroll
    for (int d = 0; d < 4; ++d)
#pragma unroll
        for (int i = 0; i < 16; ++i) o[d][i] = 0.f;
    float Rp = 1.0f;
    const int i16 = lane & 15, tq = i16 >> 2, tp = i16 & 3, blk = (lane >> 4) & 1;
    const LAS unsigned char* trb = wv_ + (4 * h + tq) * 256 + 32 * blk + 8 * tp;
    const LAS unsigned char* krb = wk_ + r * 256;
#define AT_BLOCK(DIAG_) do { \
        if (kb > 0) asm volatile("s_waitcnt vmcnt(8)" ::: "memory"); else asm volatile("s_waitcnt vmcnt(0)" ::: "memory"); \
        bf16x8 kf[8]; \
_Pragma("unroll") \
        for (int ks = 0; ks < 8; ++ks) kf[ks] = *(const LAS bf16x8*)(krb + (((2 * ks + h) ^ (r & 15)) * 16)); \
        asm volatile("s_waitcnt lgkmcnt(0)" ::: "memory"); \
        __builtin_amdgcn_sched_barrier(0); \
        if (kb > 0) AT_ISSUE_K(kb - 1); \
        __builtin_amdgcn_sched_barrier(0); \
        f32x16 x; \
_Pragma("unroll") \
        for (int i = 0; i < 16; ++i) x[i] = 0.f; \
_Pragma("unroll") \
        for (int ks = 0; ks < 8; ++ks) x = MFMA32(kf[ks], qf[ks], x); \
 \
 \
        float kp[16], bt[16]; \
_Pragma("unroll") \
        for (int i = 0; i < 16; ++i) { const bool valid = !DIAG_ || crow(i, h) < r; const float e = __builtin_amdgcn_exp2f(x[i]);     const float k_ = __builtin_amdgcn_rcpf(1.0f + e); \
            kp[i] = valid ? k_ : 1.0f; bt[i] = valid ? 1.0f - k_ : 0.0f; }     \
 \
        float E[16], T[4], To[4]; \
_Pragma("unroll") \
        for (int g = 0; g < 4; ++g) { E[4 * g + 3] = 1.0f; E[4 * g + 2] = kp[4 * g + 3]; E[4 * g + 1] = E[4 * g + 2] * kp[4 * g + 2]; E[4 * g] = E[4 * g + 1] * kp[4 * g + 1]; T[g] = E[4 * g] * kp[4 * g]; } \
_Pragma("unroll") \
        for (int g = 0; g < 4; ++g) { const auto rt = __builtin_amdgcn_permlane32_swap(__float_as_uint(T[g]), __float_as_uint(T[g]), false, false); \
            T[g] = __uint_as_float(rt[0]); To[g] = __uint_as_float(rt[1]); } \
        const float U0 = T[0] * To[0], U1 = T[1] * To[1], U2 = T[2] * To[2], U3 = T[3] * To[3]; \
        float C[4]; C[3] = 1.0f; C[2] = U3; C[1] = U3 * U2; C[0] = C[1] * U1; \
        const float tot = C[0] * U0; \
        float w[16]; \
_Pragma("unroll") \
        for (int g = 0; g < 4; ++g) { const float off = C[g] * (h == 0 ? To[g] : 1.0f) * Rp; \
_Pragma("unroll") \
            for (int j = 0; j < 4; ++j) w[4 * g + j] = bt[4 * g + j] * E[4 * g + j] * off; } \
        Rp *= tot; \
        bf16x8 xs[2]; \
_Pragma("unroll") \
        for (int s = 0; s < 2; ++s) { u32x4 pw; pw.x = pk2(w[8 * s], w[8 * s + 1]); pw.y = pk2(w[8 * s + 2], w[8 * s + 3]); pw.z = pk2(w[8 * s + 4], w[8 * s + 5]); pw.w = pk2(w[8 * s + 6], w[8 * s + 7]); xs[s] = __builtin_bit_cast(bf16x8, pw); } \
        if (kb > 0) asm volatile("s_waitcnt vmcnt(8)" ::: "memory"); else asm volatile("s_waitcnt vmcnt(0)" ::: "memory"); \
_Pragma("unroll") \
        for (int db = 0; db < 4; ++db) \
_Pragma("unroll") \
            for (int s = 0; s < 2; ++s) { \
                const s16x4 lo = vtr(trb + (16 * s) * 256 + ((db ^ tq) * 64)), hi = vtr(trb + (16 * s + 8) * 256 + ((db ^ tq) * 64)); \
                const bf16x8 vf = __builtin_shufflevector(lo, hi, 0, 1, 2, 3, 4, 5, 6, 7); \
                o[db] = MFMA32(vf, xs[s], o[db]); \
            } \
        const bool done = __all(Rp < 1.17549435e-38f); \
        asm volatile("s_waitcnt lgkmcnt(0)" ::: "memory"); \
        __builtin_amdgcn_sched_barrier(0); \
        if (kb > 0) AT_ISSUE_V(kb - 1); \
        __builtin_amdgcn_sched_barrier(0); \
        stop_ = done; \
    } while (0)
    bool stop_ = false; int kb = qb;
    AT_BLOCK(true);
    for (kb = qb - 1; kb >= 0 && !stop_; --kb) AT_BLOCK(false);
#undef AT_BLOCK
    asm volatile("s_waitcnt vmcnt(0)" ::: "memory");
    bf16_t* op = ob + (rowb + q0 + r) * DM + hh * HD + 4 * h;
#pragma unroll
    for (int db = 0; db < 4; ++db)
#pragma unroll
        for (int g = 0; g < 4; ++g) { u32x2 wv; wv.x = pk2(o[db][4 * g], o[db][4 * g + 1]); wv.y = pk2(o[db][4 * g + 2], o[db][4 * g + 3]); *(u32x2*)(op + 32 * db + 8 * g) = wv; }
#undef AT_GLDS
#undef AT_ISSUE_K
#undef AT_ISSUE_V
}

template <bool PASSB>
__device__ __forceinline__ void rnn_wave(const Args& a, int lane, LAS unsigned char* wl, int gw, int ngw) {
    const bf16_t* xc = (const bf16_t*)(a.ws + WS_XC); const bf16_t* gg = (const bf16_t*)(a.ws + WS_GG); bf16_t* ar = (bf16_t*)(a.ws + WS_AR);
    const bf16_t* wra = (const bf16_t*)(a.ws + WS_WRA); const bf16_t* wrx = (const bf16_t*)(a.ws + WS_WRX); float* summ = (float*)(a.ws + WS_SMALL + SM_SUMM);
    const int r = lane & 31, h = lane >> 5;
    constexpr int XP = 352, NUNITS = NBATCH * NRB * 6 * NCHUNK;
    LAS unsigned char* wt_ = wl; LAS unsigned char* wg_ = wl + 12288; LAS unsigned char* wo_ = wl + 14336;
#define RNN_GLDS(src, dst) __builtin_amdgcn_global_load_lds((const unsigned*)(src), (LAS unsigned*)(dst), 16, 0, 0)
#define RNN_VMWAIT() asm volatile("s_waitcnt vmcnt(0)" ::: "memory")
#define RNN_LGWAIT() asm volatile("s_waitcnt lgkmcnt(0)" ::: "memory")
    const int per = (NUNITS + ngw - 1) / ngw, u0 = gw * per, u1 = (u0 + per < NUNITS) ? u0 + per : NUNITS;
    unsigned xoffp[6];
#pragma unroll
    for (int j2 = 0; j2 < 6; ++j2) { unsigned w = 0u;
#pragma unroll
        for (int s = 0; s < 2; ++s) { const int j = 2 * j2 + s; if (j < 11) { const int p = lane + 64 * j, rr = (p * 2979) >> 16, q = p - rr * 22; w |= (unsigned)(rr * (DR / 8) + q) << (16 * s); } }
        xoffp[j2] = w; }
    bf16x8 wa[11], wx[11];
    int cur_nct = -1, prev_bc = -2; float bav = 0.f, bxv = 0.f, cl = 0.f; float hc = 0.f;
    for (int u = u0; u < u1; ++u) {
        const int nct = u >> 6, bc = u & 63, b = bc >> 5, c = bc & 31, n = nct / 6, ct = nct - 6 * n;
        const int chl = ct * 32 + r; const bool chv = chl < RB; const int chc = chv ? chl : RB - 1; const int ch = n * RB + chc;
        if (nct != cur_nct) {
            cur_nct = nct;
#pragma unroll
            for (int gsel = 0; gsel < 2; ++gsel) {
                const bf16_t* wsrc = gsel == 0 ? wra : wrx; int ln_ = lane; asm volatile("" : "+v"(ln_));
#pragma unroll
                for (int j = 0; j < 12; ++j) { const int p = ln_ + 64 * j, rr = (p * 2731) >> 16, q = p - rr * 24; const int cr = ct * 32 + rr;
                    RNN_GLDS(wsrc + (size_t)(n * RB + (cr < RB ? cr : RB - 1)) * RBP + q * 8, wt_ + j * 1024); }
                RNN_VMWAIT();
#pragma unroll
                for (int ks = 0; ks < 11; ++ks) { const bf16x8 v = *(const LAS bf16x8*)(wt_ + r * 384 + (16 * ks + 8 * h) * 2); if (gsel == 0) wa[ks] = v; else wx[ks] = v; }
                RNN_LGWAIT();
            }
            bav = -LOG2E * a.b_rg_a[ch]; bxv = -LOG2E * a.b_rg_x[ch]; const float l = a.lam[ch];
            cl = -LOG2E * 8.0f * (fmaxf(-l, 0.f) + log1pf(expf(-fabsf(l))));
            prev_bc = -2;
        }
        const size_t mc0 = (size_t)b * SEQ + c * CHUNK;
        const bf16_t* xrow = xc + mc0 * DR + n * RB;
#define RNN_ISSUE_X(tt_) do { const char* xn_ = (const char*)(xrow + (size_t)(tt_) * 32 * DR); \
        _Pragma("unroll") for (int j = 0; j < 11; ++j) { unsigned w_ = xoffp[j >> 1]; asm volatile("" : "+v"(w_));     \
            const unsigned o16_ = (j & 1) ? (w_ >> 16) : (w_ & 0xffffu); RNN_GLDS(xn_ + ((size_t)o16_ << 4), wt_ + j * 1024); } } while (0)
        RNN_ISSUE_X(0);
        const int tokp = lane >> 2, qp = lane & 3;
        const bool stv = ct * 32 + qp * 8 < RB;
        const size_t pbase = (mc0 + tokp) * DR + n * RB + ct * 32 + qp * 8;
        u32x4 gt[4][2];
        if (PASSB) { const bf16_t* gtile = gg + ((size_t)((mc0 >> 5) * 16 + n) * 6 + ct) * 1024 + lane * 8;
#pragma unroll
            for (int t4 = 0; t4 < 4; ++t4) { gt[t4][0] = *(const u32x4*)(gtile + (size_t)t4 * (96 * 1024)); gt[t4][1] = *(const u32x4*)(gtile + (size_t)t4 * (96 * 1024) + 512); } }
        float Pc = 1.f;
        if (!PASSB) hc = 0.f;
        else if (c == 0) hc = 0.f;
        else if (bc != prev_bc + 1) {
            typedef float f32x2_ __attribute__((ext_vector_type(2)));
            f32x2_ sv[NCHUNK - 1];
#pragma unroll
            for (int cp = 0; cp < NCHUNK - 1; ++cp) sv[cp] = *(const f32x2_*)(summ + ((size_t)(b * NCHUNK + cp) * DR + ch) * 2);
            hc = 0.f;
#pragma unroll
            for (int cp = 0; cp < NCHUNK - 1; ++cp) hc = cp < c ? sv[cp][0] * hc + sv[cp][1] : hc;
        }
        prev_bc = bc;
        for (int tt = 0; tt < 4; ++tt) {
            if (PASSB && tt > 0) asm volatile("s_waitcnt vmcnt(2)" ::: "memory"); else RNN_VMWAIT();
            if (PASSB) { u32x4 g0 = gt[0][0], g1 = gt[0][1];
                if (tt == 1) { g0 = gt[1][0]; g1 = gt[1][1]; } else if (tt == 2) { g0 = gt[2][0]; g1 = gt[2][1]; } else if (tt == 3) { g0 = gt[3][0]; g1 = gt[3][1]; }
                *(LAS u32x4*)(wg_ + tokp * 64 + qp * 16) = g0; *(LAS u32x4*)(wg_ + (tokp + 16) * 64 + qp * 16) = g1; }
            f32x16 aa, ax;
#pragma unroll
            for (int i = 0; i < 16; ++i) { aa[i] = 0.f; ax[i] = 0.f; }
#pragma unroll
            for (int ks = 0; ks < 11; ++ks) { const bf16x8 af = *(const LAS bf16x8*)(wt_ + r * XP + (16 * ks + 8 * h) * 2); aa = MFMA32(af, wa[ks], aa); ax = MFMA32(af, wx[ks], ax); }
            unsigned short xvr[16], ggr[16];
#pragma unroll
            for (int i = 0; i < 16; ++i) { xvr[i] = *(const LAS unsigned short*)(wt_ + crow(i, h) * XP + chl * 2); if (PASSB) ggr[i] = *(const LAS unsigned short*)(wg_ + crow(i, h) * 64 + r * 2); }
            RNN_LGWAIT();
            __builtin_amdgcn_sched_barrier(0);
            if (tt < 3) RNN_ISSUE_X(tt + 1);
            __builtin_amdgcn_sched_barrier(0);
            float av[16], uv[16];
#pragma unroll
            for (int i = 0; i < 16; ++i) { const float xv = bf2f(xvr[i]);
                const float rg = __builtin_amdgcn_rcpf(1.0f + __builtin_amdgcn_exp2f(aa[i] + bav)), ig = __builtin_amdgcn_rcpf(1.0f + __builtin_amdgcn_exp2f(ax[i] + bxv));
                const float av_ = __builtin_amdgcn_exp2f(cl * rg); av[i] = av_;
                uv[i] = __builtin_amdgcn_sqrtf(__builtin_fmaf(-av_, av_, 1.0f)) * (ig * xv); }
            float pc[16], hl[16], Pg[4], Hg[4], Pgo[4], Hgo[4];
#pragma unroll
            for (int g = 0; g < 4; ++g) { float P = 1.f, H = 0.f;
#pragma unroll
                for (int j = 0; j < 4; ++j) { H = av[4 * g + j] * H + uv[4 * g + j]; P = P * av[4 * g + j]; pc[4 * g + j] = P; hl[4 * g + j] = H; }
                Pg[g] = P; Hg[g] = H; }
#pragma unroll
            for (int g = 0; g < 4; ++g) {
                const auto rp = __builtin_amdgcn_permlane32_swap(__float_as_uint(Pg[g]), __float_as_uint(Pg[g]), false, false), rh = __builtin_amdgcn_permlane32_swap(__float_as_uint(Hg[g]), __float_as_uint(Hg[g]), false, false);
                Pg[g] = __uint_as_float(rp[0]); Pgo[g] = __uint_as_float(rp[1]); Hg[g] = __uint_as_float(rh[0]); Hgo[g] = __uint_as_float(rh[1]); }
            float cur = hc, cin[4];
#pragma unroll
            for (int g = 0; g < 4; ++g) { const float P0 = Pg[g], H0 = Hg[g], P1 = Pgo[g], H1 = Hgo[g];
                const float c0 = cur; cur = P0 * cur + H0; const float c1 = cur; cur = P1 * cur + H1; cin[g] = h == 0 ? c0 : c1; Pc *= P0 * P1; }
            hc = cur;
            if (PASSB) {
#pragma unroll
                for (int i = 0; i < 16; ++i) { const float hv = hl[i] + pc[i] * cin[i >> 2]; const float y = bf2f(ggr[i]) * hv; *(LAS unsigned short*)(wo_ + crow(i, h) * 64 + r * 2) = f2bf_hw(y); }
                const u32x4 o0 = *(const LAS u32x4*)(wo_ + tokp * 64 + qp * 16), o1 = *(const LAS u32x4*)(wo_ + (tokp + 16) * 64 + qp * 16);
                if (stv) { const size_t po = pbase + (size_t)tt * 32 * DR; *(u32x4*)(ar + po) = o0; *(u32x4*)(ar + po + (size_t)16 * DR) = o1; } }
            __builtin_amdgcn_sched_barrier(0);
        }
        if (!PASSB && chv && h == 0) { float* sp = summ + ((size_t)(b * NCHUNK + c) * DR + ch) * 2; sp[0] = Pc; sp[1] = hc; }
#undef RNN_ISSUE_X
    }
#undef RNN_GLDS
#undef RNN_VMWAIT
#undef RNN_LGWAIT
}

namespace cg = cooperative_groups;
__global__ void __launch_bounds__(NTHREADS, 2) fwd(Args a) {
    extern __shared__ __attribute__((aligned(16))) unsigned char lds_raw[];
    LAS unsigned char* lds = (LAS unsigned char*)lds_raw;
    const int tid = threadIdx.x, lane = tid & 63, wave = __builtin_amdgcn_readfirstlane(tid >> 6);
    const int G = gridDim.x, bx = blockIdx.x;
    const int gw = bx * NWAVES + wave, ngw = G * NWAVES, gtid = bx * NTHREADS + tid, ngt = G * NTHREADS;
    unsigned char* ws = a.ws;
    const int lo = a.ph_lo, hi = a.ph_hi, mask = a.mask;
#define IN(k) (lo <= (k) && (k) < hi)
    { volatile LAS unsigned* misc = (volatile LAS unsigned*)(lds + MISC_OFF); if (tid < 16) misc[tid] = 0u; }
    __syncthreads();
#ifndef STAMPK
#define STAMPK -1
#endif
    unsigned long long t_idle0 = 0, t_idle1 = 0;
    unsigned long long t_start = 0, t_stamp = 0;
    if (STAMPK >= 0) t_start = __builtin_amdgcn_s_memrealtime();
    XcdBarrier bar = xcd_barrier_post((unsigned*)(ws + WS_SMALL + SM_CTL), (volatile LAS unsigned*)(lds + MISC_OFF));
#if USE_CG_SYNC
#define SEAM(k) do { if (IN(k) && IN((k) + 1)) cg::this_grid().sync(); } while (0)
#else
    bool lmode = false; int xslot = 0, lrank = 0;
    unsigned* bar2 = (unsigned*)(ws + WS_SMALL + SM_CTL) + 8192;
#ifndef LOCAL_SEAMS
#define LOCAL_SEAMS 1
#endif
#ifndef IDLEK
#define IDLEK -1
#endif
#ifndef IDLE_COND
#define IDLE_COND (bx == 0)
#endif
#ifndef IDLE_SYNC
#define IDLE_SYNC 1
#endif
#ifndef IDLE_MUL
#define IDLE_MUL 10ull
#endif
#define SEAM(k) do { if (IDLEK == (k)) { if (IDLE_SYNC) { if (IDLE_SYNC > 1) asm volatile("s_waitcnt vmcnt(0)" ::: "memory"); __syncthreads(); } t_idle0 = __builtin_amdgcn_s_memrealtime(); } if (IN(k) && IN((k) + 1)) { if (lmode && (k) >= 5 && (k) <= 8 && !((k) == 7 && LATE_CONV && !LC_P4 && LC_P7TAIL)) xcd_local_barrier(bar2, bar.x, 32u); else xcd_barrier(bar); } if (STAMPK == (k)) t_stamp = __builtin_amdgcn_s_memrealtime(); if (IDLEK == (k)) t_idle1 = __builtin_amdgcn_s_memrealtime(); } while (0)
#endif
    bf16_t* hb = (bf16_t*)(ws + WS_HB); bf16_t* qn = (bf16_t*)(ws + WS_QN); bf16_t* kn = (bf16_t*)(ws + WS_KN); bf16_t* vv = (bf16_t*)(ws + WS_VV); bf16_t* xr = (bf16_t*)(ws + WS_XR);
    bf16_t* gg = (bf16_t*)(ws + WS_GG); bf16_t* sgr = (bf16_t*)(ws + WS_SGR); bf16_t* sga = (bf16_t*)(ws + WS_SGA); bf16_t* pb = (bf16_t*)(ws + WS_PB);
    bf16_t* ob = (bf16_t*)(ws + WS_OB); bf16_t* mixa = (bf16_t*)(ws + WS_MIXA); bf16_t* Pp = (bf16_t*)(ws + WS_PP); bf16_t* ar = (bf16_t*)(ws + WS_AR); bf16_t* mixb = (bf16_t*)(ws + WS_MIXB);
    bf16_t* x1b = (bf16_t*)(ws + WS_X1B); bf16_t* x2b = (bf16_t*)(ws + WS_X2B); bf16_t* act = (bf16_t*)(ws + WS_ACT);
    float* ssq1 = (float*)(ws + WS_SMALL + SM_SSQ1); float* ssq2 = (float*)(ws + WS_SMALL + SM_SSQ2);

#ifndef NO_P0
    if (IN(0)) { for (int rep = 0; rep < NREP(0); ++rep) if (mask & F_P0) p0_prologue(a, lds, gw, ngw, lane, gtid, ngt); }
#endif
    SEAM(0);
    if (LOCAL_SEAMS && G == 256 && IN(0) && IN(1)) {
        volatile LAS unsigned* misc = (volatile LAS unsigned*)(lds + MISC_OFF);
        __syncthreads();
        lrank = __builtin_amdgcn_readfirstlane((int)misc[2]); xslot = __builtin_amdgcn_readfirstlane((int)misc[3]); lmode = __builtin_amdgcn_readfirstlane((int)misc[4]) != 0;
    }
    if (PHON(1) && IN(1) && (mask & F_G1)) for (int rep = 0; rep < NREP(1); ++rep) {
        pg8::Gemm g{hb, (const bf16_t*)(ws + WS_W1), M, DIN, DM}; pg8::Order<3> S; S.init(M, DIN, G, bx, lmode && P1_LOCAL, xslot, lrank);
        pg8::Epi1 E{xr, gg, qn, kn, vv, sgr, sga, a.q_gain, a.k_gain, (LAS float*)(lds + XCH_OFF), 1.0f / P1_KREP};
        pg8::gemm_phase<pg8::Epi1, pg8::Order<3>, true, true, P1_KREP, P1_EREP>(lds, g, S, E);
        const int tidx = (lmode && P1_LOCAL) ? (lrank >= 24 ? xslot * 8 + (lrank - 24) : -1) : (bx >= 192 ? bx - 192 : -1);
        if (LATE_CONV && LC_WAO_TAIL && G == 256 && tidx >= 0) convert_range(a, lds + wave * 16384, lane, CI_W1, CI_P2, tidx * NWAVES + wave, 64 * NWAVES);
        if (LC_SMALL_TAIL && G == 256 && tidx >= 0) { p0_small(a, tidx * NTHREADS + tid, 64 * NTHREADS, true, false);
            if (LATE_CONV && !LC_P4 && LC_P7TAIL) convert_range(a, lds + wave * 16384, lane, CI_P4 + CI_WDN + CI_WPG, CI_END, tidx * NWAVES + wave, 64 * NWAVES); }
        if (LATE_CONV && LC_P1TAIL && G == 256 && tidx >= 0) convert_range(a, lds + wave * 16384, lane, CI_P2, CI_P3 + TAIL_EXTRA, tidx * NWAVES + wave, 64 * NWAVES);
    }
    SEAM(1);
    if (IN(2)) for (int rep = 0; rep < NREP(2); ++rep) {
        LAS unsigned char* wl = lds + wave * 16384;
#define P2_STREAM() do { if (mask & F_CONV) conv_phase(a, gtid, ngt); if (LATE_CONV && LC_P2) convert_range(a, wl, lane, CI_P2, CI_P3, gw, ngw); } while (0)
#define P2_ATTN() do { if (mask & F_ATTN) { for (int u = gw; u < NBATCH * NH * (SEQ / 32); u += ngw) attn_unit(u >> 11, (u >> 7) & 15, u & 127, qn, kn, vv, ob, wl, lane); } } while (0)
#ifndef P2_DYN
#define P2_DYN 1
#endif
        if (P2_DYN && (mask & F_CONV) && (mask & F_ATTN) && NREP(2) == 1 && G == 256) {
            static_assert(256 * 22 * 64 == (M / 8) * (DR / 8), "P2 conv chunks");
            volatile LAS unsigned* cctr = (volatile LAS unsigned*)(lds + MISC_OFF) + 6;
#define P2_DRAW() ({ unsigned c_ = 0u; if (lane == 0) c_ = __hip_atomic_fetch_add((LAS unsigned*)cctr, 1u, __ATOMIC_RELAXED, __HIP_MEMORY_SCOPE_WORKGROUP); (unsigned)__builtin_amdgcn_readfirstlane((int)c_); })
            if (wave >= 4) { for (int k2 = 0; k2 < 2; ++k2) { const unsigned c = P2_DRAW(); if (c < 22u) conv_item(a, bx * 1408 + (int)c * 64 + lane); } }
            attn_unit(gw >> 11, (gw >> 7) & 15, gw & 127, qn, kn, vv, ob, wl, lane);
            { const int u = gw + 2048; attn_unit(u >> 11, (u >> 7) & 15, u & 127, qn, kn, vv, ob, wl, lane); }
            for (;;) { const unsigned c = P2_DRAW(); if (c >= 22u) break; conv_item(a, bx * 1408 + (int)c * 64 + lane); }
#undef P2_DRAW
        } else
        if (P2_SWAP && wave < 4) { P2_ATTN(); P2_STREAM(); } else { P2_STREAM(); P2_ATTN(); }
#undef P2_STREAM
#undef P2_ATTN
    }
    SEAM(2);
    if (IN(3)) for (int rep = 0; rep < NREP(3); ++rep) {
#ifndef P3_SWAP
#define P3_SWAP 0
#endif
        const bool gemm_first = P3_SWAP && PHON(3) && (mask & F_YA) && (mask & F_RNN) && ((bx >> 3) & 1);
#define P3_RNN() do { if (mask & F_RNN) { LAS unsigned char* wl = lds + wave * 16384; \
            if (wave >= 4 && LATE_CONV) convert_range(a, wl, lane, (LC_P2 || (LC_P1TAIL && G == 256)) ? CI_P3 + ((LC_P1TAIL && G == 256) ? TAIL_EXTRA : 0) : CI_P2, CI_P4, gw, ngw); \
            rnn_wave<false>(a, lane, wl, gw, ngw); \
            if (wave < 4 && LATE_CONV) convert_range(a, wl, lane, (LC_P2 || (LC_P1TAIL && G == 256)) ? CI_P3 + ((LC_P1TAIL && G == 256) ? TAIL_EXTRA : 0) : CI_P2, CI_P4, gw, ngw); } } while (0)
#define P3_GEMM() do { if (PHON(3) && (mask & F_YA)) { __syncthreads(); \
            { pg8::Gemm g{ob, (const bf16_t*)(ws + WS_WAO), M, DM, DM}; pg8::StaticOrder S; S.init(M, DM, G, bx); pg8::EpiMixA E{mixa, sga, DM}; \
              pg8::gemm_phase<pg8::EpiMixA, pg8::StaticOrder, true, true>(lds, g, S, E); } __syncthreads(); } } while (0)
        if (gemm_first) { P3_GEMM(); P3_RNN(); } else { P3_RNN(); P3_GEMM(); }
#undef P3_RNN
#undef P3_GEMM
    }
    SEAM(3);
    if (IN(4) && (mask & F_RNN)) {
        LAS unsigned char* wl = lds + wave * 16384;
        if (wave >= 4 && LATE_CONV && LC_P4) convert_range(a, wl, lane, CI_P4, CI_END, gw, ngw);
        rnn_wave<true>(a, lane, wl, gw, ngw);
        if (wave < 4 && LATE_CONV && LC_P4) convert_range(a, wl, lane, CI_P4, CI_END, gw, ngw);
    }
    SEAM(4);
    if (PHON(5) && IN(5) && (mask & F_YR)) for (int rep = 0; rep < NREP(5); ++rep) { pg8::Gemm g{ar, (const bf16_t*)(ws + WS_WRO), M, DM, DR}; pg8::Order<0> S; S.init(M, DM, G, bx, lmode, xslot, lrank); pg8::EpiMixB E{mixb, mixa, sgr, DM};
        pg8::gemm_phase<pg8::EpiMixB, pg8::Order<0>, true, true, 1, P5_EREP>(lds, g, S, E); }
    SEAM(5);
    if (PHON(6) && IN(6) && (mask & F_WO)) { pg8::Gemm g{mixb, (const bf16_t*)(ws + WS_WO), M, DM, DM}; pg8::Order<0> S; S.init(M, DM, G, bx, lmode, xslot, lrank); pg8::EpiRes<false> E{a.x, x1b, ssq1, DM};
        pg8::gemm_phase<pg8::EpiRes<false>, pg8::Order<0>, true, true>(lds, g, S, E); }
    SEAM(6);
    if (PHON(7) && IN(7) && (mask & F_FFU)) {
#ifndef P7_CONV_FIRST
#define P7_CONV_FIRST 0
#endif
        if (P7_CONV_FIRST) {
        if (LATE_CONV && !LC_P4 && LC_P7TAIL && G == 256) { const int sidx = lmode ? (lrank >= 16 ? xslot * 16 + (lrank - 16) : -1) : (bx >= 128 ? bx - 128 : -1);
            if (sidx >= 0) { convert_range(a, lds + wave * 16384, lane, CI_P4, CI_P4 + CI_WDN + CI_WPG, sidx * NWAVES + wave, 128 * NWAVES); __syncthreads(); } } }
        pg8::Gemm g{x1b, (const bf16_t*)(ws + WS_WGU), M, 2 * DFF, DM}; pg8::Order<1> S; S.init(M, 2 * DFF, G, bx, lmode, xslot, lrank); pg8::EpiFfn E{act, ssq1, DFF, 1.0f / P7_KREP};
        pg8::gemm_phase<pg8::EpiFfn, pg8::Order<1>, P7_ALIGN, P7_SP2, P7_KREP, P7_EREP>(lds, g, S, E);
        if (lmode || G != 256 || bx >= 128) { pg8::Gemm g2{pb, (const bf16_t*)(ws + WS_WPP), M, DM, PLE}; pg8::Order<2> S2; if (G == 256) S2.init(M, DM, 128, bx - 128, lmode, xslot, lrank); else S2.init(M, DM, G, bx, false, 0, 0);
            pg8::EpiMixA E2{Pp, nullptr, DM};
            pg8::gemm_phase<pg8::EpiMixA, pg8::Order<2>, true, false>(lds, g2, S2, E2); }
        if (!P7_CONV_FIRST && LATE_CONV && !LC_P4 && LC_P7TAIL && G == 256) { const int sidx = lmode ? (lrank >= 16 ? xslot * 16 + (lrank - 16) : -1) : (bx >= 128 ? bx - 128 : -1);
            if (sidx >= 0) convert_range(a, lds + wave * 16384, lane, CI_P4, CI_P4 + CI_WDN + CI_WPG, sidx * NWAVES + wave, 128 * NWAVES); } }
    SEAM(7);
    if (PHON(8) && IN(8) && (mask & F_FFD)) { pg8::Gemm g{act, (const bf16_t*)(ws + WS_WDN), M, DM, DFF}; pg8::Order<0> S; S.init(M, DM, G, bx, lmode, xslot, lrank); pg8::EpiRes<true> E{x1b, x2b, ssq2, DM};
        pg8::gemm_phase<pg8::EpiRes<true>, pg8::Order<0>, true, true>(lds, g, S, E); }
    SEAM(8);
    if (PHON(9) && IN(9) && (mask & F_PLE)) { pg8::Gemm g{x2b, (const bf16_t*)(ws + WS_WPG), M, DM, DM}; pg8::Order<0> S; S.init(M, DM, G, bx, lmode, xslot, lrank); pg8::EpiPle E{x2b, Pp, a.out, ssq2, DM};
        pg8::gemm_phase<pg8::EpiPle, pg8::Order<0>, true, true, 1, P9_EREP>(lds, g, S, E); }
#ifndef IDLE_AVG
#define IDLE_AVG 0
#endif
#ifndef IDLE_FILT
#define IDLE_FILT 1
#endif
    if (IDLEK >= 0 && IDLE_AVG) {
        unsigned* acc = (unsigned*)(ws + WS_SMALL + SM_CTL) + 12288;
        if (tid == 0 && (IDLE_FILT)) { atomicAdd(acc, (unsigned)(t_idle1 - t_idle0)); atomicAdd(acc + 1, 1u); }
        xcd_barrier(bar);
        if (bx == 0) { const unsigned long long t_end = __builtin_amdgcn_s_memrealtime(), wait = IDLE_MUL * (unsigned long long)xb_ld(acc) / (unsigned long long)xb_ld(acc + 1); while (__builtin_amdgcn_s_memrealtime() - t_end < wait) __builtin_amdgcn_s_sleep(16); }
    } else
    if (IDLEK >= 0 && (IDLE_COND)) { const unsigned long long t_end = __builtin_amdgcn_s_memrealtime(), wait = IDLE_MUL * (t_idle1 - t_idle0); while (__builtin_amdgcn_s_memrealtime() - t_end < wait) __builtin_amdgcn_s_sleep(16); }
    if (STAMPK >= 0 && bx == 0) { const unsigned long long t_end = __builtin_amdgcn_s_memrealtime(), wait = 2ull * (t_stamp - t_start); while (__builtin_amdgcn_s_memrealtime() - t_end < wait) __builtin_amdgcn_s_sleep(16); }
#undef IN
#undef SEAM
}

#ifndef FASTMASK
#define FASTMASK F_ALL
#endif
#ifndef ONE_LAUNCH
#define ONE_LAUNCH 1
#endif
extern "C" void kernel_launch(void* const* d_in, const int* in_sizes, int n_in, void* d_out, int out_size, void* d_ws, size_t ws_size, hipStream_t stream) {
    if (n_in != 22 || out_size != M * DM || ws_size < WS_END) { fprintf(stderr, "kernel_launch: unexpected sizes n_in %d out %d ws %zu\n", n_in, out_size, ws_size); return; }
    const float* x = (const float*)d_in[0]; const float* p = (const float*)d_in[1]; const float* g_mix = (const float*)d_in[2]; const float* w_in = (const float*)d_in[3];
    const float* conv_w = (const float*)d_in[4]; const float* conv_b = (const float*)d_in[5]; const float* w_rg_a = (const float*)d_in[6]; const float* b_rg_a = (const float*)d_in[7];
    const float* w_rg_x = (const float*)d_in[8]; const float* b_rg_x = (const float*)d_in[9]; const float* lam = (const float*)d_in[10]; const float* q_gain = (const float*)d_in[11];
    const float* k_gain = (const float*)d_in[12]; const float* w_rnn_out = (const float*)d_in[13]; const float* w_attn_out = (const float*)d_in[14]; const float* w_o = (const float*)d_in[15];
    const float* g_ffn = (const float*)d_in[16]; const float* w_gu = (const float*)d_in[17]; const float* w_dn = (const float*)d_in[18]; const float* g_ple = (const float*)d_in[19];
    const float* w_pg = (const float*)d_in[20]; const float* w_pp = (const float*)d_in[21];
    float* out = (float*)d_out; unsigned char* ws = (unsigned char*)d_ws;
    static int grid = 0;
    if (grid == 0) {
        int dev = 0, cus = 0, per_cu = 0;
        if (hipGetDevice(&dev) != hipSuccess || hipDeviceGetAttribute(&cus, hipDeviceAttributeMultiprocessorCount, dev) != hipSuccess) { fprintf(stderr, "kernel_launch: device query failed\n"); grid = -1; return; }
        if (hipFuncSetAttribute((const void*)fwd, hipFuncAttributeMaxDynamicSharedMemorySize, LDS_BYTES) != hipSuccess) { fprintf(stderr, "kernel_launch: hipFuncSetAttribute failed\n"); grid = -1; return; }
        if (hipOccupancyMaxActiveBlocksPerMultiprocessor(&per_cu, (const void*)fwd, NTHREADS, LDS_BYTES) != hipSuccess || per_cu < 1) { fprintf(stderr, "kernel_launch: occupancy query says %d blocks per CU\n", per_cu); (void)hipGetLastError(); grid = -1; return; }
        grid = cus;
    }
    if (grid < 0) return;
    Args a{};
    a.x = x; a.p = p; a.g_mix = g_mix; a.w_in = w_in; a.conv_w = conv_w; a.conv_b = conv_b; a.w_rg_a = w_rg_a; a.b_rg_a = b_rg_a; a.w_rg_x = w_rg_x; a.b_rg_x = b_rg_x; a.lam = lam;
    a.q_gain = q_gain; a.k_gain = k_gain; a.w_rnn_out = w_rnn_out; a.w_attn_out = w_attn_out; a.w_o = w_o; a.g_ffn = g_ffn; a.w_gu = w_gu; a.w_dn = w_dn; a.g_ple = g_ple; a.w_pg = w_pg; a.w_pp = w_pp;
    a.out = out; a.ws = ws;
    if (hipMemsetAsync(ws + WS_SMALL + SM_CTL, 0, CTL_BYTES, stream) != hipSuccess) { fprintf(stderr, "kernel_launch: memset failed\n"); return; }
    a.ph_lo = 0; a.ph_hi = 10; a.mask = F_ALL;
    void* kargs[] = {&a};
    hipError_t e = hipLaunchCooperativeKernel((const void*)fwd, dim3(grid), dim3(NTHREADS), kargs, LDS_BYTES, stream);
    if (e != hipSuccess) fprintf(stderr, "kernel_launch: launch failed: %s (grid %d)\n", hipGetErrorString(e), grid);
}
```
